# Optimizing an MI355X kernel written in HIP

```python
import math
import jax, jax.numpy as jnp
from jax import lax
import numpy as np

D_MODEL = 1024
BATCH = 16
SEQ = 4096
DEPTH = 2
DEC_BATCH = 32
DEC_SEQ = 64
PAST_LEN = 2048

CHUNK = 64
N_MIXERS = 2
N_SB_LAYERS = (DEPTH + 1) // 2
N_POOL_LAYERS = DEPTH // 2
SB_HEADS = 16
SB_HEAD_DIM = D_MODEL // SB_HEADS
Q_BLOCK = 128
POOL_WINDOWS = (2, 4, 8, 16)
POOL_GROUPS = len(POOL_WINDOWS)
POOL_GROUP_DIM = D_MODEL // POOL_GROUPS
POOL_STATE = max(POOL_WINDOWS) - 1
N_MEM = 256
MEM_HEADS = 4
MEM_HEAD_DIM = D_MODEL // MEM_HEADS
D_FF = 2816
CONV_WIDTH = 3
RMS_EPS = 1e-6

kernel_name = "stickbreak_pool_hybrid_stream_step"


def rmsnorm(x, g):
    xf = x.astype(jnp.float32)
    y = xf * lax.rsqrt(jnp.mean(xf * xf, axis=-1, keepdims=True) + RMS_EPS)
    return (y * g.astype(jnp.float32)).astype(x.dtype)


def stick_breaking(q, k, v, q_pos, k_pos):
    z = jnp.einsum('bqhd,bkhd->bhqk', q.astype(jnp.float32), k.astype(jnp.float32)) / math.sqrt(SB_HEAD_DIM)
    mask = k_pos[None, :] < q_pos[:, None]
    log_keep = jnp.where(mask, jax.nn.log_sigmoid(-z), 0.0)
    after = lax.cumsum(log_keep, axis=3, reverse=True) - log_keep
    w = jnp.where(mask, jnp.exp(jax.nn.log_sigmoid(z) + after), 0.0)
    return jnp.einsum('bhqk,bkhd->bqhd', w, v.astype(jnp.float32)).astype(q.dtype)


def sb_qkv(h, w_qkv):
    B, T, _ = h.shape
    qkv = (h @ w_qkv).reshape(B, T, 3, SB_HEADS, SB_HEAD_DIM)
    return qkv[:, :, 0], qkv[:, :, 1], qkv[:, :, 2]


def sb_prompt(q, k, v):
    S = q.shape[1]
    outs = []
    for start in range(0, S, Q_BLOCK):
        end = min(start + Q_BLOCK, S)
        outs.append(stick_breaking(q[:, start:end], k[:, :end], v[:, :end],
                                   jnp.arange(start, end), jnp.arange(end)))
    return jnp.concatenate(outs, axis=1)


def sb_sample(q, k, v, cache_k, cache_v):
    P = cache_k.shape[1]
    T = q.shape[1]
    k_all = jnp.concatenate([cache_k, k], axis=1)
    v_all = jnp.concatenate([cache_v, v], axis=1)
    return stick_breaking(q, k_all, v_all, P + jnp.arange(T), jnp.arange(P + T))


def pool_mixer(h, prev, w_group, scale, pos0):
    B, T, D = h.shape
    hp = jnp.concatenate([prev, h], axis=1).astype(jnp.float32)
    c = jnp.concatenate([jnp.zeros((B, 1, D), jnp.float32), jnp.cumsum(hp, axis=1)], axis=1)
    pos = pos0 + jnp.arange(T)
    outs = []
    for g, w in enumerate(POOL_WINDOWS):
        sl = slice(g * POOL_GROUP_DIM, (g + 1) * POOL_GROUP_DIM)
        s = c[:, POOL_STATE + 1:POOL_STATE + 1 + T, sl] - c[:, POOL_STATE + 1 - w:POOL_STATE + 1 - w + T, sl]
        cnt = jnp.minimum(pos + 1, w).astype(jnp.float32)
        outs.append(s / cnt[None, :, None])
    pooled = jnp.concatenate(outs, axis=-1) - h.astype(jnp.float32)
    mixed = jnp.einsum('btgc,gcd->btgd', pooled.reshape(B, T, POOL_GROUPS, POOL_GROUP_DIM),
                       w_group.astype(jnp.float32)).reshape(B, T, D)
    y = (mixed * scale.astype(jnp.float32)).astype(h.dtype)
    return y, hp[:, -POOL_STATE:].astype(h.dtype)


def memory_kv(mem, g, w_kv):
    B, N, _ = mem.shape
    kv = (rmsnorm(mem, g) @ w_kv).reshape(B, N, 2, MEM_HEADS, MEM_HEAD_DIM)
    return kv[:, :, 0], kv[:, :, 1]


def cross_attn(h, mk, mv, w_q, w_o):
    B, T, D = h.shape
    q = (h @ w_q).reshape(B, T, MEM_HEADS, MEM_HEAD_DIM)
    s = jnp.einsum('bthd,bnhd->bhtn', q.astype(jnp.float32), mk.astype(jnp.float32)) / math.sqrt(MEM_HEAD_DIM)
    p = jax.nn.softmax(s, axis=-1)
    o = jnp.einsum('bhtn,bnhd->bthd', p, mv.astype(jnp.float32)).astype(h.dtype)
    return o.reshape(B, T, D) @ w_o


def conv_ffn(h, prev, w_up, conv_w, conv_b, w_down):
    T = h.shape[1]
    u = h @ w_up
    up = jnp.concatenate([prev, u], axis=1)
    a = conv_b
    for j in range(CONV_WIDTH):
        a = a + up[:, j:j + T] * conv_w[j]
    gate, val = a[..., :D_FF], a[..., D_FF:]
    y = (jax.nn.silu(gate) * val) @ w_down
    return y, up[:, -(CONV_WIDTH - 1):]


def trunk(x, pos0, cache_k, cache_v, st_pool, st_ffn, mem_k, mem_v,
          norm_mix, norm_mem_q, norm_ffn, norm_final, sb_w_qkv, sb_w_o, pool_w, pool_scale,
          ca_w_q, ca_w_o, ffn_w_up, ffn_conv_w, ffn_conv_b, ffn_w_down):
    B, T, D = x.shape
    new_k, new_v, new_pool, new_ffn = [], [], [], []
    for i in range(DEPTH):
        j = i // N_MIXERS
        h = rmsnorm(x, norm_mix[i])
        if i % N_MIXERS == 0:
            q, k, v = sb_qkv(h, sb_w_qkv[j])
            if cache_k is None:
                o = sb_prompt(q, k, v)
            else:
                o = sb_sample(q, k, v, cache_k[j], cache_v[j])
            x = x + o.reshape(B, T, D) @ sb_w_o[j]
            new_k.append(k)
            new_v.append(v)
        else:
            prev = jnp.zeros((B, POOL_STATE, D), h.dtype) if st_pool is None else st_pool[j]
            m, ps = pool_mixer(h, prev, pool_w[j], pool_scale[j], pos0)
            x = x + m
            new_pool.append(ps)
        h = rmsnorm(x, norm_mem_q[i])
        x = x + cross_attn(h, mem_k[i], mem_v[i], ca_w_q[i], ca_w_o[i])
        h = rmsnorm(x, norm_ffn[i])
        prev = jnp.zeros((B, CONV_WIDTH - 1, 2 * D_FF), h.dtype) if st_ffn is None else st_ffn[i]
        f, fs = conv_ffn(h, prev, ffn_w_up[i], ffn_conv_w[i], ffn_conv_b[i], ffn_w_down[i])
        x = x + f
        new_ffn.append(fs)
    y = rmsnorm(x, norm_final)
    return y, jnp.stack(new_k), jnp.stack(new_v), jnp.stack(new_pool), jnp.stack(new_ffn)


def setup_inputs(seed: int = 0) -> dict:
    key = jax.random.key(seed)
    ks = iter(jax.random.split(key, 32))

    def nrm(shape, scale=1.0):
        return jax.random.normal(next(ks), shape, jnp.float32) * scale

    def gain(shape):
        return 1.0 + nrm(shape, 0.05)

    D, F = D_MODEL, D_FF
    return {
        "x_prompt": nrm((BATCH, SEQ, D)),
        "x_sample": nrm((DEC_BATCH, DEC_SEQ, D)),
        "mem_prompt": nrm((BATCH, N_MEM, D)),
        "cache_sb_k": nrm((N_SB_LAYERS, DEC_BATCH, PAST_LEN, SB_HEADS, SB_HEAD_DIM)),
        "cache_sb_v": nrm((N_SB_LAYERS, DEC_BATCH, PAST_LEN, SB_HEADS, SB_HEAD_DIM)),
        "state_pool": nrm((N_POOL_LAYERS, DEC_BATCH, POOL_STATE, D)),
        "state_ffn": nrm((DEPTH, DEC_BATCH, CONV_WIDTH - 1, 2 * F)),
        "cache_mem_k": nrm((DEPTH, DEC_BATCH, N_MEM, MEM_HEADS, MEM_HEAD_DIM)),
        "cache_mem_v": nrm((DEPTH, DEC_BATCH, N_MEM, MEM_HEADS, MEM_HEAD_DIM)),
        "norm_mix": gain((DEPTH, D)),
        "norm_mem_q": gain((DEPTH, D)),
        "norm_mem_kv": gain((DEPTH, D)),
        "norm_ffn": gain((DEPTH, D)),
        "norm_final": gain((D,)),
        "sb_w_qkv": nrm((N_SB_LAYERS, D, 3 * D), D ** -0.5),
        "sb_w_o": nrm((N_SB_LAYERS, D, D), D ** -0.5),
        "pool_w": nrm((N_POOL_LAYERS, POOL_GROUPS, POOL_GROUP_DIM, POOL_GROUP_DIM), POOL_GROUP_DIM ** -0.5),
        "pool_scale": gain((N_POOL_LAYERS, D)),
        "ca_w_q": nrm((DEPTH, D, D), D ** -0.5),
        "ca_w_kv": nrm((DEPTH, D, 2 * D), D ** -0.5),
        "ca_w_o": nrm((DEPTH, D, D), D ** -0.5),
        "ffn_w_up": nrm((DEPTH, D, 2 * F), D ** -0.5),
        "ffn_conv_w": nrm((DEPTH, CONV_WIDTH, 2 * F), CONV_WIDTH ** -0.5),
        "ffn_conv_b": nrm((DEPTH, 2 * F), 0.02),
        "ffn_w_down": nrm((DEPTH, F, D), F ** -0.5),
    }


def reference(x_prompt, x_sample, mem_prompt, cache_sb_k, cache_sb_v, state_pool, state_ffn,
              cache_mem_k, cache_mem_v, norm_mix, norm_mem_q, norm_mem_kv, norm_ffn, norm_final,
              sb_w_qkv, sb_w_o, pool_w, pool_scale, ca_w_q, ca_w_kv, ca_w_o,
              ffn_w_up, ffn_conv_w, ffn_conv_b, ffn_w_down):
    mk, mv = [], []
    for i in range(DEPTH):
        k_i, v_i = memory_kv(mem_prompt, norm_mem_kv[i], ca_w_kv[i])
        mk.append(k_i)
        mv.append(v_i)
    mem_k_prompt = jnp.stack(mk)
    mem_v_prompt = jnp.stack(mv)

    y_prompt, sb_k_prompt, sb_v_prompt, pool_state_prompt, ffn_state_prompt = trunk(
        x_prompt, 0, None, None, None, None, mem_k_prompt, mem_v_prompt,
        norm_mix, norm_mem_q, norm_ffn, norm_final, sb_w_qkv, sb_w_o, pool_w, pool_scale,
        ca_w_q, ca_w_o, ffn_w_up, ffn_conv_w, ffn_conv_b, ffn_w_down)

    y_sample, sb_k_sample, sb_v_sample, pool_state_sample, ffn_state_sample = trunk(
        x_sample, PAST_LEN, cache_sb_k, cache_sb_v, state_pool, state_ffn, cache_mem_k, cache_mem_v,
        norm_mix, norm_mem_q, norm_ffn, norm_final, sb_w_qkv, sb_w_o, pool_w, pool_scale,
        ca_w_q, ca_w_o, ffn_w_up, ffn_conv_w, ffn_conv_b, ffn_w_down)

    return (y_prompt, y_sample, sb_k_prompt, sb_v_prompt, sb_k_sample, sb_v_sample,
            pool_state_prompt, pool_state_sample, ffn_state_prompt, ffn_state_sample,
            mem_k_prompt, mem_v_prompt)
```

```cpp
#include <hip/hip_runtime.h>
#include <cstdio>
#include <cstdint>

#ifndef MK_ONE_LAUNCH
#define MK_ONE_LAUNCH 0
#endif

#define GAS __attribute__((address_space(1)))
#define LAS __attribute__((address_space(3)))
typedef unsigned short bf16_t;
typedef short bf16x8 __attribute__((ext_vector_type(8)));
typedef short s16x4 __attribute__((ext_vector_type(4)));
typedef float f32x4 __attribute__((ext_vector_type(4)));
typedef float f32x16 __attribute__((ext_vector_type(16)));
typedef unsigned u32x4 __attribute__((ext_vector_type(4)));
typedef unsigned u32x2 __attribute__((ext_vector_type(2)));
typedef float f32x2_t __attribute__((ext_vector_type(2)));
typedef __bf16 bf16x2_t __attribute__((ext_vector_type(2)));
typedef GAS unsigned gu32;

__device__ __forceinline__ unsigned pk_bf16(float lo, float hi) { f32x2_t v = {lo, hi}; bf16x2_t b = __builtin_convertvector(v, bf16x2_t); return __builtin_bit_cast(unsigned, b); }
__device__ __forceinline__ float shx(float v, int mask, int lane) { return __int_as_float(__builtin_amdgcn_ds_bpermute((lane ^ mask) << 2, __float_as_int(v))); }
__device__ __forceinline__ float bf_lo(unsigned u) { return __uint_as_float(u << 16); }
__device__ __forceinline__ float bf_hi(unsigned u) { return __uint_as_float(u & 0xffff0000u); }

constexpr int D = 1024, MP = 65536, MS = 2048, M = MP + MS;
constexpr int SEQ = 4096, NB = 16, DB = 32, DSEQ = 64, PAST = 2048;
constexpr int FF = 2816, FF2 = 5632, NMEM = 256;
constexpr float RMS_EPS = 1e-6f;
constexpr float LOG2E = 1.4426950408889634f;
constexpr size_t OUT_Y = 0, OUT_KP = (size_t)M * D, OUT_VP = OUT_KP + (size_t)MP * D, OUT_KS = OUT_VP + (size_t)MP * D, OUT_VS = OUT_KS + (size_t)MS * D;
constexpr size_t OUT_PSP = OUT_VS + (size_t)MS * D, OUT_PSS = OUT_PSP + (size_t)NB * 15 * D, OUT_FSP = OUT_PSS + (size_t)DB * 15 * D;
constexpr size_t OUT_FSS = OUT_FSP + (size_t)2 * NB * 2 * FF2, OUT_MKP = OUT_FSS + (size_t)2 * DB * 2 * FF2, OUT_MVP = OUT_MKP + (size_t)2 * NB * NMEM * D;
constexpr size_t OUT_TOTAL = OUT_MVP + (size_t)2 * NB * NMEM * D;
static_assert(OUT_TOTAL == 226213888ull, "output size");
constexpr size_t MiB = 1u << 20;
constexpr size_t WS_CTL = 0, CTL_ZERO_BYTES = 1 * MiB;
constexpr size_t WS_WQKV = 2 * MiB, WS_WO = 8 * MiB, WS_WPOOL = 10 * MiB, WS_WCAQ = 11 * MiB, WS_WCAKV = 15 * MiB, WS_WCAO = 23 * MiB, WS_WUP = 27 * MiB, WS_WDN = 49 * MiB;
constexpr size_t WS_MN = 60 * MiB, WS_KMP = 76 * MiB, WS_VMTP = 92 * MiB, WS_KMS = 108 * MiB, WS_VMTS = 140 * MiB;
constexpr size_t WS_HB = 172 * MiB, WS_QB = 304 * MiB, WS_KB = 436 * MiB, WS_VB = 568 * MiB;
constexpr size_t WS_UB = 304 * MiB, WS_A2 = 667 * MiB, WS_END = 1030 * MiB;
static_assert(WS_UB + (size_t)M * FF * 2 <= WS_A2 && WS_A2 + (size_t)M * FF * 2 <= WS_END && WS_HB + (size_t)M * D * 2 <= WS_QB, "ws map");
constexpr int CW_BAR = 4096;

namespace pg8 {
constexpr int BM = 256, BK = 64, HALF = 128, HTB = HALF * BK * 2, STAGE_BYTES = 8 * HTB, NXCD = 8, WGM = 8;
__host__ __device__ __forceinline__ int lds_byte(int r, int c) { const int st = (r >> 4) * 2 + (c >> 5), rr = r & 15, cc = c & 31, ob = rr * 64 + cc * 2; return st * 1024 + (ob ^ (((ob >> 9) & 1) << 5)); }
__host__ __device__ __forceinline__ void stage_rc(int b, int& R, int& C) { const int st = b / 1024, sb = b % 1024, swz = sb ^ (((sb >> 9) & 1) << 5); R = (st >> 1) * 16 + swz / 64; C = (st & 1) * 32 + (swz % 64) / 2; }
__host__ __device__ __forceinline__ int perm32(int rho) { const int n = rho >> 4, i = rho & 15; return 8 * (i >> 2) + 4 * n + (i & 3); }

struct Unit { const char* a; const char* b; int row0, col0, vlo, vhi, aux; };
struct GemmP { int lda, ldb, K; };

__device__ __forceinline__ bool tile_of(long L, int nM, int nN, int& pm, int& pn) {
    const int nwg = nM * nN; if (L >= nwg) return false;
    int wgid = (int)L; { const int q = nwg / NXCD, r = nwg % NXCD, xcd = wgid % NXCD, off = wgid / NXCD; wgid = (xcd < r ? xcd * (q + 1) : r * (q + 1) + (xcd - r) * q) + off; }
    const int nig = WGM * nN, gid = wgid / nig, fm = gid * WGM, gsz = (nM - fm) < WGM ? (nM - fm) : WGM;
    pm = fm + ((wgid % nig) % gsz); pn = (wgid % nig) / gsz; return true;
}

template <class Epi, class Sched>
__device__ __forceinline__ void gemm_phase(LAS unsigned char* lds, const GemmP g, const Sched& S, const Epi& E, int tid) {
    const int wid = __builtin_amdgcn_readfirstlane(tid >> 6), lane = tid & 63, wr = wid >> 2, wc = wid & 3, fr = lane & 15, fq = lane >> 4;
    const int K = g.K, nt = K / BK;
    unsigned voffA[2], voffB[2];
#pragma unroll
    for (int i = 0; i < 2; ++i) { int R, C; stage_rc(tid * 16 + i * 8192, R, C); const int Rb = (R & ~31) + perm32(R & 31);
        voffA[i] = (unsigned)(R * g.lda + C) * 2u; voffB[i] = (unsigned)(Rb * g.ldb + C) * 2u; }
    const size_t kstep = (size_t)(BK * 2);
    const size_t hstepA = (size_t)HALF * g.lda * 2, hstepB = (size_t)HALF * g.ldb * 2;
    const unsigned ldsw = (unsigned)wid * 1024u;
    const int aoff = lds_byte(wr * 64 + fr, fq * 8), boff = lds_byte(wc * 32 + fr, fq * 8);
#define PG8_SA(b, h) (((b) * 2 + (h)) * HTB)
#define PG8_SB(b, h) ((4 + (b) * 2 + (h)) * HTB)
#define PG8_STAGE(bufoff, gbase, voff) do { _Pragma("unroll") for (int _i = 0; _i < 2; ++_i) \
        __builtin_amdgcn_global_load_lds((const unsigned*)((const char*)(gbase) + (voff)[_i]), (LAS unsigned*)(lds + (bufoff) + ldsw + _i * 8192), 16, 0, 0); } while (0)
#define PG8_LDA(dst, b, h) do { _Pragma("unroll") for (int m = 0; m < 4; ++m) _Pragma("unroll") for (int k = 0; k < 2; ++k) dst[m][k] = *(const LAS bf16x8*)(lds + PG8_SA(b, h) + aoff + m * 2048 + k * 1024); } while (0)
#define PG8_LDB(dst, b, h) do { _Pragma("unroll") for (int n = 0; n < 2; ++n) _Pragma("unroll") for (int k = 0; k < 2; ++k) dst[n][k] = *(const LAS bf16x8*)(lds + PG8_SB(b, h) + boff + n * 2048 + k * 1024); } while (0)
#define PG8_MMA(ai, bj, At, Bt) do { __builtin_amdgcn_s_setprio(1); _Pragma("unroll") for (int m = 0; m < 4; ++m) _Pragma("unroll") for (int n = 0; n < 2; ++n) _Pragma("unroll") for (int k = 0; k < 2; ++k) \
        acc[ai][bj][m][n] = __builtin_amdgcn_mfma_f32_16x16x32_bf16(Bt[n][k], At[m][k], acc[ai][bj][m][n], 0, 0, 0); __builtin_amdgcn_s_setprio(0); } while (0)
#define PG8_WAIT_V(n) asm volatile("s_waitcnt vmcnt(" #n ")" ::: "memory")
#define PG8_WAIT_L(n) asm volatile("s_waitcnt lgkmcnt(" #n ")" ::: "memory")
#define PG8_BAR __builtin_amdgcn_s_barrier()
#define PG8_SCHED __builtin_amdgcn_sched_barrier(0)
    Unit cur, nxt; int ui = 0;
    if (!S.next(0, cur)) return;
    f32x4 acc[2][2][4][2];
#pragma unroll
    for (int a = 0; a < 2; ++a)
#pragma unroll
        for (int b = 0; b < 2; ++b)
#pragma unroll
            for (int m = 0; m < 4; ++m)
#pragma unroll
                for (int n = 0; n < 2; ++n) acc[a][b][m][n] = (f32x4){0.f, 0.f, 0.f, 0.f};
    bf16x8 At[4][2], B0[2][2], B1[2][2];
    const char* cA = cur.a; const char* cB = cur.b;
    PG8_STAGE(PG8_SB(0, 0), cB, voffB); PG8_STAGE(PG8_SB(0, 1), cB + hstepB, voffB); PG8_STAGE(PG8_SA(0, 0), cA, voffA); PG8_STAGE(PG8_SA(0, 1), cA + hstepA, voffA);
    if (wr == 1) PG8_BAR;
    PG8_WAIT_V(2); PG8_BAR;
    PG8_STAGE(PG8_SB(1, 0), cB + kstep, voffB); PG8_STAGE(PG8_SA(1, 0), cA + kstep, voffA); PG8_STAGE(PG8_SB(1, 1), cB + hstepB + kstep, voffB);
    PG8_WAIT_V(6); PG8_BAR;
    for (;;) {
        const bool has_next = S.next(ui + 1, nxt);
        const char* nA = has_next ? nxt.a : cA; const char* nB = has_next ? nxt.b : cB;
        for (int t = 0; t < nt; t += 2) {
            const bool last = (t == nt - 2);
            const char* a1 = cA + (size_t)(t + 1) * kstep;
            const char* a2 = last ? nA : cA + (size_t)(t + 2) * kstep; const char* b2 = last ? nB : cB + (size_t)(t + 2) * kstep;
            const char* a3 = a2 + kstep; const char* b3 = b2 + kstep;
            PG8_LDB(B0, 0, 0); PG8_LDB(B1, 0, 1); PG8_SCHED; PG8_LDA(At, 0, 0); PG8_STAGE(PG8_SA(1, 1), a1 + hstepA, voffA);
            PG8_WAIT_V(8); PG8_WAIT_L(0); PG8_BAR; PG8_MMA(0, 0, At, B0); PG8_MMA(0, 1, At, B1); PG8_BAR; PG8_SCHED;
            PG8_LDA(At, 0, 1); PG8_STAGE(PG8_SB(0, 0), b2, voffB); PG8_STAGE(PG8_SB(0, 1), b2 + hstepB, voffB); PG8_STAGE(PG8_SA(0, 0), a2, voffA);
            PG8_WAIT_V(8); PG8_WAIT_L(0); PG8_BAR; PG8_MMA(1, 0, At, B0); PG8_MMA(1, 1, At, B1); PG8_BAR; PG8_SCHED;
            PG8_LDB(B0, 1, 0); PG8_LDB(B1, 1, 1); PG8_SCHED; PG8_LDA(At, 1, 0); PG8_STAGE(PG8_SA(0, 1), a2 + hstepA, voffA);
            PG8_WAIT_V(8); PG8_WAIT_L(0); PG8_BAR; PG8_MMA(0, 0, At, B0); PG8_MMA(0, 1, At, B1); PG8_BAR; PG8_SCHED;
            PG8_LDA(At, 1, 1); PG8_STAGE(PG8_SB(1, 0), b3, voffB); PG8_STAGE(PG8_SB(1, 1), b3 + hstepB, voffB); PG8_STAGE(PG8_SA(1, 0), a3, voffA);
            PG8_WAIT_V(8); PG8_WAIT_L(0); PG8_BAR; PG8_MMA(1, 0, At, B0); PG8_MMA(1, 1, At, B1); PG8_BAR; PG8_SCHED;
        }
        if (wr == 0) PG8_BAR;
        { unsigned ones = ~0u; asm volatile("" : "+s"(ones));
          const int ln = (int)__builtin_amdgcn_mbcnt_hi(ones, __builtin_amdgcn_mbcnt_lo(ones, 0u));
          E(acc, cur, wr, wc, ln & 15, ln >> 4, lds); }
        if (!has_next) break;
#pragma unroll
        for (int a = 0; a < 2; ++a)
#pragma unroll
            for (int b = 0; b < 2; ++b)
#pragma unroll
                for (int m = 0; m < 4; ++m)
#pragma unroll
                    for (int n = 0; n < 2; ++n) acc[a][b][m][n] = (f32x4){0.f, 0.f, 0.f, 0.f};
        cur = nxt; cA = nA; cB = nB; ++ui;
        if (wr == 1) PG8_BAR;
    }
    PG8_WAIT_V(0);
    PG8_BAR;
#undef PG8_SA
#undef PG8_SB
#undef PG8_STAGE
#undef PG8_LDA
#undef PG8_LDB
#undef PG8_MMA
#undef PG8_WAIT_V
#undef PG8_WAIT_L
#undef PG8_BAR
#undef PG8_SCHED
}

struct SchedMN {
    const char* A; const char* Bt; int lda, ldb, nM, nN, G, c, col_base;
    __device__ __forceinline__ bool next(int i, Unit& u) const {
        int pm, pn; if (!tile_of((long)i * G + c, nM, nN, pm, pn)) return false;
        u.a = A + (size_t)pm * BM * lda * 2; u.b = Bt + (size_t)pn * BM * ldb * 2; u.row0 = pm * BM; u.col0 = col_base + pn * BM; u.vlo = 0; u.vhi = 0x7fffffff; u.aux = pn; return true;
    }
};
template <int MODE> struct SchedCA {
    const char* A; const char* BP; const char* BS; int G, c;
    __device__ __forceinline__ bool next(int i, Unit& u) const {
        const int L = i * G + c; if (L >= 1024 + 128) return false;
        int row0, b, h; const char* B;
        if (L < 1024) { const int pm = L >> 2; h = L & 3; row0 = pm * BM; b = pm >> 4; B = BP; u.vlo = 0; u.vhi = 0x7fffffff; }
        else { const int s = L - 1024; b = s >> 2; h = s & 3; const int r = MP + DSEQ * b; row0 = r < M - BM ? r : M - BM; B = BS; u.vlo = r; u.vhi = r + DSEQ; }
        u.a = A + ((size_t)row0 * D + h * 256) * 2;
        u.b = MODE == 0 ? B + ((size_t)b * NMEM * D + h * 256) * 2 : B + (size_t)(b * 4 + h) * 65536 * 2;
        u.row0 = row0; u.col0 = h * 256; u.aux = 0; return true;
    }
};

#define EPI_ARGS f32x4 (&acc)[2][2][4][2], const Unit& u, int wr, int wc, int fr, int fq, LAS unsigned char* lds
struct EpiBf16 {
    bf16_t* O; int ldc; float scale;
    __device__ __forceinline__ void operator()(EPI_ARGS) const {
        const int row0 = u.row0 + wr * 64 + fr, col0 = u.col0 + wc * 32 + 8 * fq;
#pragma unroll
        for (int ai = 0; ai < 2; ++ai)
#pragma unroll
            for (int m = 0; m < 4; ++m) { const int row = row0 + ai * HALF + m * 16; bf16_t* rowp = O + (size_t)row * ldc + col0;
                if (row >= u.vlo && row < u.vhi) {
#pragma unroll
                for (int bj = 0; bj < 2; ++bj) { const f32x4 v0 = acc[ai][bj][m][0] * scale, v1 = acc[ai][bj][m][1] * scale;
                    u32x4 w; w.x = pk_bf16(v0[0], v0[1]); w.y = pk_bf16(v0[2], v0[3]); w.z = pk_bf16(v1[0], v1[1]); w.w = pk_bf16(v1[2], v1[3]);
                    *(u32x4*)(rowp + bj * HALF) = w; } } }
    }
};
struct EpiQKV {
    bf16_t* Qb; size_t bstride; float* out; float qscale;
    __device__ __forceinline__ void operator()(EPI_ARGS) const {
        const int typ = u.aux >> 2, colt = (u.aux & 3) * BM + wc * 32 + 8 * fq, row0 = u.row0 + wr * 64 + fr;
        bf16_t* B = Qb + (size_t)typ * bstride;
        const bool samp = u.row0 >= MP;
        float* F = typ == 1 ? (samp ? out + OUT_KS - (size_t)MP * D : out + OUT_KP) : (samp ? out + OUT_VS - (size_t)MP * D : out + OUT_VP);
        const float sc = typ == 0 ? qscale : 1.f;
#pragma unroll
        for (int ai = 0; ai < 2; ++ai)
#pragma unroll
            for (int m = 0; m < 4; ++m) { const size_t off = (size_t)(row0 + ai * HALF + m * 16) * D + colt;
#pragma unroll
                for (int bj = 0; bj < 2; ++bj) { const f32x4 v0 = acc[ai][bj][m][0], v1 = acc[ai][bj][m][1];
                    if (typ != 0) { *(f32x4*)(F + off + bj * HALF) = v0; *(f32x4*)(F + off + bj * HALF + 4) = v1; }
                    u32x4 w; w.x = pk_bf16(v0[0] * sc, v0[1] * sc); w.y = pk_bf16(v0[2] * sc, v0[3] * sc); w.z = pk_bf16(v1[0] * sc, v1[1] * sc); w.w = pk_bf16(v1[2] * sc, v1[3] * sc);
                    *(u32x4*)(B + off + bj * HALF) = w; } }
    }
};
struct EpiResid {
    float* X; const float* cscale;
    __device__ __forceinline__ void operator()(EPI_ARGS) const {
        const int row0 = u.row0 + wr * 64 + fr, col0 = u.col0 + wc * 32 + 8 * fq;
#pragma unroll
        for (int bj = 0; bj < 2; ++bj)
#pragma unroll
            for (int n = 0; n < 2; ++n) {
                const f32x4 sc = cscale ? *(const f32x4*)(cscale + col0 + bj * HALF + 4 * n) : (f32x4){1.f, 1.f, 1.f, 1.f};
                float* colp = X + (size_t)row0 * D + col0 + bj * HALF + 4 * n;
#pragma unroll
                for (int ai = 0; ai < 2; ++ai)
#pragma unroll
                    for (int m = 0; m < 4; ++m) { f32x4* p = (f32x4*)(colp + (size_t)(ai * HALF + m * 16) * D); *p = *p + acc[ai][bj][m][n] * sc; }
                asm volatile("" ::: "memory"); }
    }
};
struct EpiMemK {
    float* F; bf16_t* B;
    __device__ __forceinline__ void operator()(EPI_ARGS) const {
        const int row0 = u.row0 + wr * 64 + fr, col0 = u.col0 + wc * 32 + 8 * fq;
#pragma unroll
        for (int ai = 0; ai < 2; ++ai)
#pragma unroll
            for (int m = 0; m < 4; ++m) { const size_t off = (size_t)(row0 + ai * HALF + m * 16) * D + col0;
#pragma unroll
                for (int bj = 0; bj < 2; ++bj) { const f32x4 v0 = acc[ai][bj][m][0], v1 = acc[ai][bj][m][1];
                    *(f32x4*)(F + off + bj * HALF) = v0; *(f32x4*)(F + off + bj * HALF + 4) = v1;
                    u32x4 w; w.x = pk_bf16(v0[0], v0[1]); w.y = pk_bf16(v0[2], v0[3]); w.z = pk_bf16(v1[0], v1[1]); w.w = pk_bf16(v1[2], v1[3]);
                    *(u32x4*)(B + off + bj * HALF) = w; } }
    }
};
struct EpiMemVT {
    float* F; bf16_t* B;
    __device__ __forceinline__ void operator()(EPI_ARGS) const {
        const int h = u.row0 >> 8, b = u.col0 >> 8;
#pragma unroll
        for (int ai = 0; ai < 2; ++ai)
#pragma unroll
            for (int m = 0; m < 4; ++m) { const int dh = ai * HALF + wr * 64 + m * 16 + fr;
#pragma unroll
                for (int bj = 0; bj < 2; ++bj) { const int n0 = bj * HALF + wc * 32 + 8 * fq; const f32x4 v0 = acc[ai][bj][m][0], v1 = acc[ai][bj][m][1];
                    u32x4 w; w.x = pk_bf16(v0[0], v0[1]); w.y = pk_bf16(v0[2], v0[3]); w.z = pk_bf16(v1[0], v1[1]); w.w = pk_bf16(v1[2], v1[3]);
                    *(u32x4*)(B + ((size_t)(b * 4 + h) * 256 + dh) * 256 + n0) = w;
                    float* fp = F + ((size_t)(b * 256 + n0) * 4 + h) * 256 + dh;
#pragma unroll
                    for (int e = 0; e < 4; ++e) { fp[(size_t)e * D] = v0[e]; fp[(size_t)(e + 4) * D] = v1[e]; } } }
    }
};
struct EpiUp {
    bf16_t* U; int ldc; int pn0; float* fsp; float* fss;
    __device__ __forceinline__ void operator()(EPI_ARGS) const {
        const int row0 = u.row0 + wr * 64 + fr, col0 = u.col0 + wc * 32 + 8 * fq;
        const int pn = pn0 + (u.col0 >> 8);
#pragma unroll
        for (int ai = 0; ai < 2; ++ai)
#pragma unroll
            for (int m = 0; m < 4; ++m) { const int row = row0 + ai * HALF + m * 16; bf16_t* rowp = U + (size_t)row * ldc + col0;
                float* st = nullptr;
                if (row < MP) { const int t = row & (SEQ - 1); if (t >= SEQ - 2) st = fsp + ((size_t)(row >> 12) * 2 + (t - (SEQ - 2))) * FF2; }
                else { const int rs = row - MP, t = rs & (DSEQ - 1); if (t >= DSEQ - 2) st = fss + ((size_t)(rs >> 6) * 2 + (t - (DSEQ - 2))) * FF2; }
#pragma unroll
                for (int bj = 0; bj < 2; ++bj) { const f32x4 v0 = acc[ai][bj][m][0], v1 = acc[ai][bj][m][1];
                    u32x4 w; w.x = pk_bf16(v0[0], v0[1]); w.y = pk_bf16(v0[2], v0[3]); w.z = pk_bf16(v1[0], v1[1]); w.w = pk_bf16(v1[2], v1[3]);
                    *(u32x4*)(rowp + bj * HALF) = w;
                    if (st) { float* sp = st + bj * FF + pn * 128 + wc * 32 + 8 * fq; *(f32x4*)sp = v0; *(f32x4*)(sp + 4) = v1; } } }
    }
};
struct EpiSoftmax {
    bf16_t* P; int xoff;
    __device__ __forceinline__ void operator()(EPI_ARGS) const {
        LAS f32x2_t* X = (LAS f32x2_t*)(lds + xoff);
        float mw[2][4];
#pragma unroll
        for (int ai = 0; ai < 2; ++ai)
#pragma unroll
            for (int m = 0; m < 4; ++m) {
                float mx = -3.0e38f;
#pragma unroll
                for (int bj = 0; bj < 2; ++bj)
#pragma unroll
                    for (int n = 0; n < 2; ++n) { const f32x4 x = acc[ai][bj][m][n]; mx = fmaxf(mx, fmaxf(fmaxf(x[0], x[1]), fmaxf(x[2], x[3]))); }
                mx = fmaxf(mx, shx(mx, 16, fq * 16 + fr)); mx = fmaxf(mx, shx(mx, 32, fq * 16 + fr));
                float s = 0.f;
#pragma unroll
                for (int bj = 0; bj < 2; ++bj)
#pragma unroll
                    for (int n = 0; n < 2; ++n) { f32x4 x = acc[ai][bj][m][n];
#pragma unroll
                        for (int e = 0; e < 4; ++e) { x[e] = __builtin_amdgcn_exp2f(x[e] - mx); s += x[e]; } acc[ai][bj][m][n] = x; }
                s += shx(s, 16, fq * 16 + fr); s += shx(s, 32, fq * 16 + fr);
                mw[ai][m] = mx;
                if (fq == 0) X[(ai * HALF + wr * 64 + m * 16 + fr) * 4 + wc] = (f32x2_t){mx, s};
            }
        asm volatile("s_waitcnt lgkmcnt(0)" ::: "memory"); __builtin_amdgcn_s_barrier(); asm volatile("" ::: "memory");
        const int row0 = u.row0 + wr * 64 + fr, col0 = u.col0 + wc * 32 + 8 * fq;
#pragma unroll
        for (int ai = 0; ai < 2; ++ai)
#pragma unroll
            for (int m = 0; m < 4; ++m) { const int rl = ai * HALF + wr * 64 + m * 16 + fr;
                const f32x2_t a = X[rl * 4 + 0], b = X[rl * 4 + 1], c = X[rl * 4 + 2], d = X[rl * 4 + 3];
                const float mt = fmaxf(fmaxf(a.x, b.x), fmaxf(c.x, d.x));
                const float L = a.y * __builtin_amdgcn_exp2f(a.x - mt) + b.y * __builtin_amdgcn_exp2f(b.x - mt) + c.y * __builtin_amdgcn_exp2f(c.x - mt) + d.y * __builtin_amdgcn_exp2f(d.x - mt);
                const float f = __builtin_amdgcn_exp2f(mw[ai][m] - mt) / L;
                const int row = row0 + ai * HALF + m * 16;
                if (row >= u.vlo && row < u.vhi) {
#pragma unroll
                for (int bj = 0; bj < 2; ++bj) { const f32x4 v0 = acc[ai][bj][m][0] * f, v1 = acc[ai][bj][m][1] * f;
                    u32x4 w; w.x = pk_bf16(v0[0], v0[1]); w.y = pk_bf16(v0[2], v0[3]); w.z = pk_bf16(v1[0], v1[1]); w.w = pk_bf16(v1[2], v1[3]);
                    *(u32x4*)(P + (size_t)row * D + col0 + bj * HALF) = w; } } }
    }
};
struct SchedPool { const char* A; const char* Bt; int G, c;
    __device__ __forceinline__ bool next(int i, Unit& u) const { int pm, pn; if (!tile_of((long)i * G + c, M / 256, 4, pm, pn)) return false;
        u.a = A + ((size_t)pm * 256 * D + pn * 256) * 2; u.b = Bt + (size_t)pn * 65536 * 2; u.row0 = pm * 256; u.col0 = pn * 256; u.vlo = 0; u.vhi = 0x7fffffff; u.aux = 0; return true; } };
}

namespace sba {
constexpr float QSCALE = 0.125f * LOG2E;
constexpr float EXIT_T = 152.f;
constexpr int VDH = 4160, WAVE_LDS = 2 * VDH;
__device__ __forceinline__ int crow(int r, int hi) { return (r & 3) + 8 * (r >> 2) + 4 * hi; }
__device__ __forceinline__ s16x4 vtr(LAS const char* p) { typedef short v4i16_t __attribute__((ext_vector_type(4))); return __builtin_bit_cast(s16x4, __builtin_amdgcn_ds_read_tr16_b64_v4i16((LAS v4i16_t*)p)); }

__device__ __forceinline__ bf16x8 cvt8(const f32x4 a, const f32x4 b) { u32x4 w; w.x = pk_bf16(a[0], a[1]); w.y = pk_bf16(a[2], a[3]); w.z = pk_bf16(b[0], b[1]); w.w = pk_bf16(b[2], b[3]); return __builtin_bit_cast(bf16x8, w); }
__device__ __forceinline__ void load_bf16(bf16x8 (&kf)[8], const bf16_t* Kt, const bf16_t* Vt, LAS char* vimg, int lane) {
    const int r32 = lane & 31, hi = lane >> 5, c = lane & 7;
    LAS char* vdst = vimg + (c >> 2) * VDH + (lane >> 3) * 64 + (c & 3) * 16;
    const bf16_t* vsrc = Vt + (size_t)(lane >> 3) * D + 8 * c;
#pragma unroll
    for (int it = 0; it < 8; ++it) { const u32x4 v = *(const GAS u32x4*)(vsrc + (size_t)it * 8 * D); *(LAS u32x4*)(vdst + it * 512) = v; }
    const bf16_t* ksrc = Kt + (size_t)r32 * D + 8 * hi;
#pragma unroll
    for (int hf = 0; hf < 2; ++hf)
#pragma unroll
        for (int d0 = 0; d0 < 4; ++d0) kf[hf * 4 + d0] = *(const GAS bf16x8*)(ksrc + (size_t)hf * 32 * D + 16 * d0);
}
__device__ __forceinline__ void load_f32(bf16x8 (&kf)[8], const float* Kt, const float* Vt, LAS char* vimg, int lane) {
    const int r32 = lane & 31, hi = lane >> 5, c = lane & 7;
    LAS char* vdst = vimg + (c >> 2) * VDH + (lane >> 3) * 64 + (c & 3) * 16;
    const float* vsrc = Vt + (size_t)(lane >> 3) * D + 8 * c;
#pragma unroll
    for (int hv = 0; hv < 2; ++hv) {
#pragma unroll
        for (int it = 4 * hv; it < 4 * hv + 4; ++it) { const GAS f32x4* p = (const GAS f32x4*)(vsrc + (size_t)it * 8 * D); *(LAS u32x4*)(vdst + it * 512) = __builtin_bit_cast(u32x4, cvt8(p[0], p[1])); }
        asm volatile("" ::: "memory"); }
    const float* ksrc = Kt + (size_t)r32 * D + 8 * hi;
#pragma unroll
    for (int hf = 0; hf < 2; ++hf) {
#pragma unroll
        for (int d0 = 0; d0 < 4; ++d0) { const GAS f32x4* p = (const GAS f32x4*)(ksrc + (size_t)hf * 32 * D + 16 * d0); kf[hf * 4 + d0] = cvt8(p[0], p[1]); }
        asm volatile("" ::: "memory"); }
}

__device__ __forceinline__ void tile_step(const bf16x8 (&kf)[8], const bf16x8 (&qr)[4], f32x16 (&o)[2], float& carry, bool masked, int tq, LAS char* vimg, int lane) {
    const int hi = lane >> 5;
    f32x16 p0 = {}, p1 = {};
#pragma unroll
    for (int d0 = 0; d0 < 4; ++d0) { p0 = __builtin_amdgcn_mfma_f32_32x32x16_bf16(kf[d0], qr[d0], p0, 0, 0, 0); p1 = __builtin_amdgcn_mfma_f32_32x32x16_bf16(kf[4 + d0], qr[d0], p1, 0, 0, 0); }
    float l0[16], l1[16];
#pragma unroll
    for (int r = 0; r < 16; ++r) {
        { const float z = p0[r]; const float e = __builtin_amdgcn_exp2f(-__builtin_fabsf(z)); float l = fmaxf(z, 0.f) + __builtin_amdgcn_logf(1.f + e); float ls = z - l;
          if (masked && !(crow(r, hi) < tq)) { l = 0.f; ls = -1.0e30f; } l0[r] = l; p0[r] = ls; }
        { const float z = p1[r]; const float e = __builtin_amdgcn_exp2f(-__builtin_fabsf(z)); float l = fmaxf(z, 0.f) + __builtin_amdgcn_logf(1.f + e); float ls = z - l;
          if (masked && !(crow(r, hi) + 32 < tq)) { l = 0.f; ls = -1.0e30f; } l1[r] = l; p1[r] = ls; }
    }
    float Glo[8], Ghi[8];
#pragma unroll
    for (int a = 0; a < 8; ++a) { const float* l = a < 4 ? l0 + 4 * a : l1 + 4 * (a - 4); const float g = (l[0] + l[1]) + (l[2] + l[3]);
        auto rr = __builtin_amdgcn_permlane32_swap(__float_as_uint(g), __float_as_uint(g), false, false); Glo[a] = __uint_as_float(rr[0]); Ghi[a] = __uint_as_float(rr[1]); }
    float sx = carry;
#pragma unroll
    for (int a = 7; a >= 0; --a) {
        const float base = sx + (hi == 0 ? Ghi[a] : 0.f);
        if (a >= 4) { const int q = 4 * (a - 4);
            const float s3 = base, s2 = s3 + l1[q + 3], s1 = s2 + l1[q + 2], s0 = s1 + l1[q + 1];
            p1[q + 3] = __builtin_amdgcn_exp2f(p1[q + 3] - s3); p1[q + 2] = __builtin_amdgcn_exp2f(p1[q + 2] - s2); p1[q + 1] = __builtin_amdgcn_exp2f(p1[q + 1] - s1); p1[q] = __builtin_amdgcn_exp2f(p1[q] - s0);
        } else { const int q = 4 * a;
            const float s3 = base, s2 = s3 + l0[q + 3], s1 = s2 + l0[q + 2], s0 = s1 + l0[q + 1];
            p0[q + 3] = __builtin_amdgcn_exp2f(p0[q + 3] - s3); p0[q + 2] = __builtin_amdgcn_exp2f(p0[q + 2] - s2); p0[q + 1] = __builtin_amdgcn_exp2f(p0[q + 1] - s1); p0[q] = __builtin_amdgcn_exp2f(p0[q] - s0);
        }
        sx += Glo[a] + Ghi[a];
    }
    carry = sx;
    bf16x8 pf[4];
#pragma unroll
    for (int s = 0; s < 4; ++s) { const f32x16& p = s < 2 ? p0 : p1; const int q = 8 * (s & 1);
        u32x4 w; w.x = pk_bf16(p[q], p[q + 1]); w.y = pk_bf16(p[q + 2], p[q + 3]); w.z = pk_bf16(p[q + 4], p[q + 5]); w.w = pk_bf16(p[q + 6], p[q + 7]); pf[s] = __builtin_bit_cast(bf16x8, w); }
    asm volatile("s_waitcnt lgkmcnt(0)" ::: "memory");
    LAS const char* vb = vimg + (4 * hi + ((lane & 15) >> 2)) * 64 + ((lane >> 4) & 1) * 32 + (lane & 3) * 8;
#pragma unroll
    for (int dh = 0; dh < 2; ++dh)
#pragma unroll
        for (int s = 0; s < 4; ++s) { const s16x4 lo = vtr(vb + dh * VDH + s * 1024), hh = vtr(vb + dh * VDH + s * 1024 + 512);
            const bf16x8 vf = (bf16x8){lo[0], lo[1], lo[2], lo[3], hh[0], hh[1], hh[2], hh[3]};
            o[dh] = __builtin_amdgcn_mfma_f32_32x32x16_bf16(vf, pf[s], o[dh], 0, 0, 0); }
    asm volatile("s_waitcnt lgkmcnt(0)" ::: "memory");
}

struct Tensors { bf16_t* Q; const bf16_t* K; const bf16_t* V; const float* cK; const float* cV; };

__device__ __forceinline__ void unit(int id, const Tensors& T, LAS char* vimg, int lane) {
    const int r32 = lane & 31, hi = lane >> 5;
    const bool samp = id >= 32768;
    int h, q0; size_t rowb; int b = 0;
    if (!samp) { const int qb = id & 127; h = (id >> 7) & 15; b = id >> 11; rowb = (size_t)b * SEQ; q0 = qb * 32; }
    else { const int s = id - 32768; const int qb = s & 1; h = (s >> 1) & 15; b = s >> 5; rowb = (size_t)MP + (size_t)b * DSEQ; q0 = qb * 32; }
    bf16_t* Qw = T.Q + (rowb + q0) * D + h * 64;
    bf16x8 qr[4];
#pragma unroll
    for (int d0 = 0; d0 < 4; ++d0) qr[d0] = *(const GAS bf16x8*)(Qw + (size_t)r32 * D + 16 * d0 + 8 * hi);
    f32x16 o[2]; o[0] = f32x16{}; o[1] = f32x16{};
    float carry = 0.f;
    const bf16_t* Kh = T.K + rowb * D + h * 64; const bf16_t* Vh = T.V + rowb * D + h * 64;
    bf16x8 kf[8];
    int kt = q0 >> 6;
    load_bf16(kf, Kh + (size_t)kt * 64 * D, Vh + (size_t)kt * 64 * D, vimg, lane);
    tile_step(kf, qr, o, carry, true, q0 + r32 - 64 * kt, vimg, lane);
    if (!samp) {
        for (--kt; kt >= 0; --kt) {
            if (__all(carry > EXIT_T)) break;
            load_bf16(kf, Kh + (size_t)kt * 64 * D, Vh + (size_t)kt * 64 * D, vimg, lane);
            tile_step(kf, qr, o, carry, false, 64, vimg, lane);
        }
    } else {
        const float* cKh = T.cK + (size_t)b * PAST * D + h * 64; const float* cVh = T.cV + (size_t)b * PAST * D + h * 64;
        for (kt = PAST / 64 - 1; kt >= 0; --kt) {
            if (__all(carry > EXIT_T)) break;
            load_f32(kf, cKh + (size_t)kt * 64 * D, cVh + (size_t)kt * 64 * D, vimg, lane);
            tile_step(kf, qr, o, carry, false, 64, vimg, lane);
        }
    }
#pragma unroll
    for (int dh = 0; dh < 2; ++dh)
#pragma unroll
        for (int a = 0; a < 4; ++a) { u32x2 w; w.x = pk_bf16(o[dh][4 * a], o[dh][4 * a + 1]); w.y = pk_bf16(o[dh][4 * a + 2], o[dh][4 * a + 3]);
            *(LAS u32x2*)(vimg + r32 * 144 + (32 * dh + 8 * a + 4 * hi) * 2) = w; }
    asm volatile("s_waitcnt lgkmcnt(0)" ::: "memory");
#pragma unroll
    for (int i = 0; i < 4; ++i) { const int row = i * 8 + (lane >> 3), ch = lane & 7; const u32x4 v = *(LAS const u32x4*)(vimg + row * 144 + ch * 16); *(GAS u32x4*)(Qw + (size_t)row * D + ch * 8) = v; }
    asm volatile("s_waitcnt lgkmcnt(0)" ::: "memory");
}
}

constexpr int NWAVES = 8;
constexpr int RING_OFF = 0, RING_BYTES = 131072, XCH_OFF = RING_BYTES, XCH_BYTES = 8192, MISC_OFF = XCH_OFF + XCH_BYTES, TICKET_OFF = MISC_OFF + 256, LDS_BYTES = 147456;
static_assert(sba::WAVE_LDS * NWAVES <= RING_BYTES && TICKET_OFF + 64 <= LDS_BYTES, "LDS map");

#define XB_TMO      128
#define XB_XCNT(j)  (256  + 64 * (j))
#define XB_XSUB(j)  (1280 + 64 * (j))
#define XB_XGEN(j)  (2304 + 64 * (j))
#define XB_TOP      3328
#define XB_TOPGEN   3392
#define XCD_BAR_WORDS 3456
#define XB_SPIN_CAP (1u << 18)
__device__ __forceinline__ unsigned xb_ld(unsigned* p)              { return __hip_atomic_load(p, __ATOMIC_RELAXED, __HIP_MEMORY_SCOPE_AGENT); }
__device__ __forceinline__ unsigned xb_add(unsigned* p, unsigned v) { return __hip_atomic_fetch_add(p, v, __ATOMIC_RELAXED, __HIP_MEMORY_SCOPE_AGENT); }
__device__ __forceinline__ unsigned xb_xcc_id() { return (unsigned)__builtin_amdgcn_s_getreg((3 << 11) | 20) & 0xFu; }
#define XB_SPIN(cond, bar) do { unsigned _sp = 0; while (cond) { __builtin_amdgcn_s_sleep(1); \
    if ((++_sp & 255u) == 0u) { if (xb_ld(&(bar)[XB_TMO])) break; if (_sp > XB_SPIN_CAP) { atomicAdd(&(bar)[XB_TMO], 1u); break; } } } } while (0)
struct XcdBarrier { unsigned* bar; unsigned x; volatile LAS unsigned* st; };
__device__ __forceinline__ XcdBarrier xcd_barrier_post(unsigned* bar, volatile LAS unsigned* st, int tid) {
    XcdBarrier b; b.bar = bar; b.x = xb_xcc_id(); b.st = st;
    if (tid == 0) (void)xb_add(&bar[XB_XCNT(b.x)], 1u);
    return b;
}
__device__ __forceinline__ void xcd_barrier_complete(unsigned* bar, unsigned x, unsigned& nloc, unsigned& nx) {
    const unsigned G = gridDim.x * gridDim.y * gridDim.z;
    unsigned sum, cnt, mine, sp = 0u;
    for (;;) {
        sum = 0u; cnt = 0u; mine = 0u;
#pragma unroll
        for (unsigned j = 0; j < 16; ++j) { const unsigned c = xb_ld(&bar[XB_XCNT(j)]); sum += c; cnt += (c > 0u) ? 1u : 0u; mine = (j == x) ? c : mine; }
        if (sum == G) break;
        __builtin_amdgcn_s_sleep(1);
        if ((++sp & 255u) == 0u) { if (xb_ld(&bar[XB_TMO])) break; if (sp > XB_SPIN_CAP) { atomicAdd(&bar[XB_TMO], 1u); break; } }
    }
    nloc = mine > 0u ? mine : 1u; nx = cnt > 0u ? cnt : 1u;
}
__device__ __forceinline__ void xcd_barrier(const XcdBarrier& b, int tid) {
    asm volatile("s_waitcnt vmcnt(0)" ::: "memory");
    __syncthreads();
    if (tid == 0) {
        unsigned* bar = b.bar;
        __builtin_amdgcn_s_waitcnt(0);
        unsigned nloc = b.st[0], nx = b.st[1];
        if (nloc == 0u) { xcd_barrier_complete(bar, b.x, nloc, nx); b.st[0] = nloc; b.st[1] = nx; }
        const unsigned old = xb_add(&bar[XB_XSUB(b.x)], 1u);
        const unsigned gen = old / nloc;
        if (old + 1u == (gen + 1u) * nloc) {
            __builtin_amdgcn_fence(__ATOMIC_RELEASE, "agent");
            asm volatile("s_waitcnt vmcnt(0)" ::: "memory");
            const unsigned og = xb_add(&bar[XB_TOP], 1u);
            const unsigned tg = og / nx;
            if (og + 1u == (tg + 1u) * nx) xb_add(&bar[XB_TOPGEN], 1u);
            else XB_SPIN(xb_ld(&bar[XB_TOPGEN]) == tg, bar);
            __builtin_amdgcn_fence(__ATOMIC_ACQUIRE, "agent");
            xb_add(&bar[XB_XGEN(b.x)], 1u);
            asm volatile("s_waitcnt vmcnt(0)" ::: "memory");
        } else {
            XB_SPIN(xb_ld(&bar[XB_XGEN(b.x)]) == gen, bar);
            __builtin_amdgcn_fence(__ATOMIC_ACQUIRE, "agent");
            asm volatile("s_waitcnt vmcnt(0)" ::: "memory");
        }
    }
    __syncthreads();
}

struct Args { const float* in[25]; float* out; unsigned char* ws; int ph_lo, ph_hi; };
struct Frame { LAS unsigned char* lds; int tid, lane, wave, vcu, G, gw, NGW, bx; };

__device__ __forceinline__ float wave_sum(float v, int lane) {
#pragma unroll
    for (int o = 1; o < 64; o <<= 1) v += shx(v, o, lane);
    return v;
}
__device__ __forceinline__ void transpose_item(const float* W, int ldw, int k0, int n0, bf16_t* WT, int ldt, int drow0, LAS float* scr, int lane) {
#pragma unroll 8
    for (int i = 0; i < 32; ++i) { const int kk = 2 * i + (lane >> 5); scr[kk * 33 + (lane & 31)] = W[(size_t)(k0 + kk) * ldw + n0 + (lane & 31)]; }
    asm volatile("s_waitcnt lgkmcnt(0)" ::: "memory");
    const int c = lane & 7;
#pragma unroll
    for (int j = 0; j < 4; ++j) { const int n = (lane >> 3) + 8 * j; const LAS float* s = scr + (8 * c) * 33 + n;
        u32x4 o; o.x = pk_bf16(s[0 * 33], s[1 * 33]); o.y = pk_bf16(s[2 * 33], s[3 * 33]); o.z = pk_bf16(s[4 * 33], s[5 * 33]); o.w = pk_bf16(s[6 * 33], s[7 * 33]);
        *(GAS u32x4*)(WT + (size_t)(drow0 + n) * ldt + k0 + 8 * c) = o; }
    asm volatile("s_waitcnt lgkmcnt(0)" ::: "memory");
}
__device__ __forceinline__ void transpose_mat_item(const float* W, int ldw, int K, int N, bf16_t* WT, int r, LAS float* scr, int lane) {
    const int nblk = N / 32, kb = r / nblk, nb = r % nblk; transpose_item(W, ldw, 64 * kb, 32 * nb, WT, K, 32 * nb, scr, lane);
}
__device__ __forceinline__ void norm_row(const float* xrow, const float* g, bf16_t* hb, float* xc, float* fo, int lane) {
    const GAS f32x4* xr = (const GAS f32x4*)xrow + lane; const GAS f32x4* gr = (const GAS f32x4*)g + lane;
    f32x4 v[4]; float s = 0.f;
#pragma unroll
    for (int j = 0; j < 4; ++j) { v[j] = xr[64 * j]; s += (v[j].x * v[j].x + v[j].y * v[j].y) + (v[j].z * v[j].z + v[j].w * v[j].w); }
    if (xc) {
#pragma unroll
        for (int j = 0; j < 4; ++j) ((GAS f32x4*)xc + lane)[64 * j] = v[j];
    }
    const float rstd = 1.0f / sqrtf(wave_sum(s, lane) * (1.f / D) + RMS_EPS);
#pragma unroll
    for (int j = 0; j < 4; ++j) { v[j] = v[j] * rstd * gr[64 * j]; }
    if (hb) { GAS u32x2* o8 = (GAS u32x2*)hb + lane;
#pragma unroll
        for (int j = 0; j < 4; ++j) { u32x2 w; w.x = pk_bf16(v[j].x, v[j].y); w.y = pk_bf16(v[j].z, v[j].w); o8[64 * j] = w; } }
    if (fo) {
#pragma unroll
        for (int j = 0; j < 4; ++j) ((GAS f32x4*)fo + lane)[64 * j] = v[j];
    }
}
__device__ __forceinline__ int up_dest_row(int n) { return n < FF ? 256 * (n >> 7) + (n & 127) : 256 * ((n - FF) >> 7) + 128 + ((n - FF) & 127); }

__device__ __forceinline__ void p0_prologue(const Frame& F, const Args& a) {
    LAS float* scr = (LAS float*)(F.lds + RING_OFF + F.wave * 16384);
    unsigned char* ws = a.ws;
    constexpr int I_QKV = 16 * 96, I_SQ = 16 * 32, I_POOL = 4 * 32, I_KV = 16 * 64, I_UP = 16 * 176, I_DN = 44 * 32, I_VS = 2 * DB * 4 * 32;
    constexpr int NIT = I_QKV + I_SQ + I_POOL + 2 * I_SQ + 2 * I_KV + 2 * I_SQ + 2 * I_UP + 2 * I_DN + I_VS;
    for (int it = F.gw; it < NIT; it += F.NGW) {
        int r = it;
        if (r < I_QKV) { transpose_mat_item(a.in[14], 3 * D, D, 3 * D, (bf16_t*)(ws + WS_WQKV), r, scr, F.lane); continue; } r -= I_QKV;
        if (r < I_SQ) { transpose_mat_item(a.in[15], D, D, D, (bf16_t*)(ws + WS_WO), r, scr, F.lane); continue; } r -= I_SQ;
        if (r < I_POOL) { const int g = r >> 5; transpose_mat_item(a.in[16] + (size_t)g * 65536, 256, 256, 256, (bf16_t*)(ws + WS_WPOOL) + (size_t)g * 65536, r & 31, scr, F.lane); continue; } r -= I_POOL;
        if (r < 2 * I_SQ) { const int l = r / I_SQ; transpose_mat_item(a.in[18] + (size_t)l * D * D, D, D, D, (bf16_t*)(ws + WS_WCAQ) + (size_t)l * D * D, r % I_SQ, scr, F.lane); continue; } r -= 2 * I_SQ;
        if (r < 2 * I_KV) { const int l = r / I_KV; transpose_mat_item(a.in[19] + (size_t)l * D * 2 * D, 2 * D, D, 2 * D, (bf16_t*)(ws + WS_WCAKV) + (size_t)l * 2 * D * D, r % I_KV, scr, F.lane); continue; } r -= 2 * I_KV;
        if (r < 2 * I_SQ) { const int l = r / I_SQ; transpose_mat_item(a.in[20] + (size_t)l * D * D, D, D, D, (bf16_t*)(ws + WS_WCAO) + (size_t)l * D * D, r % I_SQ, scr, F.lane); continue; } r -= 2 * I_SQ;
        if (r < 2 * I_UP) { const int l = r / I_UP, q = r % I_UP, kb = q / 176, nb = q % 176;
            transpose_item(a.in[21] + (size_t)l * D * FF2, FF2, 64 * kb, 32 * nb, (bf16_t*)(ws + WS_WUP) + (size_t)l * FF2 * D, D, up_dest_row(32 * nb), scr, F.lane); continue; } r -= 2 * I_UP;
        if (r < 2 * I_DN) { const int l = r / I_DN; transpose_mat_item(a.in[24] + (size_t)l * FF * D, D, FF, D, (bf16_t*)(ws + WS_WDN) + (size_t)l * D * FF, r % I_DN, scr, F.lane); continue; } r -= 2 * I_DN;
        { const int mat = r >> 5, lb = mat >> 2, h = mat & 3;
          transpose_mat_item(a.in[8] + (size_t)lb * NMEM * D + h * 256, D, 256, 256, (bf16_t*)(ws + WS_VMTS) + (size_t)(lb * 4 + h) * 65536, r & 31, scr, F.lane); }
    }
    { const GAS f32x4* src = (const GAS f32x4*)a.in[7]; GAS u32x4* dst = (GAS u32x4*)(ws + WS_KMS); const int n8 = 2 * DB * NMEM * D / 8;
      for (int i = F.bx * 512 + F.tid; i < n8; i += F.G * 512) { const f32x4 x = src[2 * i], y = src[2 * i + 1]; u32x4 w; w.x = pk_bf16(x[0], x[1]); w.y = pk_bf16(x[2], x[3]); w.z = pk_bf16(y[0], y[1]); w.w = pk_bf16(y[2], y[3]); dst[i] = w; } }
    for (int m = F.gw; m < 2 * NB * NMEM; m += F.NGW) { const int l = m / (NB * NMEM), r = m % (NB * NMEM);
        norm_row(a.in[2] + (size_t)r * D, a.in[11] + l * D, (bf16_t*)(ws + WS_MN) + (size_t)m * D, nullptr, nullptr, F.lane); }
    for (int m = F.gw; m < M; m += F.NGW) { const float* xr = m < MP ? a.in[0] + (size_t)m * D : a.in[1] + (size_t)(m - MP) * D;
        norm_row(xr, a.in[9], (bf16_t*)(ws + WS_HB) + (size_t)m * D, a.out + OUT_Y + (size_t)m * D, nullptr, F.lane); }
}
__device__ __forceinline__ void norm_phase(const Frame& F, const Args& a, const float* g, bool ps) {
    for (int m = F.gw; m < M; m += F.NGW) {
        float* fo = nullptr;
        if (ps) { if (m < MP) { const int t = m & (SEQ - 1); if (t >= SEQ - 15) fo = a.out + OUT_PSP + ((size_t)(m >> 12) * 15 + (t - (SEQ - 15))) * D; }
                  else { const int rs = m - MP, t = rs & (DSEQ - 1); if (t >= DSEQ - 15) fo = a.out + OUT_PSS + ((size_t)(rs >> 6) * 15 + (t - (DSEQ - 15))) * D; } }
        norm_row(a.out + OUT_Y + (size_t)m * D, g, (bf16_t*)(a.ws + WS_HB) + (size_t)m * D, nullptr, fo, F.lane);
    }
}
__device__ __forceinline__ void final_norm_phase(const Frame& F, const Args& a) {
    for (int m = F.gw; m < M; m += F.NGW) { float* xr = a.out + OUT_Y + (size_t)m * D; norm_row(xr, a.in[13], nullptr, nullptr, xr, F.lane); }
}
__device__ __forceinline__ void pool_phase(const Frame& F, const Args& a) {
    const bf16_t* HB = (const bf16_t*)(a.ws + WS_HB); bf16_t* PB = (bf16_t*)(a.ws + WS_QB);
    const int c0 = F.lane * 16, w = 2 << (F.lane >> 4);
    for (int m = F.gw; m < M; m += F.NGW) {
        const bool samp = m >= MP; const int t = samp ? ((m - MP) & (DSEQ - 1)) : (m & (SEQ - 1)); const int b = samp ? ((m - MP) >> 6) : 0;
        float acc[16], h0[16];
#pragma unroll
        for (int e = 0; e < 16; ++e) acc[e] = 0.f;
        for (int j = 0; j < 16; ++j) {
            if (j < w) {
                if (t - j >= 0) { const GAS u32x4* p = (const GAS u32x4*)(HB + (size_t)(m - j) * D + c0); const u32x4 x = p[0], y = p[1];
                    float v[16] = {bf_lo(x.x), bf_hi(x.x), bf_lo(x.y), bf_hi(x.y), bf_lo(x.z), bf_hi(x.z), bf_lo(x.w), bf_hi(x.w), bf_lo(y.x), bf_hi(y.x), bf_lo(y.y), bf_hi(y.y), bf_lo(y.z), bf_hi(y.z), bf_lo(y.w), bf_hi(y.w)};
#pragma unroll
                    for (int e = 0; e < 16; ++e) { acc[e] += v[e]; if (j == 0) h0[e] = v[e]; } }
                else if (samp) { const GAS f32x4* p = (const GAS f32x4*)(a.in[5] + ((size_t)b * 15 + (15 + t - j)) * D + c0);
#pragma unroll
                    for (int q = 0; q < 4; ++q) { const f32x4 x = p[q]; acc[4 * q] += x[0]; acc[4 * q + 1] += x[1]; acc[4 * q + 2] += x[2]; acc[4 * q + 3] += x[3]; } }
            }
        }
        const int pos = samp ? PAST + t : t; const float inv = 1.0f / (float)(pos + 1 < w ? pos + 1 : w);
        u32x4 o0, o1;
        o0.x = pk_bf16(acc[0] * inv - h0[0], acc[1] * inv - h0[1]); o0.y = pk_bf16(acc[2] * inv - h0[2], acc[3] * inv - h0[3]); o0.z = pk_bf16(acc[4] * inv - h0[4], acc[5] * inv - h0[5]); o0.w = pk_bf16(acc[6] * inv - h0[6], acc[7] * inv - h0[7]);
        o1.x = pk_bf16(acc[8] * inv - h0[8], acc[9] * inv - h0[9]); o1.y = pk_bf16(acc[10] * inv - h0[10], acc[11] * inv - h0[11]); o1.z = pk_bf16(acc[12] * inv - h0[12], acc[13] * inv - h0[13]); o1.w = pk_bf16(acc[14] * inv - h0[14], acc[15] * inv - h0[15]);
        GAS u32x4* op = (GAS u32x4*)(PB + (size_t)m * D + c0); op[0] = o0; op[1] = o1;
    }
}
__device__ __forceinline__ void gate_phase(const Frame& F, const Args& a, int layer, int chunk) {
    const bf16_t* UB = (const bf16_t*)(a.ws + WS_UB); bf16_t* A2 = (bf16_t*)(a.ws + WS_A2);
    const float* cw = a.in[22] + (size_t)layer * 3 * FF2; const float* cb = a.in[23] + (size_t)layer * FF2;
    const int nitems = (M / 32) * 176;
    for (int it = F.bx * 512 + F.tid; it < nitems; it += F.G * 512) {
        const int cg = it % 176, rc = it / 176, r0 = rc * 32;
        const int ch = chunk * 1408 + cg * 8, ucol = 256 * (cg >> 4) + (cg & 15) * 8;
        float wg[3][8], wv[3][8], bg[8], bv[8];
#pragma unroll
        for (int j = 0; j < 3; ++j)
#pragma unroll
            for (int e = 0; e < 8; ++e) { wg[j][e] = cw[(size_t)j * FF2 + ch + e]; wv[j][e] = cw[(size_t)j * FF2 + FF + ch + e]; }
#pragma unroll
        for (int e = 0; e < 8; ++e) { bg[e] = cb[ch + e]; bv[e] = cb[FF + ch + e]; }
        const bool samp = r0 >= MP; const int t0 = samp ? ((r0 - MP) & (DSEQ - 1)) : (r0 & (SEQ - 1));
        float g1[8], g2[8], v1[8], v2[8];
        if (t0 == 0) {
            if (samp) { const int b = (r0 - MP) >> 6; const float* sp = a.in[6] + ((size_t)(layer * DB + b) * 2) * FF2;
#pragma unroll
                for (int e = 0; e < 8; ++e) { g2[e] = sp[ch + e]; v2[e] = sp[FF + ch + e]; g1[e] = sp[FF2 + ch + e]; v1[e] = sp[FF2 + FF + ch + e]; } }
            else {
#pragma unroll
                for (int e = 0; e < 8; ++e) { g1[e] = g2[e] = v1[e] = v2[e] = 0.f; } }
        } else {
            const u32x4 a1 = *(const GAS u32x4*)(UB + (size_t)(r0 - 1) * FF + ucol), b1 = *(const GAS u32x4*)(UB + (size_t)(r0 - 1) * FF + ucol + 128);
            const u32x4 a2 = *(const GAS u32x4*)(UB + (size_t)(r0 - 2) * FF + ucol), b2 = *(const GAS u32x4*)(UB + (size_t)(r0 - 2) * FF + ucol + 128);
            g1[0] = bf_lo(a1.x); g1[1] = bf_hi(a1.x); g1[2] = bf_lo(a1.y); g1[3] = bf_hi(a1.y); g1[4] = bf_lo(a1.z); g1[5] = bf_hi(a1.z); g1[6] = bf_lo(a1.w); g1[7] = bf_hi(a1.w);
            v1[0] = bf_lo(b1.x); v1[1] = bf_hi(b1.x); v1[2] = bf_lo(b1.y); v1[3] = bf_hi(b1.y); v1[4] = bf_lo(b1.z); v1[5] = bf_hi(b1.z); v1[6] = bf_lo(b1.w); v1[7] = bf_hi(b1.w);
            g2[0] = bf_lo(a2.x); g2[1] = bf_hi(a2.x); g2[2] = bf_lo(a2.y); g2[3] = bf_hi(a2.y); g2[4] = bf_lo(a2.z); g2[5] = bf_hi(a2.z); g2[6] = bf_lo(a2.w); g2[7] = bf_hi(a2.w);
            v2[0] = bf_lo(b2.x); v2[1] = bf_hi(b2.x); v2[2] = bf_lo(b2.y); v2[3] = bf_hi(b2.y); v2[4] = bf_lo(b2.z); v2[5] = bf_hi(b2.z); v2[6] = bf_lo(b2.w); v2[7] = bf_hi(b2.w);
        }
        for (int i = 0; i < 32; ++i) {
            const int r = r0 + i;
            const u32x4 ua = *(const GAS u32x4*)(UB + (size_t)r * FF + ucol), ub = *(const GAS u32x4*)(UB + (size_t)r * FF + ucol + 128);
            float g0[8] = {bf_lo(ua.x), bf_hi(ua.x), bf_lo(ua.y), bf_hi(ua.y), bf_lo(ua.z), bf_hi(ua.z), bf_lo(ua.w), bf_hi(ua.w)};
            float v0[8] = {bf_lo(ub.x), bf_hi(ub.x), bf_lo(ub.y), bf_hi(ub.y), bf_lo(ub.z), bf_hi(ub.z), bf_lo(ub.w), bf_hi(ub.w)};
            float y[8];
#pragma unroll
            for (int e = 0; e < 8; ++e) { const float gg = bg[e] + wg[0][e] * g2[e] + wg[1][e] * g1[e] + wg[2][e] * g0[e]; const float vv = bv[e] + wv[0][e] * v2[e] + wv[1][e] * v1[e] + wv[2][e] * v0[e];
                y[e] = gg * vv / (1.f + __builtin_amdgcn_exp2f(-gg * LOG2E)); g2[e] = g1[e]; g1[e] = g0[e]; v2[e] = v1[e]; v1[e] = v0[e]; }
            u32x4 o; o.x = pk_bf16(y[0], y[1]); o.y = pk_bf16(y[2], y[3]); o.z = pk_bf16(y[4], y[5]); o.w = pk_bf16(y[6], y[7]);
            *(GAS u32x4*)(A2 + (size_t)r * FF + ch) = o;
        }
    }
}

extern __shared__ __attribute__((aligned(16))) unsigned char lds_raw[];
typedef __attribute__((address_space(4))) const Args CArgs;
__device__ __forceinline__ CArgs* kargs() { CArgs* k = (CArgs*)__builtin_amdgcn_kernarg_segment_ptr(); asm volatile("" : "+s"(k)); return k; }
__device__ __forceinline__ int elect_tid() {
    unsigned ones = ~0u; asm volatile("" : "+s"(ones));
    const int lane = (int)__builtin_amdgcn_mbcnt_hi(ones, __builtin_amdgcn_mbcnt_lo(ones, 0u));
    unsigned t = 0u;
    if (lane == 0) t = __hip_atomic_fetch_add((LAS unsigned*)((LAS unsigned char*)lds_raw + TICKET_OFF), 1u, __ATOMIC_RELAXED, __HIP_MEMORY_SCOPE_WORKGROUP);
    return (int)((__builtin_amdgcn_readfirstlane(t) & 7u) * 64u) + lane;
}
__device__ __forceinline__ Frame make_frame() {
    Frame F; F.lds = (LAS unsigned char*)lds_raw;
    const int tid = elect_tid(); __syncthreads();
    int bx = blockIdx.x, G = gridDim.x; asm volatile("" : "+s"(bx), "+s"(G));
    F.tid = tid; F.lane = F.tid & 63; F.wave = __builtin_amdgcn_readfirstlane(F.tid >> 6);
    F.G = G; F.bx = bx; F.vcu = (F.G % 8 == 0) ? (bx % 8) * (F.G / 8) + bx / 8 : bx;
    F.gw = F.vcu * NWAVES + F.wave; F.NGW = F.G * NWAVES; return F;
}
__device__ __forceinline__ Args load_args() { CArgs* k = kargs(); Args a;
#pragma unroll
    for (int i = 0; i < 25; ++i) a.in[i] = k->in[i];
    a.out = k->out; a.ws = k->ws; a.ph_lo = k->ph_lo; a.ph_hi = k->ph_hi; return a; }
#define PHASE static __device__ __forceinline__ void

PHASE ph_prologue() { const Frame F = make_frame(); const Args a = load_args(); p0_prologue(F, a); }
PHASE ph_qkv() {
    const Frame F = make_frame(); CArgs* k = kargs(); unsigned char* ws = k->ws;
    pg8::GemmP g{D, D, D}; pg8::SchedMN S{(const char*)(ws + WS_HB), (const char*)(ws + WS_WQKV), D, D, M / 256, 12, F.G, F.bx, 0};
    pg8::EpiQKV E{(bf16_t*)(ws + WS_QB), (size_t)(WS_KB - WS_QB) / 2, k->out, sba::QSCALE};
    pg8::gemm_phase(F.lds + RING_OFF, g, S, E, F.tid);
}
PHASE ph_memkv() {
    const Frame F = make_frame(); CArgs* k = kargs(); unsigned char* ws = k->ws; float* out = k->out; const int cblk = F.bx;
    for (int l = 0; l < 2; ++l) {
        { pg8::GemmP g{D, D, D}; pg8::SchedMN S{(const char*)(ws + WS_MN) + (size_t)l * NB * NMEM * D * 2, (const char*)(ws + WS_WCAKV) + (size_t)l * 2 * D * D * 2, D, D, 16, 4, F.G, (cblk + 128 * l) % F.G, 0};
          pg8::EpiMemK E{out + OUT_MKP + (size_t)l * NB * NMEM * D, (bf16_t*)(ws + WS_KMP) + (size_t)l * NB * NMEM * D};
          pg8::gemm_phase(F.lds + RING_OFF, g, S, E, F.tid); }
        { pg8::GemmP g{D, D, D}; pg8::SchedMN S{(const char*)(ws + WS_WCAKV) + ((size_t)l * 2 * D * D + (size_t)D * D) * 2, (const char*)(ws + WS_MN) + (size_t)l * NB * NMEM * D * 2, D, D, 4, 16, F.G, (cblk + 128 * l + 64) % F.G, 0};
          pg8::EpiMemVT E{out + OUT_MVP + (size_t)l * NB * NMEM * D, (bf16_t*)(ws + WS_VMTP) + (size_t)l * NB * NMEM * D};
          pg8::gemm_phase(F.lds + RING_OFF, g, S, E, F.tid); }
    }
}
PHASE ph_sbattn() {
    const Frame F = make_frame(); CArgs* k = kargs(); unsigned char* ws = k->ws;
    sba::Tensors T{(bf16_t*)(ws + WS_QB), (const bf16_t*)(ws + WS_KB), (const bf16_t*)(ws + WS_VB), k->in[3], k->in[4]};
    LAS char* vimg = (LAS char*)(F.lds + RING_OFF + F.wave * sba::WAVE_LDS);
    for (int id = F.gw; id < 32768 + 1024; id += F.NGW) sba::unit(id, T, vimg, F.lane);
}
PHASE ph_resid_gemm(int which_, int layer_) {
    const int which = __builtin_amdgcn_readfirstlane(which_), layer = __builtin_amdgcn_readfirstlane(layer_);
    const Frame F = make_frame(); CArgs* k = kargs(); unsigned char* ws = k->ws;
    const char* A; const char* W; int K;
    if (which == 0) { A = (const char*)(ws + WS_QB); W = (const char*)(ws + WS_WO); K = D; }
    else if (which == 1) { A = (const char*)(ws + WS_VB); W = (const char*)(ws + WS_WCAO) + (size_t)layer * D * D * 2; K = D; }
    else { A = (const char*)(ws + WS_A2); W = (const char*)(ws + WS_WDN) + (size_t)layer * D * FF * 2; K = FF; }
    pg8::GemmP g{K, K, K}; pg8::SchedMN S{A, W, K, K, M / 256, 4, F.G, F.bx, 0};
    pg8::EpiResid E{k->out + OUT_Y, nullptr};
    pg8::gemm_phase(F.lds + RING_OFF, g, S, E, F.tid);
}
PHASE ph_pool_gemm() {
    const Frame F = make_frame(); CArgs* k = kargs(); unsigned char* ws = k->ws;
    pg8::GemmP g{D, 256, 256}; pg8::SchedPool S{(const char*)(ws + WS_QB), (const char*)(ws + WS_WPOOL), F.G, F.bx};
    pg8::EpiResid E{k->out + OUT_Y, k->in[17]};
    pg8::gemm_phase(F.lds + RING_OFF, g, S, E, F.tid);
}
PHASE ph_norm(int which_, int layer_) {
    const int which = __builtin_amdgcn_readfirstlane(which_), layer = __builtin_amdgcn_readfirstlane(layer_);
    const Frame F = make_frame(); const Args a = load_args();
    if (which == 3) { final_norm_phase(F, a); return; }
    const float* g = (which == 0 ? a.in[9] : which == 1 ? a.in[10] : a.in[12]) + layer * D;
    norm_phase(F, a, g, which == 0);
}
PHASE ph_pool() { const Frame F = make_frame(); const Args a = load_args(); pool_phase(F, a); }
PHASE ph_caq(int layer_) {
    const int layer = __builtin_amdgcn_readfirstlane(layer_);
    const Frame F = make_frame(); CArgs* k = kargs(); unsigned char* ws = k->ws;
    pg8::GemmP g{D, D, D}; pg8::SchedMN S{(const char*)(ws + WS_HB), (const char*)(ws + WS_WCAQ) + (size_t)layer * D * D * 2, D, D, M / 256, 4, F.G, F.bx, 0};
    pg8::EpiBf16 E{(bf16_t*)(ws + WS_QB), D, 0.0625f * LOG2E};
    pg8::gemm_phase(F.lds + RING_OFF, g, S, E, F.tid);
}
PHASE ph_cascore(int layer_) {
    const int layer = __builtin_amdgcn_readfirstlane(layer_);
    const Frame F = make_frame(); CArgs* k = kargs(); unsigned char* ws = k->ws;
    pg8::GemmP g{D, D, 256}; pg8::SchedCA<0> S{(const char*)(ws + WS_QB), (const char*)(ws + WS_KMP) + (size_t)layer * NB * NMEM * D * 2, (const char*)(ws + WS_KMS) + (size_t)layer * DB * NMEM * D * 2, F.G, F.bx};
    pg8::EpiSoftmax E{(bf16_t*)(ws + WS_KB), XCH_OFF};
    pg8::gemm_phase(F.lds + RING_OFF, g, S, E, F.tid);
}
PHASE ph_capv(int layer_) {
    const int layer = __builtin_amdgcn_readfirstlane(layer_);
    const Frame F = make_frame(); CArgs* k = kargs(); unsigned char* ws = k->ws;
    pg8::GemmP g{D, 256, 256}; pg8::SchedCA<1> S{(const char*)(ws + WS_KB), (const char*)(ws + WS_VMTP) + (size_t)layer * NB * NMEM * D * 2, (const char*)(ws + WS_VMTS) + (size_t)layer * DB * NMEM * D * 2, F.G, F.bx};
    pg8::EpiBf16 E{(bf16_t*)(ws + WS_VB), D, 1.f};
    pg8::gemm_phase(F.lds + RING_OFF, g, S, E, F.tid);
}
PHASE ph_up(int layer_, int chunk_) {
    const int layer = __builtin_amdgcn_readfirstlane(layer_), chunk = __builtin_amdgcn_readfirstlane(chunk_);
    const Frame F = make_frame(); CArgs* k = kargs(); unsigned char* ws = k->ws; float* out = k->out;
    pg8::GemmP g{D, D, D}; pg8::SchedMN S{(const char*)(ws + WS_HB), (const char*)(ws + WS_WUP) + ((size_t)layer * FF2 + (size_t)chunk * FF) * D * 2, D, D, M / 256, 11, F.G, F.bx, 0};
    pg8::EpiUp E{(bf16_t*)(ws + WS_UB), FF, 11 * chunk, out + OUT_FSP + (size_t)layer * NB * 2 * FF2, out + OUT_FSS + (size_t)layer * DB * 2 * FF2};
    pg8::gemm_phase(F.lds + RING_OFF, g, S, E, F.tid);
}
PHASE ph_gate(int layer_, int chunk_) {
    const int layer = __builtin_amdgcn_readfirstlane(layer_), chunk = __builtin_amdgcn_readfirstlane(chunk_);
    const Frame F = make_frame(); const Args a = load_args(); gate_phase(F, a, layer, chunk);
}

constexpr int N_PHASES = 31;
__global__ void __launch_bounds__(NWAVES * 64, 2) trunk_fwd(Args args_unused) {
    CArgs* k = kargs();
    volatile LAS unsigned* MISC = (volatile LAS unsigned*)((LAS unsigned char*)lds_raw + MISC_OFF);
    { const int tid = elect_tid(); __syncthreads();
      if (tid < 32) MISC[tid] = 0u;
      __syncthreads();
      if (k->ph_hi - k->ph_lo > 1) (void)xcd_barrier_post((unsigned*)(k->ws + WS_CTL) + CW_BAR, MISC + 8, tid); }
#ifndef PHASE_MASK
#define PHASE_MASK 0xffffffffull
#endif
#define IN(p) ((((PHASE_MASK) >> (p)) & 1ull) && k->ph_lo <= (p) && (p) < k->ph_hi)
#define SEAM(p) do { if (IN(p) && IN((p) + 1)) { XcdBarrier bar; bar.bar = (unsigned*)(k->ws + WS_CTL) + CW_BAR; bar.x = xb_xcc_id(); bar.st = MISC + 8; xcd_barrier(bar, elect_tid()); } } while (0)
    if (IN(0)) ph_prologue(); SEAM(0);
    if (IN(1)) ph_qkv(); SEAM(1);
    if (IN(2)) ph_memkv(); SEAM(2);
    if (IN(3)) ph_sbattn(); SEAM(3);
    if (IN(4)) ph_resid_gemm(0, 0); SEAM(4);
    for (int layer = 0; layer < 2; ++layer) {
        const int pb = 5 + 14 * layer;
        if (layer == 1) {
            if (IN(16)) ph_norm(0, 1); SEAM(16);
            if (IN(17)) ph_pool(); SEAM(17);
            if (IN(18)) ph_pool_gemm(); SEAM(18);
        }
        if (IN(pb + 0)) ph_norm(1, layer); SEAM(pb + 0);
        if (IN(pb + 1)) ph_caq(layer); SEAM(pb + 1);
        if (IN(pb + 2)) ph_cascore(layer); SEAM(pb + 2);
        if (IN(pb + 3)) ph_capv(layer); SEAM(pb + 3);
        if (IN(pb + 4)) ph_resid_gemm(1, layer); SEAM(pb + 4);
        if (IN(pb + 5)) ph_norm(2, layer); SEAM(pb + 5);
        for (int chunk = 0; chunk < 2; ++chunk) {
            if (IN(pb + 6 + 2 * chunk)) ph_up(layer, chunk); SEAM(pb + 6 + 2 * chunk);
            if (IN(pb + 7 + 2 * chunk)) ph_gate(layer, chunk); SEAM(pb + 7 + 2 * chunk);
        }
        if (IN(pb + 10)) ph_resid_gemm(2, layer); SEAM(pb + 10);
    }
    if (IN(30)) ph_norm(3, 0);
#undef IN
#undef SEAM
}

extern "C" void kernel_launch(void* const* d_in, const int* in_sizes, int n_in, void* d_out, int out_size, void* d_ws, size_t ws_size, hipStream_t stream) {
    static int grid = 0;
    if (grid == 0) {
        if (n_in != 25 || (size_t)out_size != OUT_TOTAL || ws_size < WS_END) { fprintf(stderr, "kernel_launch: unexpected shapes: n_in %d out %d ws %zu\n", n_in, out_size, ws_size); grid = -1; return; }
        int dev = 0, cus = 0;
        if (hipGetDevice(&dev) != hipSuccess || hipDeviceGetAttribute(&cus, hipDeviceAttributeMultiprocessorCount, dev) != hipSuccess) { grid = -1; return; }
        if (hipFuncSetAttribute((const void*)trunk_fwd, hipFuncAttributeMaxDynamicSharedMemorySize, LDS_BYTES) != hipSuccess) { fprintf(stderr, "kernel_launch: hipFuncSetAttribute failed\n"); grid = -1; return; }
        int per_cu = 0;
        if (hipOccupancyMaxActiveBlocksPerMultiprocessor(&per_cu, (const void*)trunk_fwd, NWAVES * 64, LDS_BYTES) != hipSuccess || per_cu < 1) fprintf(stderr, "kernel_launch: occupancy query reports %d\n", per_cu);
        (void)hipGetLastError();
        grid = cus;
    }
    if (grid < 0) return;
    (void)hipMemsetAsync((char*)d_ws + WS_CTL, 0, CTL_ZERO_BYTES, stream);
    Args a{};
    for (int i = 0; i < 25; ++i) a.in[i] = (const float*)d_in[i];
    a.out = (float*)d_out; a.ws = (unsigned char*)d_ws;
#if MK_ONE_LAUNCH
    a.ph_lo = 0; a.ph_hi = N_PHASES;
    hipLaunchKernelGGL(trunk_fwd, dim3(grid), dim3(NWAVES * 64), LDS_BYTES, stream, a);
#else
    for (int p = 0; p < N_PHASES; ++p) { a.ph_lo = p; a.ph_hi = p + 1; hipLaunchKernelGGL(trunk_fwd, dim3(grid), dim3(NWAVES * 64), LDS_BYTES, stream, a); }
#endif
}
```

```cpp
#include <hip/hip_runtime.h>
#include <cstdio>
#include <cstdint>

#ifndef MK_ONE_LAUNCH
#define MK_ONE_LAUNCH 1
#endif

#define GAS __attribute__((address_space(1)))
#define LAS __attribute__((address_space(3)))
typedef unsigned short bf16_t;
typedef short bf16x8 __attribute__((ext_vector_type(8)));
typedef short s16x4 __attribute__((ext_vector_type(4)));
typedef float f32x4 __attribute__((ext_vector_type(4)));
typedef float f32x16 __attribute__((ext_vector_type(16)));
typedef unsigned u32x4 __attribute__((ext_vector_type(4)));
typedef unsigned u32x2 __attribute__((ext_vector_type(2)));
typedef float f32x2_t __attribute__((ext_vector_type(2)));
typedef __bf16 bf16x2_t __attribute__((ext_vector_type(2)));
typedef GAS unsigned gu32;

__device__ __forceinline__ unsigned pk_bf16(float lo, float hi) { f32x2_t v = {lo, hi}; bf16x2_t b = __builtin_convertvector(v, bf16x2_t); return __builtin_bit_cast(unsigned, b); }
__device__ __forceinline__ float shx(float v, int mask, int lane) { return __int_as_float(__builtin_amdgcn_ds_bpermute((lane ^ mask) << 2, __float_as_int(v))); }
__device__ __forceinline__ float bf_lo(unsigned u) { return __uint_as_float(u << 16); }
__device__ __forceinline__ float bf_hi(unsigned u) { return __uint_as_float(u & 0xffff0000u); }

constexpr int D = 1024, MP = 65536, MS = 2048, M = MP + MS;
constexpr int SEQ = 4096, NB = 16, DB = 32, DSEQ = 64, PAST = 2048;
constexpr int FF = 2816, FF2 = 5632, NMEM = 256;
constexpr float RMS_EPS = 1e-6f;
constexpr float LOG2E = 1.4426950408889634f;
constexpr size_t OUT_Y = 0, OUT_KP = (size_t)M * D, OUT_VP = OUT_KP + (size_t)MP * D, OUT_KS = OUT_VP + (size_t)MP * D, OUT_VS = OUT_KS + (size_t)MS * D;
constexpr size_t OUT_PSP = OUT_VS + (size_t)MS * D, OUT_PSS = OUT_PSP + (size_t)NB * 15 * D, OUT_FSP = OUT_PSS + (size_t)DB * 15 * D;
constexpr size_t OUT_FSS = OUT_FSP + (size_t)2 * NB * 2 * FF2, OUT_MKP = OUT_FSS + (size_t)2 * DB * 2 * FF2, OUT_MVP = OUT_MKP + (size_t)2 * NB * NMEM * D;
constexpr size_t OUT_TOTAL = OUT_MVP + (size_t)2 * NB * NMEM * D;
static_assert(OUT_TOTAL == 226213888ull, "output size");
constexpr size_t MiB = 1u << 20;
constexpr size_t WS_CTL = 0, CTL_ZERO_BYTES = 1 * MiB;
constexpr size_t WS_WQKV = 2 * MiB, WS_WO = 8 * MiB, WS_WPOOL = 10 * MiB, WS_WCAQ = 11 * MiB, WS_WCAKV = 15 * MiB, WS_WCAO = 23 * MiB, WS_WUP = 27 * MiB, WS_WDN = 49 * MiB;
constexpr size_t WS_MN = 60 * MiB, WS_KMP = 76 * MiB, WS_VMTP = 92 * MiB, WS_KMS = 108 * MiB, WS_VMTS = 140 * MiB;
constexpr size_t WS_HB = 172 * MiB, WS_QB = 304 * MiB, WS_KB = 436 * MiB, WS_VB = 568 * MiB;
constexpr size_t WS_A2 = 304 * MiB, WS_EDGE = 700 * MiB, WS_FIRST = 712 * MiB, WS_OB = 724 * MiB, WS_SS = 856 * MiB, WS_VW1 = 858 * MiB, WS_END = 954 * MiB, WS_PART = WS_OB;
static_assert(WS_A2 + (size_t)M * FF * 2 <= WS_EDGE && WS_EDGE + (size_t)(M / 256) * 2 * FF2 * 4 <= WS_FIRST && WS_FIRST + (size_t)(M / 256) * 2 * FF2 * 4 <= WS_OB && WS_OB + (size_t)M * D * 2 <= WS_SS && WS_SS + (size_t)7 * M * 4 <= WS_END && WS_HB + (size_t)M * D * 2 <= WS_QB && WS_VB + (size_t)M * D * 2 <= WS_EDGE, "ws map");
constexpr int CW_BAR = 4096;

namespace pg8 {
constexpr int BM = 256, BK = 64, HALF = 128, HTB = HALF * BK * 2, STAGE_BYTES = 8 * HTB, NXCD = 8, WGM = 8;
__host__ __device__ __forceinline__ int lds_byte(int r, int c) { const int st = (r >> 4) * 2 + (c >> 5), rr = r & 15, cc = c & 31, ob = rr * 64 + cc * 2; return st * 1024 + (ob ^ (((ob >> 9) & 1) << 5)); }
__host__ __device__ __forceinline__ void stage_rc(int b, int& R, int& C) { const int st = b / 1024, sb = b % 1024, swz = sb ^ (((sb >> 9) & 1) << 5); R = (st >> 1) * 16 + swz / 64; C = (st & 1) * 32 + (swz % 64) / 2; }
__host__ __device__ __forceinline__ int perm32(int rho) { const int n = rho >> 4, i = rho & 15; return 8 * (i >> 2) + 4 * n + (i & 3); }

struct Unit { const char* a; const char* b; int row0, col0, vlo, vhi, aux; };
struct GemmP { int lda, ldb, K; };

__device__ __forceinline__ bool tile_of(long L, int nM, int nN, int& pm, int& pn) {
    const int nwg = nM * nN; if (L >= nwg) return false;
    int wgid = (int)L; { const int q = nwg / NXCD, r = nwg % NXCD, xcd = wgid % NXCD, off = wgid / NXCD; wgid = (xcd < r ? xcd * (q + 1) : r * (q + 1) + (xcd - r) * q) + off; }
    const int nig = WGM * nN, gid = wgid / nig, fm = gid * WGM, gsz = (nM - fm) < WGM ? (nM - fm) : WGM;
    pm = fm + ((wgid % nig) % gsz); pn = (wgid % nig) / gsz; return true;
}

template <class Epi, class Sched>
__device__ __forceinline__ void gemm_phase(LAS unsigned char* lds, const GemmP g, const Sched& S, const Epi& E, int tid) {
    const int wid = __builtin_amdgcn_readfirstlane(tid >> 6), lane = tid & 63, wr = wid >> 2, wc = wid & 3, fr = lane & 15, fq = lane >> 4;
    const int K = g.K, nt = K / BK;
    unsigned voffA[2], voffB[2];
#pragma unroll
    for (int i = 0; i < 2; ++i) { int R, C; stage_rc(tid * 16 + i * 8192, R, C); const int Rb = (R & ~31) + perm32(R & 31);
        voffA[i] = (unsigned)(R * g.lda + C) * 2u; voffB[i] = (unsigned)(Rb * g.ldb + C) * 2u; }
    const size_t kstep = (size_t)(BK * 2);
    const size_t hstepA = (size_t)HALF * g.lda * 2, hstepB = (size_t)HALF * g.ldb * 2;
    const unsigned ldsw = (unsigned)wid * 1024u;
    const int aoff = lds_byte(wr * 64 + fr, fq * 8), boff = lds_byte(wc * 32 + fr, fq * 8);
#define PG8_SA(b, h) (((b) * 2 + (h)) * HTB)
#define PG8_SB(b, h) ((4 + (b) * 2 + (h)) * HTB)
#define PG8_STAGE(bufoff, gbase, voff) do { _Pragma("unroll") for (int _i = 0; _i < 2; ++_i) \
        __builtin_amdgcn_global_load_lds((const unsigned*)((const char*)(gbase) + (voff)[_i]), (LAS unsigned*)(lds + (bufoff) + ldsw + _i * 8192), 16, 0, 0); } while (0)
#define PG8_LDA(dst, b, h) do { _Pragma("unroll") for (int m = 0; m < 4; ++m) _Pragma("unroll") for (int k = 0; k < 2; ++k) dst[m][k] = *(const LAS bf16x8*)(lds + PG8_SA(b, h) + aoff + m * 2048 + k * 1024); } while (0)
#define PG8_LDB(dst, b, h) do { _Pragma("unroll") for (int n = 0; n < 2; ++n) _Pragma("unroll") for (int k = 0; k < 2; ++k) dst[n][k] = *(const LAS bf16x8*)(lds + PG8_SB(b, h) + boff + n * 2048 + k * 1024); } while (0)
#define PG8_MMA(ai, bj, At, Bt) do { __builtin_amdgcn_s_setprio(1); _Pragma("unroll") for (int m = 0; m < 4; ++m) _Pragma("unroll") for (int n = 0; n < 2; ++n) _Pragma("unroll") for (int k = 0; k < 2; ++k) \
        acc[ai][bj][m][n] = __builtin_amdgcn_mfma_f32_16x16x32_bf16(Bt[n][k], At[m][k], acc[ai][bj][m][n], 0, 0, 0); __builtin_amdgcn_s_setprio(0); } while (0)
#define PG8_WAIT_V(n) asm volatile("s_waitcnt vmcnt(" #n ")" ::: "memory")
#define PG8_WAIT_L(n) asm volatile("s_waitcnt lgkmcnt(" #n ")" ::: "memory")
#define PG8_BAR __builtin_amdgcn_s_barrier()
#define PG8_SCHED __builtin_amdgcn_sched_barrier(0)
    Unit cur, nxt; int ui = 0;
    if (!S.next(0, cur)) return;
    f32x4 acc[2][2][4][2];
#pragma unroll
    for (int a = 0; a < 2; ++a)
#pragma unroll
        for (int b = 0; b < 2; ++b)
#pragma unroll
            for (int m = 0; m < 4; ++m)
#pragma unroll
                for (int n = 0; n < 2; ++n) acc[a][b][m][n] = (f32x4){0.f, 0.f, 0.f, 0.f};
    bf16x8 At[4][2], B0[2][2], B1[2][2];
    const char* cA = cur.a; const char* cB = cur.b;
    bool lv0 = true, lv1 = true;
#define PG8_LIVE() do { if (Sched::MASKED) { const int r_ = cur.row0 + wr * 64; lv0 = r_ < cur.vhi && r_ + 64 > cur.vlo; lv1 = r_ + HALF < cur.vhi && r_ + HALF + 64 > cur.vlo; } } while (0)
    PG8_LIVE();
    PG8_STAGE(PG8_SB(0, 0), cB, voffB); PG8_STAGE(PG8_SB(0, 1), cB + hstepB, voffB); PG8_STAGE(PG8_SA(0, 0), cA, voffA); PG8_STAGE(PG8_SA(0, 1), cA + hstepA, voffA);
    if (wr == 1) PG8_BAR;
    PG8_WAIT_V(2); PG8_BAR;
    PG8_STAGE(PG8_SB(1, 0), cB + kstep, voffB); PG8_STAGE(PG8_SA(1, 0), cA + kstep, voffA); PG8_STAGE(PG8_SB(1, 1), cB + hstepB + kstep, voffB);
    PG8_WAIT_V(6); PG8_BAR;
    for (;;) {
        const bool has_next = S.next(ui + 1, nxt);
        const char* nA = has_next ? nxt.a : cA; const char* nB = has_next ? nxt.b : cB;
        for (int t = 0; t < nt; t += 2) {
            const bool last = (t == nt - 2);
            const char* a1 = cA + (size_t)(t + 1) * kstep;
            const char* a2 = last ? nA : cA + (size_t)(t + 2) * kstep; const char* b2 = last ? nB : cB + (size_t)(t + 2) * kstep;
            const char* a3 = a2 + kstep; const char* b3 = b2 + kstep;
            if (lv0 || lv1) { PG8_LDB(B0, 0, 0); PG8_LDB(B1, 0, 1); } PG8_SCHED; if (lv0) PG8_LDA(At, 0, 0); PG8_STAGE(PG8_SA(1, 1), a1 + hstepA, voffA);
            PG8_WAIT_V(8); PG8_WAIT_L(0); PG8_BAR; if (lv0) { PG8_MMA(0, 0, At, B0); PG8_MMA(0, 1, At, B1); } PG8_BAR; PG8_SCHED;
            if (lv1) PG8_LDA(At, 0, 1); PG8_STAGE(PG8_SB(0, 0), b2, voffB); PG8_STAGE(PG8_SB(0, 1), b2 + hstepB, voffB); PG8_STAGE(PG8_SA(0, 0), a2, voffA);
            PG8_WAIT_V(8); PG8_WAIT_L(0); PG8_BAR; if (lv1) { PG8_MMA(1, 0, At, B0); PG8_MMA(1, 1, At, B1); } PG8_BAR; PG8_SCHED;
            if (lv0 || lv1) { PG8_LDB(B0, 1, 0); PG8_LDB(B1, 1, 1); } PG8_SCHED; if (lv0) PG8_LDA(At, 1, 0); PG8_STAGE(PG8_SA(0, 1), a2 + hstepA, voffA);
            PG8_WAIT_V(8); PG8_WAIT_L(0); PG8_BAR; if (lv0) { PG8_MMA(0, 0, At, B0); PG8_MMA(0, 1, At, B1); } PG8_BAR; PG8_SCHED;
            if (lv1) PG8_LDA(At, 1, 1); PG8_STAGE(PG8_SB(1, 0), b3, voffB); PG8_STAGE(PG8_SB(1, 1), b3 + hstepB, voffB); PG8_STAGE(PG8_SA(1, 0), a3, voffA);
            PG8_WAIT_V(8); PG8_WAIT_L(0); PG8_BAR; if (lv1) { PG8_MMA(1, 0, At, B0); PG8_MMA(1, 1, At, B1); } PG8_BAR; PG8_SCHED;
        }
        if (wr == 0) PG8_BAR;
        { unsigned ones = ~0u; asm volatile("" : "+s"(ones));
          const int ln = (int)__builtin_amdgcn_mbcnt_hi(ones, __builtin_amdgcn_mbcnt_lo(ones, 0u));
          E(acc, cur, wr, wc, ln & 15, ln >> 4, lds); }
        if (!has_next) break;
#pragma unroll
        for (int a = 0; a < 2; ++a)
#pragma unroll
            for (int b = 0; b < 2; ++b)
#pragma unroll
                for (int m = 0; m < 4; ++m)
#pragma unroll
                    for (int n = 0; n < 2; ++n) acc[a][b][m][n] = (f32x4){0.f, 0.f, 0.f, 0.f};
        cur = nxt; cA = nA; cB = nB; ++ui; PG8_LIVE();
        if (wr == 1) PG8_BAR;
    }
    PG8_WAIT_V(0);
    PG8_BAR;
#undef PG8_LIVE
#undef PG8_SA
#undef PG8_SB
#undef PG8_STAGE
#undef PG8_LDA
#undef PG8_LDB
#undef PG8_MMA
#undef PG8_WAIT_V
#undef PG8_WAIT_L
#undef PG8_BAR
#undef PG8_SCHED
}

struct SchedMN {
    static constexpr bool MASKED = false;
    const char* A; const char* Bt; int lda, ldb, nM, nN, G, c, col_base;
    __device__ __forceinline__ bool next(int i, Unit& u) const {
        int pm, pn; if (!tile_of((long)i * G + c, nM, nN, pm, pn)) return false;
        u.a = A + (size_t)pm * BM * lda * 2; u.b = Bt + (size_t)pn * BM * ldb * 2; u.row0 = pm * BM; u.col0 = col_base + pn * BM; u.vlo = 0; u.vhi = 0x7fffffff; u.aux = pn; return true;
    }
};
struct SchedWKVW {
    static constexpr bool MASKED = false;
    const char* KMP; const char* KMS; const char* VMP; const char* VMS; const char* WQN; const char* WOT; int G, c, VW_ROW0;
    __device__ __forceinline__ bool next(int i, Unit& u) const {
        const int L = i * G + c; if (c < 0 || L >= 1536) return false;
        const int q = L < 768 ? L : L - 768, bb = q >> 4, h = (q >> 2) & 3, ch = q & 3;
        u.vlo = 0; u.vhi = 0x7fffffff; u.aux = 0; u.col0 = L < 768 ? ch * 256 : h * 256;
        if (L < 768) { const char* Km = bb < NB ? KMP + (size_t)bb * NMEM * D * 2 : KMS + (size_t)(bb - NB) * NMEM * D * 2;
            u.a = Km + h * 256 * 2; u.b = WQN + ((size_t)ch * 256 * D + h * 256) * 2; u.row0 = (bb * 4 + h) * 256; }
        else { const char* Vm = bb < NB ? VMP + (size_t)bb * NMEM * D * 2 : VMS + (size_t)(bb - NB) * NMEM * D * 2;
            u.a = WOT + ((size_t)ch * 256 * D + h * 256) * 2; u.b = Vm + h * 256 * 2; u.row0 = VW_ROW0 + bb * 1024 + ch * 256; }
        return true;
    }
};
template <int MODE> struct SchedCA2 {
    static constexpr bool MASKED = MODE == 0;
    const char* A; const char* W; int G, c, VW_ROW0;
    __device__ __forceinline__ bool next(int i, Unit& u) const {
        const int L = i * G + c; if (L >= 1024 + 128) return false;
        int row0, bb, hp;
        if (L < 1024) { const int pm = L >> 2; hp = L & 3; row0 = pm * BM; bb = pm >> 4; u.vlo = 0; u.vhi = 0x7fffffff; }
        else { const int s = L - 1024, b = s >> 2; hp = s & 3; const int r = MP + DSEQ * b; row0 = r < M - BM ? r : M - BM; bb = NB + b; u.vlo = r; u.vhi = r + DSEQ; }
        u.a = A + (size_t)row0 * D * 2;
        u.b = W + (MODE == 0 ? (size_t)((bb * 4 + hp) * 256) : (size_t)(VW_ROW0 + bb * 1024 + hp * 256)) * D * 2;
        u.row0 = row0; u.col0 = hp * 256; u.aux = 0; return true;
    }
};

#define EPI_ARGS f32x4 (&acc)[2][2][4][2], const Unit& u, int wr, int wc, int fr, int fq, LAS unsigned char* lds
struct EpiBf16 {
    bf16_t* O; int ldc; float scale; const float* ss;
    __device__ __forceinline__ void operator()(EPI_ARGS) const {
        const int row0 = u.row0 + wr * 64 + fr, col0 = u.col0 + wc * 32 + 8 * fq;
#pragma unroll
        for (int ai = 0; ai < 2; ++ai)
#pragma unroll
            for (int m = 0; m < 4; ++m) { const int row = row0 + ai * HALF + m * 16; bf16_t* rowp = O + (size_t)row * ldc + col0;
                const float rs = ss ? scale * __builtin_amdgcn_rsqf(ss[row] * (1.f / D) + RMS_EPS) : scale;
                if (row >= u.vlo && row < u.vhi) {
#pragma unroll
                for (int bj = 0; bj < 2; ++bj) { const f32x4 v0 = acc[ai][bj][m][0] * rs, v1 = acc[ai][bj][m][1] * rs;
                    u32x4 w; w.x = pk_bf16(v0[0], v0[1]); w.y = pk_bf16(v0[2], v0[3]); w.z = pk_bf16(v1[0], v1[1]); w.w = pk_bf16(v1[2], v1[3]);
                    *(u32x4*)(rowp + bj * HALF) = w; } } }
    }
};
struct SchedSplitK {
    static constexpr bool MASKED = false;
    const char* A; const char* Bt; int G, c;
    __device__ __forceinline__ bool next(int i, Unit& u) const {
        const int L = i * G + c; if (L >= 352) return false;
        const int part = L >> 5, t = L & 31, pm = t >> 2, pn = t & 3;
        u.a = A + ((size_t)(MP + pm * BM) * FF + part * 256) * 2; u.b = Bt + ((size_t)(pn * BM) * FF + part * 256) * 2;
        u.row0 = part * MS + pm * BM; u.col0 = pn * BM; u.vlo = 0; u.vhi = 0x7fffffff; u.aux = part; return true;
    }
};
struct EpiQKV {
    bf16_t* Qb; size_t bstride; float* out; float qscale; const float* ss;
    __device__ __forceinline__ void operator()(EPI_ARGS) const {
        const int typ = u.aux >> 2, colt = (u.aux & 3) * BM + wc * 32 + 8 * fq, row0 = u.row0 + wr * 64 + fr;
        bf16_t* B = Qb + (size_t)typ * bstride;
        const bool samp = u.row0 >= MP;
        float* F = typ == 1 ? (samp ? out + OUT_KS - (size_t)MP * D : out + OUT_KP) : (samp ? out + OUT_VS - (size_t)MP * D : out + OUT_VP);
        const float sc = typ == 0 ? qscale : 1.f;
#pragma unroll
        for (int ai = 0; ai < 2; ++ai)
#pragma unroll
            for (int m = 0; m < 4; ++m) { const size_t off = (size_t)(row0 + ai * HALF + m * 16) * D + colt;
                const float rs = __builtin_amdgcn_rsqf(ss[row0 + ai * HALF + m * 16] * (1.f / D) + RMS_EPS);
#pragma unroll
                for (int bj = 0; bj < 2; ++bj) { const f32x4 v0 = acc[ai][bj][m][0] * rs, v1 = acc[ai][bj][m][1] * rs;
                    if (typ != 0) { *(f32x4*)(F + off + bj * HALF) = v0; *(f32x4*)(F + off + bj * HALF + 4) = v1; }
                    u32x4 w; w.x = pk_bf16(v0[0] * sc, v0[1] * sc); w.y = pk_bf16(v0[2] * sc, v0[3] * sc); w.z = pk_bf16(v1[0] * sc, v1[1] * sc); w.w = pk_bf16(v1[2] * sc, v1[3] * sc);
                    *(u32x4*)(B + off + bj * HALF) = w; } }
    }
};
template <bool SC> struct EpiResid {
    bf16_t* XB; float* ssn; const float* cscale; float alpha;
    __device__ __forceinline__ void operator()(EPI_ARGS) const {
        const int row0 = u.row0 + wr * 64 + fr, col0 = u.col0 + wc * 32 + 8 * fq;
        GAS bf16_t* base = (GAS bf16_t*)XB + (size_t)row0 * D + col0;
        u32x4 xo[2][4][2];
#pragma unroll
        for (int ai = 0; ai < 2; ++ai)
#pragma unroll
            for (int m = 0; m < 4; ++m)
#pragma unroll
                for (int bj = 0; bj < 2; ++bj) xo[ai][m][bj] = *(GAS u32x4*)(base + (size_t)(ai * HALF + m * 16) * D + bj * HALF);
        float q[2][4];
#pragma unroll
        for (int ai = 0; ai < 2; ++ai)
#pragma unroll
            for (int m = 0; m < 4; ++m) q[ai][m] = 0.f;
#pragma unroll
        for (int bj = 0; bj < 2; ++bj) {
            const float al = alpha; const f32x4 ones = {1.f, 1.f, 1.f, 1.f};
            const f32x4 sc0 = (SC ? *(const GAS f32x4*)(cscale + col0 + bj * HALF) : ones) * al, sc1 = (SC ? *(const GAS f32x4*)(cscale + col0 + bj * HALF + 4) : ones) * al;
#pragma unroll
            for (int ai = 0; ai < 2; ++ai)
#pragma unroll
                for (int m = 0; m < 4; ++m) { const u32x4 o = xo[ai][m][bj]; const f32x4 d0 = acc[ai][bj][m][0] * sc0, d1 = acc[ai][bj][m][1] * sc1;
                    u32x4 w; w.x = pk_bf16(bf_lo(o.x) + d0[0], bf_hi(o.x) + d0[1]); w.y = pk_bf16(bf_lo(o.y) + d0[2], bf_hi(o.y) + d0[3]); w.z = pk_bf16(bf_lo(o.z) + d1[0], bf_hi(o.z) + d1[1]); w.w = pk_bf16(bf_lo(o.w) + d1[2], bf_hi(o.w) + d1[3]);
                    const int row = row0 + ai * HALF + m * 16;
                    if (row >= u.vlo && row < u.vhi) *(GAS u32x4*)(base + (size_t)(ai * HALF + m * 16) * D + bj * HALF) = w;
                    q[ai][m] += (bf_lo(w.x) * bf_lo(w.x) + bf_hi(w.x) * bf_hi(w.x)) + (bf_lo(w.y) * bf_lo(w.y) + bf_hi(w.y) * bf_hi(w.y)) + (bf_lo(w.z) * bf_lo(w.z) + bf_hi(w.z) * bf_hi(w.z)) + (bf_lo(w.w) * bf_lo(w.w) + bf_hi(w.w) * bf_hi(w.w)); }
        }
#pragma unroll
        for (int ai = 0; ai < 2; ++ai)
#pragma unroll
            for (int m = 0; m < 4; ++m) { float t = q[ai][m]; t += shx(t, 16, fq * 16 + fr); t += shx(t, 32, fq * 16 + fr);
                const int row = row0 + ai * HALF + m * 16;
                if (fq == 0 && alpha != 0.f && row >= u.vlo && row < u.vhi) __builtin_amdgcn_global_atomic_fadd_f32((GAS float*)ssn + row, t); }
    }
};
struct EpiMemK {
    float* F; bf16_t* B;
    __device__ __forceinline__ void operator()(EPI_ARGS) const {
        const int row0 = u.row0 + wr * 64 + fr, col0 = u.col0 + wc * 32 + 8 * fq;
#pragma unroll
        for (int ai = 0; ai < 2; ++ai)
#pragma unroll
            for (int m = 0; m < 4; ++m) { const size_t off = (size_t)(row0 + ai * HALF + m * 16) * D + col0;
#pragma unroll
                for (int bj = 0; bj < 2; ++bj) { const f32x4 v0 = acc[ai][bj][m][0], v1 = acc[ai][bj][m][1];
                    *(f32x4*)(F + off + bj * HALF) = v0; *(f32x4*)(F + off + bj * HALF + 4) = v1;
                    u32x4 w; w.x = pk_bf16(v0[0], v0[1]); w.y = pk_bf16(v0[2], v0[3]); w.z = pk_bf16(v1[0], v1[1]); w.w = pk_bf16(v1[2], v1[3]);
                    *(u32x4*)(B + off + bj * HALF) = w; } }
    }
};
__device__ __forceinline__ float dpp_ror1(float v) { return __int_as_float(__builtin_amdgcn_update_dpp(0, __float_as_int(v), 0x121, 0xf, 0xf, false)); }
__device__ __forceinline__ float dpp_ror2(float v) { return __int_as_float(__builtin_amdgcn_update_dpp(0, __float_as_int(v), 0x122, 0xf, 0xf, false)); }
__device__ __forceinline__ f32x4 ror1(const f32x4 v) { return (f32x4){dpp_ror1(v[0]), dpp_ror1(v[1]), dpp_ror1(v[2]), dpp_ror1(v[3])}; }
__device__ __forceinline__ f32x4 ror2(const f32x4 v) { return (f32x4){dpp_ror2(v[0]), dpp_ror2(v[1]), dpp_ror2(v[2]), dpp_ror2(v[3])}; }
__device__ __forceinline__ f32x4 sel4(bool c, const f32x4 a, const f32x4 b) { return (f32x4){c ? a[0] : b[0], c ? a[1] : b[1], c ? a[2] : b[2], c ? a[3] : b[3]}; }
struct EpiUpGate {
    bf16_t* A2; const float* cw; const float* cb; const float* sfs; float* fsp; float* fss; float* edge; float* first; int xoff; const float* ss;
    __device__ __forceinline__ void operator()(EPI_ARGS) const {
#pragma unroll
        for (int ai = 0; ai < 2; ++ai)
#pragma unroll
            for (int m = 0; m < 4; ++m) { const float rs = __builtin_amdgcn_rsqf(ss[u.row0 + ai * HALF + wr * 64 + m * 16 + fr] * (1.f / D) + RMS_EPS);
#pragma unroll
                for (int bj = 0; bj < 2; ++bj) { acc[ai][bj][m][0] = acc[ai][bj][m][0] * rs; acc[ai][bj][m][1] = acc[ai][bj][m][1] * rs; } }
        LAS float* X = (LAS float*)(lds + xoff);
        const int pn = u.col0 >> 8, pm = u.row0 >> 8, cl = wc * 32 + 8 * fq, ch = pn * 128 + cl;
        const bool samp = u.row0 >= MP;
        if (fr >= 14) {
#pragma unroll
            for (int ai = 0; ai < 2; ++ai) {
#pragma unroll
                for (int bj = 0; bj < 2; ++bj)
#pragma unroll
                    for (int n = 0; n < 2; ++n) *(LAS f32x4*)(X + ((ai * 2 + wr) * 2 + (fr - 14)) * 256 + bj * HALF + cl + 4 * n) = acc[ai][bj][3][n];
                const bool is_state = samp || (ai == 1 && wr == 1 && (pm & 15) == 15);
                if (is_state) {
                    float* st = samp ? fss + ((size_t)((u.row0 + ai * HALF + wr * 64 - MP) >> 6) * 2 + (fr - 14)) * FF2 : fsp + ((size_t)(pm >> 4) * 2 + (fr - 14)) * FF2;
#pragma unroll
                    for (int bj = 0; bj < 2; ++bj) { float* sp = st + bj * FF + ch; *(f32x4*)sp = acc[ai][bj][3][0]; *(f32x4*)(sp + 4) = acc[ai][bj][3][1]; } }
                asm volatile("" ::: "memory");
            }
            if (wr == 1) {
#pragma unroll
                for (int bj = 0; bj < 2; ++bj)
#pragma unroll
                    for (int n = 0; n < 2; ++n) *(f32x4*)(edge + ((size_t)pm * 2 + (fr - 14)) * FF2 + u.col0 + bj * HALF + cl + 4 * n) = acc[1][bj][3][n];
            }
        }
        if (wr == 0 && fr < 2) {
#pragma unroll
            for (int bj = 0; bj < 2; ++bj)
#pragma unroll
                for (int n = 0; n < 2; ++n) *(f32x4*)(first + ((size_t)pm * 2 + fr) * FF2 + u.col0 + bj * HALF + cl + 4 * n) = acc[0][bj][0][n];
        }
        unsigned P[2][2][4][4];
#pragma unroll
        for (int ai = 0; ai < 2; ++ai)
#pragma unroll
            for (int bj = 0; bj < 2; ++bj)
#pragma unroll
                for (int m = 0; m < 4; ++m)
#pragma unroll
                    for (int n = 0; n < 2; ++n) { const f32x4 v = acc[ai][bj][m][n];
                        asm volatile("v_cvt_pk_bf16_f32 %0, %1, %2" : "=v"(P[ai][bj][m][2 * n]) : "v"(v[0]), "v"(v[1])); asm volatile("v_cvt_pk_bf16_f32 %0, %1, %2" : "=v"(P[ai][bj][m][2 * n + 1]) : "v"(v[2]), "v"(v[3])); }
        f32x4 WG[3][2], WV[3][2], BG[2], BV[2];
#pragma unroll
        for (int n = 0; n < 2; ++n) {
#pragma unroll
            for (int j = 0; j < 3; ++j) { WG[j][n] = *(const GAS f32x4*)(cw + (size_t)j * FF2 + ch + 4 * n); WV[j][n] = *(const GAS f32x4*)(cw + (size_t)j * FF2 + FF + ch + 4 * n); }
            BG[n] = *(const GAS f32x4*)(cb + ch + 4 * n); BV[n] = *(const GAS f32x4*)(cb + FF + ch + 4 * n); }
        asm volatile("s_waitcnt lgkmcnt(0)" ::: "memory"); __builtin_amdgcn_s_barrier(); asm volatile("" ::: "memory");
        const bool f0 = fr == 0, f01 = fr < 2;
#pragma unroll
        for (int ai = 0; ai < 2; ++ai) {
            const int brow0 = u.row0 + ai * HALF + wr * 64;
            const int sb = samp ? ((brow0 - MP) >> 6) : 0, pred = (ai * 2 + wr) > 0 ? (ai * 2 + wr - 1) : 0;
            const bool use_x = !samp && (brow0 & (SEQ - 1)) != 0 && (ai | wr) != 0;
            const int hsel = fr >= 14 ? fr - 14 : 0;
            unsigned pk[4][4];
#pragma unroll
            for (int q = 0; q < 4; ++q) {
                const int c2 = ch + 2 * q;
                f32x2_t wg[3], wv[3];
#pragma unroll
                for (int j = 0; j < 3; ++j) { wg[j] = (f32x2_t){WG[j][q >> 1][2 * (q & 1)], WG[j][q >> 1][2 * (q & 1) + 1]}; wv[j] = (f32x2_t){WV[j][q >> 1][2 * (q & 1)], WV[j][q >> 1][2 * (q & 1) + 1]}; }
                const f32x2_t bg = {BG[q >> 1][2 * (q & 1)], BG[q >> 1][2 * (q & 1) + 1]}, bv = {BV[q >> 1][2 * (q & 1)], BV[q >> 1][2 * (q & 1) + 1]};
                const LAS float* xp = X + (pred * 2 + hsel) * 256 + cl + 2 * q;
                const f32x2_t xgv = *(const LAS f32x2_t*)xp, xvv = *(const LAS f32x2_t*)(xp + HALF);
                unsigned hg = use_x ? pk_bf16(xgv.x, xgv.y) : 0u, hv = use_x ? pk_bf16(xvv.x, xvv.y) : 0u;
                if (samp) { const float* sp = sfs + ((size_t)sb * 2 + hsel) * FF2 + c2; const f32x2_t sgv = *(const GAS f32x2_t*)sp, svv = *(const GAS f32x2_t*)(sp + FF); hg = pk_bf16(sgv.x, sgv.y); hv = pk_bf16(svv.x, svv.y); }
                unsigned rg1 = __builtin_amdgcn_mov_dpp(hg, 0x121, 0xf, 0xf, false), rg2 = __builtin_amdgcn_mov_dpp(hg, 0x122, 0xf, 0xf, false);
                unsigned rv1 = __builtin_amdgcn_mov_dpp(hv, 0x121, 0xf, 0xf, false), rv2 = __builtin_amdgcn_mov_dpp(hv, 0x122, 0xf, 0xf, false);
#pragma unroll
                for (int m = 0; m < 4; ++m) {
                    const unsigned ug = P[ai][0][m][q], uv = P[ai][1][m][q];
                    const unsigned cg1 = __builtin_amdgcn_mov_dpp(ug, 0x121, 0xf, 0xf, false), cg2 = __builtin_amdgcn_mov_dpp(ug, 0x122, 0xf, 0xf, false);
                    const unsigned cv1 = __builtin_amdgcn_mov_dpp(uv, 0x121, 0xf, 0xf, false), cv2 = __builtin_amdgcn_mov_dpp(uv, 0x122, 0xf, 0xf, false);
                    const unsigned g1 = f0 ? rg1 : cg1, g2 = f01 ? rg2 : cg2, v1 = f0 ? rv1 : cv1, v2 = f01 ? rv2 : cv2;
                    const float ga = bg.x + wg[0].x * bf_lo(g2) + wg[1].x * bf_lo(g1) + wg[2].x * bf_lo(ug), gb = bg.y + wg[0].y * bf_hi(g2) + wg[1].y * bf_hi(g1) + wg[2].y * bf_hi(ug);
                    const float va = bv.x + wv[0].x * bf_lo(v2) + wv[1].x * bf_lo(v1) + wv[2].x * bf_lo(uv), vb = bv.y + wv[0].y * bf_hi(v2) + wv[1].y * bf_hi(v1) + wv[2].y * bf_hi(uv);
                    const float y0 = ga * va * __builtin_amdgcn_rcpf(1.f + __builtin_amdgcn_exp2f(-ga * LOG2E)), y1 = gb * vb * __builtin_amdgcn_rcpf(1.f + __builtin_amdgcn_exp2f(-gb * LOG2E));
                    pk[m][q] = pk_bf16(y0, y1);
                    rg1 = cg1; rg2 = cg2; rv1 = cv1; rv2 = cv2;
                }
            }
#pragma unroll
            for (int m = 0; m < 4; ++m) { u32x4 w; w.x = pk[m][0]; w.y = pk[m][1]; w.z = pk[m][2]; w.w = pk[m][3];
                *(u32x4*)(A2 + (size_t)(brow0 + m * 16 + fr) * FF + ch) = w; }
            asm volatile("" ::: "memory");
        }
    }
};
struct EpiSoftmax {
    bf16_t* P; int xoff; const float* ss; float scale;
    __device__ __forceinline__ void operator()(EPI_ARGS) const {
        LAS f32x2_t* X = (LAS f32x2_t*)(lds + xoff);
#pragma unroll
        for (int ai = 0; ai < 2; ++ai)
#pragma unroll
            for (int m = 0; m < 4; ++m) { const float rs = scale * __builtin_amdgcn_rsqf(ss[u.row0 + ai * HALF + wr * 64 + m * 16 + fr] * (1.f / D) + RMS_EPS);
#pragma unroll
                for (int bj = 0; bj < 2; ++bj) { acc[ai][bj][m][0] = acc[ai][bj][m][0] * rs; acc[ai][bj][m][1] = acc[ai][bj][m][1] * rs; } }
        float mw[2][4];
#pragma unroll
        for (int ai = 0; ai < 2; ++ai)
#pragma unroll
            for (int m = 0; m < 4; ++m) {
                float mx = -3.0e38f;
#pragma unroll
                for (int bj = 0; bj < 2; ++bj)
#pragma unroll
                    for (int n = 0; n < 2; ++n) { const f32x4 x = acc[ai][bj][m][n]; mx = fmaxf(mx, fmaxf(fmaxf(x[0], x[1]), fmaxf(x[2], x[3]))); }
                mx = fmaxf(mx, shx(mx, 16, fq * 16 + fr)); mx = fmaxf(mx, shx(mx, 32, fq * 16 + fr));
                float s = 0.f;
#pragma unroll
                for (int bj = 0; bj < 2; ++bj)
#pragma unroll
                    for (int n = 0; n < 2; ++n) { f32x4 x = acc[ai][bj][m][n];
#pragma unroll
                        for (int e = 0; e < 4; ++e) { x[e] = __builtin_amdgcn_exp2f(x[e] - mx); s += x[e]; } acc[ai][bj][m][n] = x; }
                s += shx(s, 16, fq * 16 + fr); s += shx(s, 32, fq * 16 + fr);
                mw[ai][m] = mx;
                if (fq == 0) X[(ai * HALF + wr * 64 + m * 16 + fr) * 4 + wc] = (f32x2_t){mx, s};
            }
        asm volatile("s_waitcnt lgkmcnt(0)" ::: "memory"); __builtin_amdgcn_s_barrier(); asm volatile("" ::: "memory");
        const int row0 = u.row0 + wr * 64 + fr, col0 = u.col0 + wc * 32 + 8 * fq;
#pragma unroll
        for (int ai = 0; ai < 2; ++ai)
#pragma unroll
            for (int m = 0; m < 4; ++m) { const int rl = ai * HALF + wr * 64 + m * 16 + fr;
                const f32x2_t a = X[rl * 4 + 0], b = X[rl * 4 + 1], c = X[rl * 4 + 2], d = X[rl * 4 + 3];
                const float mt = fmaxf(fmaxf(a.x, b.x), fmaxf(c.x, d.x));
                const float L = a.y * __builtin_amdgcn_exp2f(a.x - mt) + b.y * __builtin_amdgcn_exp2f(b.x - mt) + c.y * __builtin_amdgcn_exp2f(c.x - mt) + d.y * __builtin_amdgcn_exp2f(d.x - mt);
                const float f = __builtin_amdgcn_exp2f(mw[ai][m] - mt) / L;
                const int row = row0 + ai * HALF + m * 16;
                if (row >= u.vlo && row < u.vhi) {
#pragma unroll
                for (int bj = 0; bj < 2; ++bj) { const f32x4 v0 = acc[ai][bj][m][0] * f, v1 = acc[ai][bj][m][1] * f;
                    u32x4 w; w.x = pk_bf16(v0[0], v0[1]); w.y = pk_bf16(v0[2], v0[3]); w.z = pk_bf16(v1[0], v1[1]); w.w = pk_bf16(v1[2], v1[3]);
                    *(u32x4*)(P + (size_t)row * D + col0 + bj * HALF) = w; } } }
    }
};
struct SchedQKV {
    static constexpr bool MASKED = false;
    const char* A; const char* Bt; int nM, G, c;
    __device__ __forceinline__ bool next(int i, Unit& u) const {
        int pm, pj; if (!tile_of((long)i * G + c, nM, 12, pm, pj)) return false;
        const int pn = (pj % 3) * 4 + pj / 3;
        u.a = A + (size_t)pm * BM * D * 2; u.b = Bt + (size_t)pn * BM * D * 2; u.row0 = pm * BM; u.col0 = pn * BM; u.vlo = 0; u.vhi = 0x7fffffff; u.aux = pn; return true;
    }
};
struct SchedPool {
    static constexpr bool MASKED = false; const char* A; const char* Bt; int G, c;
    __device__ __forceinline__ bool next(int i, Unit& u) const { int pm, pn; if (!tile_of((long)i * G + c, M / 256, 4, pm, pn)) return false;
        u.a = A + ((size_t)pm * 256 * D + pn * 256) * 2; u.b = Bt + (size_t)pn * 65536 * 2; u.row0 = pm * 256; u.col0 = pn * 256; u.vlo = 0; u.vhi = 0x7fffffff; u.aux = 0; return true; } };
}

namespace sba {
constexpr float QSCALE = 0.125f * LOG2E;
constexpr float EXIT_T = 126.f;
constexpr int VDH = 4160, KIMG = 2 * VDH, KROW = 144, WAVE_LDS = KIMG + 64 * KROW;
__device__ __forceinline__ int crow(int r, int hi) { return (r & 3) + 8 * (r >> 2) + 4 * hi; }
__device__ __forceinline__ s16x4 vtr(LAS const char* p) { typedef short v4i16_t __attribute__((ext_vector_type(4))); return __builtin_bit_cast(s16x4, __builtin_amdgcn_ds_read_tr16_b64_v4i16((LAS v4i16_t*)p)); }

__device__ __forceinline__ bf16x8 cvt8(const f32x4 a, const f32x4 b) { u32x4 w; w.x = pk_bf16(a[0], a[1]); w.y = pk_bf16(a[2], a[3]); w.z = pk_bf16(b[0], b[1]); w.w = pk_bf16(b[2], b[3]); return __builtin_bit_cast(bf16x8, w); }
__device__ __forceinline__ void load_bf16(const bf16_t* Kt, const bf16_t* Vt, LAS char* vimg, int lane) {
    const int c = lane & 7;
    LAS char* vdst = vimg + (c >> 2) * VDH + (lane >> 3) * 64 + (c & 3) * 16; LAS char* kdst = vimg + KIMG + (lane >> 3) * KROW + c * 16;
    const unsigned vvo = (unsigned)((lane >> 3) * D + 8 * c) * 2u;
#pragma unroll
    for (int it = 0; it < 8; ++it) { const u32x4 v = *(const GAS u32x4*)((const GAS char*)Vt + (size_t)it * 8 * D * 2 + vvo); *(LAS u32x4*)(vdst + it * 512) = v; }
#pragma unroll
    for (int it = 0; it < 8; ++it) { const u32x4 v = *(const GAS u32x4*)((const GAS char*)Kt + (size_t)it * 8 * D * 2 + vvo); *(LAS u32x4*)(kdst + it * 8 * KROW) = v; }
}
__device__ __forceinline__ void load_f32(const float* Kt, const float* Vt, LAS char* vimg, int lane) {
    const int c = lane & 7;
    LAS char* vdst = vimg + (c >> 2) * VDH + (lane >> 3) * 64 + (c & 3) * 16; LAS char* kdst = vimg + KIMG + (lane >> 3) * KROW + c * 16;
    const unsigned vvo = (unsigned)((lane >> 3) * D + 8 * c) * 4u;
#pragma unroll
    for (int hv = 0; hv < 2; ++hv) {
#pragma unroll
        for (int it = 4 * hv; it < 4 * hv + 4; ++it) { const GAS f32x4* p = (const GAS f32x4*)((const GAS char*)Vt + (size_t)it * 8 * D * 4 + vvo); *(LAS u32x4*)(vdst + it * 512) = __builtin_bit_cast(u32x4, cvt8(p[0], p[1])); }
        asm volatile("" ::: "memory"); }
#pragma unroll
    for (int hv = 0; hv < 2; ++hv) {
#pragma unroll
        for (int it = 4 * hv; it < 4 * hv + 4; ++it) { const GAS f32x4* p = (const GAS f32x4*)((const GAS char*)Kt + (size_t)it * 8 * D * 4 + vvo); *(LAS u32x4*)(kdst + it * 8 * KROW) = __builtin_bit_cast(u32x4, cvt8(p[0], p[1])); }
        asm volatile("" ::: "memory"); }
}
__device__ __forceinline__ void load_bf16_regs(u32x4 (&kr)[8], u32x4 (&vr)[8], const bf16_t* Kt, const bf16_t* Vt, int lane) {
    const unsigned vvo = (unsigned)((lane >> 3) * D + 8 * (lane & 7)) * 2u;
#pragma unroll
    for (int it = 0; it < 8; ++it) vr[it] = *(const GAS u32x4*)((const GAS char*)Vt + (size_t)it * 8 * D * 2 + vvo);
#pragma unroll
    for (int it = 0; it < 8; ++it) kr[it] = *(const GAS u32x4*)((const GAS char*)Kt + (size_t)it * 8 * D * 2 + vvo);
}
template <bool PF>
__device__ __forceinline__ void tile_step(u32x4 (&kr)[8], u32x4 (&vr)[8], const bf16x8 (&qr)[4], f32x16 (&o)[2], float& carry, bool masked, bool upper_dead, int tq, LAS char* vimg, int lane, const bf16_t* nK, const bf16_t* nV, bool do_pf) {
    const int hi = lane >> 5;
    if (PF) { const int c = lane & 7; LAS char* vdst = vimg + (c >> 2) * VDH + (lane >> 3) * 64 + (c & 3) * 16; LAS char* kdst = vimg + KIMG + (lane >> 3) * KROW + c * 16;
#pragma unroll
        for (int it = 0; it < 8; ++it) *(LAS u32x4*)(kdst + it * 8 * KROW) = kr[it];
#pragma unroll
        for (int it = 0; it < 8; ++it) *(LAS u32x4*)(vdst + it * 512) = vr[it]; }
    asm volatile("s_waitcnt lgkmcnt(0)" ::: "memory");
    bf16x8 kf[8];
    { LAS const char* kb = vimg + KIMG + (lane & 31) * KROW + hi * 16;
#pragma unroll
      for (int hf = 0; hf < 2; ++hf)
#pragma unroll
          for (int d0 = 0; d0 < 4; ++d0) kf[hf * 4 + d0] = *(LAS const bf16x8*)(kb + hf * 32 * KROW + d0 * 32); }
    f32x16 p0 = {}, p1 = {};
#pragma unroll
    for (int d0 = 0; d0 < 4; ++d0) p0 = __builtin_amdgcn_mfma_f32_32x32x16_bf16(kf[d0], qr[d0], p0, 0, 0, 0);
    if (!upper_dead) {
#pragma unroll
        for (int d0 = 0; d0 < 4; ++d0) p1 = __builtin_amdgcn_mfma_f32_32x32x16_bf16(kf[4 + d0], qr[d0], p1, 0, 0, 0);
    }
    if (PF && do_pf) { load_bf16_regs(kr, vr, nK, nV, lane); }
    float k0[16], k1[16];
#pragma unroll
    for (int r = 0; r < 16; ++r) {
        const float z = __builtin_amdgcn_fmed3f(p0[r], -100.f, 100.f); const float e = __builtin_amdgcn_exp2f(-z); float sg = __builtin_amdgcn_rcpf(1.f + e); float kp = e * sg;
        if (masked && !(crow(r, hi) < tq)) { sg = 0.f; kp = 1.f; } p0[r] = sg; k0[r] = kp; }
    if (!upper_dead) {
#pragma unroll
        for (int r = 0; r < 16; ++r) {
            const float z = __builtin_amdgcn_fmed3f(p1[r], -100.f, 100.f); const float e = __builtin_amdgcn_exp2f(-z); float sg = __builtin_amdgcn_rcpf(1.f + e); float kp = e * sg;
            if (masked && !(crow(r, hi) + 32 < tq)) { sg = 0.f; kp = 1.f; } p1[r] = sg; k1[r] = kp; }
    } else {
#pragma unroll
        for (int r = 0; r < 16; ++r) { p1[r] = 0.f; k1[r] = 1.f; }
    }
    float Glo[8], Ghi[8];
#pragma unroll
    for (int a = 0; a < 8; ++a) { const float* kk = a < 4 ? k0 + 4 * a : k1 + 4 * (a - 4); const float g = (kk[0] * kk[1]) * (kk[2] * kk[3]);
        auto rr = __builtin_amdgcn_permlane32_swap(__float_as_uint(g), __float_as_uint(g), false, false); Glo[a] = __uint_as_float(rr[0]); Ghi[a] = __uint_as_float(rr[1]); }
    float sx = __builtin_amdgcn_exp2f(-carry);
#pragma unroll
    for (int a = 7; a >= 0; --a) {
        const float base = hi == 0 ? sx * Ghi[a] : sx;
        if (a >= 4) { const int q = 4 * (a - 4);
            const float s3 = base, s2 = s3 * k1[q + 3], s1 = s2 * k1[q + 2], s0 = s1 * k1[q + 1];
            p1[q + 3] *= s3; p1[q + 2] *= s2; p1[q + 1] *= s1; p1[q] *= s0;
        } else { const int q = 4 * a;
            const float s3 = base, s2 = s3 * k0[q + 3], s1 = s2 * k0[q + 2], s0 = s1 * k0[q + 1];
            p0[q + 3] *= s3; p0[q + 2] *= s2; p0[q + 1] *= s1; p0[q] *= s0;
        }
        sx *= Glo[a] * Ghi[a];
    }
    carry = -__builtin_amdgcn_logf(sx);
    bf16x8 pf[4];
#pragma unroll
    for (int s = 0; s < 4; ++s) { const f32x16& p = s < 2 ? p0 : p1; const int q = 8 * (s & 1);
        u32x4 w; w.x = pk_bf16(p[q], p[q + 1]); w.y = pk_bf16(p[q + 2], p[q + 3]); w.z = pk_bf16(p[q + 4], p[q + 5]); w.w = pk_bf16(p[q + 6], p[q + 7]); pf[s] = __builtin_bit_cast(bf16x8, w); }
    LAS const char* vb = vimg + (4 * hi + ((lane & 15) >> 2)) * 64 + ((lane >> 4) & 1) * 32 + (lane & 3) * 8;
#pragma unroll
    for (int dh = 0; dh < 2; ++dh) {
#pragma unroll
        for (int s = 0; s < 2; ++s) { const s16x4 lo = vtr(vb + dh * VDH + s * 1024), hh = vtr(vb + dh * VDH + s * 1024 + 512);
            const bf16x8 vf = (bf16x8){lo[0], lo[1], lo[2], lo[3], hh[0], hh[1], hh[2], hh[3]};
            o[dh] = __builtin_amdgcn_mfma_f32_32x32x16_bf16(vf, pf[s], o[dh], 0, 0, 0); }
        if (!upper_dead) {
#pragma unroll
            for (int s = 2; s < 4; ++s) { const s16x4 lo = vtr(vb + dh * VDH + s * 1024), hh = vtr(vb + dh * VDH + s * 1024 + 512);
                const bf16x8 vf = (bf16x8){lo[0], lo[1], lo[2], lo[3], hh[0], hh[1], hh[2], hh[3]};
                o[dh] = __builtin_amdgcn_mfma_f32_32x32x16_bf16(vf, pf[s], o[dh], 0, 0, 0); }
        }
    }
    asm volatile("s_waitcnt lgkmcnt(0)" ::: "memory");
}

struct Tensors { const bf16_t* Q; const bf16_t* K; const bf16_t* V; bf16_t* O; const float* cK; const float* cV; };

__device__ __forceinline__ void unit(int id, const Tensors& T, LAS char* vimg, int lane) {
    const int r32 = lane & 31, hi = lane >> 5;
    const bool samp = id >= 32768;
    int h, q0; size_t rowb; int b = 0;
    if (!samp) { const int qb = id & 127; h = (id >> 7) & 15; b = id >> 11; rowb = (size_t)b * SEQ; q0 = qb * 32; }
    else { const int s = id - 32768; const int qb = s & 1; h = (s >> 1) & 15; b = s >> 5; rowb = (size_t)MP + (size_t)b * DSEQ; q0 = qb * 32; }
    const bf16_t* Qw = T.Q + (rowb + q0) * D + h * 64; bf16_t* Ow = T.O + (rowb + q0) * D + h * 64;
    asm volatile("" : "+s"(Qw), "+s"(Ow));
    bf16x8 qr[4];
#pragma unroll
    for (int d0 = 0; d0 < 4; ++d0) qr[d0] = *(const GAS bf16x8*)((const GAS char*)Qw + 32 * d0 + (unsigned)(r32 * D + 8 * hi) * 2u);
    f32x16 o[2]; o[0] = f32x16{}; o[1] = f32x16{};
    float carry = 0.f;
    const bf16_t* Kh = T.K + rowb * D + h * 64; const bf16_t* Vh = T.V + rowb * D + h * 64;
    asm volatile("" : "+s"(Kh), "+s"(Vh));
    u32x4 kr[8], vr[8];
    int kt = q0 >> 6;
    if (!samp) {
        int k0 = q0 >= 32 ? q0 - 32 : 0;
        load_bf16_regs(kr, vr, Kh + (size_t)k0 * D, Vh + (size_t)k0 * D, lane);
        { const int kn = k0 >= 64 ? k0 - 64 : 0;
          tile_step<true>(kr, vr, qr, o, carry, true, q0 < 32, q0 + r32 - k0, vimg, lane, Kh + (size_t)kn * D, Vh + (size_t)kn * D, k0 > 0); }
        while (k0 > 0) {
            if (__all(carry > EXIT_T)) break;
            const int prev = k0; k0 = prev >= 64 ? prev - 64 : 0;
            const int kn = k0 >= 64 ? k0 - 64 : 0; const bool clamp = prev < 64;
            tile_step<true>(kr, vr, qr, o, carry, clamp, clamp && prev <= 32, prev - k0, vimg, lane, Kh + (size_t)kn * D, Vh + (size_t)kn * D, k0 > 0);
        }
    } else {
        load_bf16(Kh + (size_t)kt * 64 * D, Vh + (size_t)kt * 64 * D, vimg, lane);
        tile_step<false>(kr, vr, qr, o, carry, true, (q0 & 32) == 0, q0 + r32 - 64 * kt, vimg, lane, nullptr, nullptr, false);
        const float* cKh = T.cK + (size_t)b * PAST * D + h * 64; const float* cVh = T.cV + (size_t)b * PAST * D + h * 64;
        asm volatile("" : "+s"(cKh), "+s"(cVh));
        for (kt = PAST / 64 - 1; kt >= 0; --kt) {
            if (__all(carry > EXIT_T)) break;
            load_f32(cKh + (size_t)kt * 64 * D, cVh + (size_t)kt * 64 * D, vimg, lane);
            tile_step<false>(kr, vr, qr, o, carry, false, false, 64, vimg, lane, nullptr, nullptr, false);
        }
    }
#pragma unroll
    for (int dh = 0; dh < 2; ++dh)
#pragma unroll
        for (int a = 0; a < 4; ++a) { u32x2 w; w.x = pk_bf16(o[dh][4 * a], o[dh][4 * a + 1]); w.y = pk_bf16(o[dh][4 * a + 2], o[dh][4 * a + 3]);
            *(LAS u32x2*)(vimg + r32 * 144 + (32 * dh + 8 * a + 4 * hi) * 2) = w; }
    asm volatile("s_waitcnt lgkmcnt(0)" ::: "memory");
#pragma unroll
    for (int i = 0; i < 4; ++i) { const int row = i * 8 + (lane >> 3), ch = lane & 7; const u32x4 v = *(LAS const u32x4*)(vimg + row * 144 + ch * 16); *(GAS u32x4*)((GAS char*)Ow + (unsigned)(row * D + ch * 8) * 2u) = v; }
    asm volatile("s_waitcnt lgkmcnt(0)" ::: "memory");
}
}

constexpr int NWAVES = 8;
constexpr int RING_OFF = 0, RING_BYTES = 131072, XCH_OFF = RING_BYTES, XCH_BYTES = 8192, MISC_OFF = 143360, TICKET_OFF = MISC_OFF + 256, LDS_BYTES = 147456;
static_assert(sba::WAVE_LDS * NWAVES <= MISC_OFF && XCH_OFF + XCH_BYTES <= MISC_OFF && TICKET_OFF + 64 <= LDS_BYTES, "LDS map");

#define XB_TMO      128
#define XB_XCNT(j)  (256  + 64 * (j))
#define XB_XSUB(j)  (1280 + 64 * (j))
#define XB_XGEN(j)  (2304 + 64 * (j))
#define XB_TOP      3328
#define XB_TOPGEN   3392
#define XCD_BAR_WORDS 3456
#define XB_SPIN_CAP (1u << 18)
__device__ __forceinline__ unsigned xb_ld(unsigned* p)              { return __hip_atomic_load(p, __ATOMIC_RELAXED, __HIP_MEMORY_SCOPE_AGENT); }
__device__ __forceinline__ unsigned xb_add(unsigned* p, unsigned v) { return __hip_atomic_fetch_add(p, v, __ATOMIC_RELAXED, __HIP_MEMORY_SCOPE_AGENT); }
__device__ __forceinline__ unsigned xb_xcc_id() { return (unsigned)__builtin_amdgcn_s_getreg((3 << 11) | 20) & 0xFu; }
#define XB_SPIN(cond, bar) do { unsigned _sp = 0; while (cond) { __builtin_amdgcn_s_sleep(1); \
    if ((++_sp & 255u) == 0u) { if (xb_ld(&(bar)[XB_TMO])) break; if (_sp > XB_SPIN_CAP) { atomicAdd(&(bar)[XB_TMO], 1u); break; } } } } while (0)
struct XcdBarrier { unsigned* bar; unsigned x; volatile LAS unsigned* st; };
__device__ __forceinline__ XcdBarrier xcd_barrier_post(unsigned* bar, volatile LAS unsigned* st, int tid) {
    XcdBarrier b; b.bar = bar; b.x = xb_xcc_id(); b.st = st;
    if (tid == 0) (void)xb_add(&bar[XB_XCNT(b.x)], 1u);
    return b;
}
__device__ __forceinline__ void xcd_barrier_complete(unsigned* bar, unsigned x, unsigned& nloc, unsigned& nx) {
    const unsigned G = gridDim.x * gridDim.y * gridDim.z;
    unsigned sum, cnt, mine, sp = 0u;
    for (;;) {
        sum = 0u; cnt = 0u; mine = 0u;
#pragma unroll
        for (unsigned j = 0; j < 16; ++j) { const unsigned c = xb_ld(&bar[XB_XCNT(j)]); sum += c; cnt += (c > 0u) ? 1u : 0u; mine = (j == x) ? c : mine; }
        if (sum == G) break;
        __builtin_amdgcn_s_sleep(1);
        if ((++sp & 255u) == 0u) { if (xb_ld(&bar[XB_TMO])) break; if (sp > XB_SPIN_CAP) { atomicAdd(&bar[XB_TMO], 1u); break; } }
    }
    nloc = mine > 0u ? mine : 1u; nx = cnt > 0u ? cnt : 1u;
}
__device__ __forceinline__ void xcd_barrier(const XcdBarrier& b, int tid) {
    asm volatile("s_waitcnt vmcnt(0)" ::: "memory");
    __syncthreads();
    if (tid == 0) {
        unsigned* bar = b.bar;
        __builtin_amdgcn_s_waitcnt(0);
        unsigned nloc = b.st[0], nx = b.st[1];
        if (nloc == 0u) { xcd_barrier_complete(bar, b.x, nloc, nx); b.st[0] = nloc; b.st[1] = nx; }
        const unsigned old = xb_add(&bar[XB_XSUB(b.x)], 1u);
        const unsigned gen = old / nloc;
        if (old + 1u == (gen + 1u) * nloc) {
            __builtin_amdgcn_fence(__ATOMIC_RELEASE, "agent");
            asm volatile("s_waitcnt vmcnt(0)" ::: "memory");
            const unsigned og = xb_add(&bar[XB_TOP], 1u);
            const unsigned tg = og / nx;
            if (og + 1u == (tg + 1u) * nx) xb_add(&bar[XB_TOPGEN], 1u);
            else XB_SPIN(xb_ld(&bar[XB_TOPGEN]) == tg, bar);
            __builtin_amdgcn_fence(__ATOMIC_ACQUIRE, "agent");
            xb_add(&bar[XB_XGEN(b.x)], 1u);
            asm volatile("s_waitcnt vmcnt(0)" ::: "memory");
        } else {
            XB_SPIN(xb_ld(&bar[XB_XGEN(b.x)]) == gen, bar);
            __builtin_amdgcn_fence(__ATOMIC_ACQUIRE, "agent");
            asm volatile("s_waitcnt vmcnt(0)" ::: "memory");
        }
    }
    __syncthreads();
}

struct Args { const float* in[25]; float* out; unsigned char* ws; int ph_lo, ph_hi; };
struct Frame { LAS unsigned char* lds; int tid, lane, wave, vcu, G, gw, NGW, bx; };

__device__ __forceinline__ float wave_sum(float v, int lane) {
#pragma unroll
    for (int o = 1; o < 64; o <<= 1) v += shx(v, o, lane);
    return v;
}
__device__ __forceinline__ void transpose_item(const float* W, int ldw, int k0, int n0, bf16_t* WT, int ldt, int drow0, LAS float* scr, int lane, const float* gk = nullptr) {
    f32x4 t[8];
#pragma unroll
    for (int i = 0; i < 8; ++i) { const int kk = 8 * i + (lane >> 3); t[i] = *(const GAS f32x4*)(W + (size_t)(k0 + kk) * ldw + n0 + 4 * (lane & 7)); }
#pragma unroll
    for (int i = 0; i < 8; ++i) { const int kk = 8 * i + (lane >> 3); const float g = gk ? gk[k0 + kk] : 1.f; LAS float* d = scr + kk * 33 + 4 * (lane & 7);
        d[0] = t[i][0] * g; d[1] = t[i][1] * g; d[2] = t[i][2] * g; d[3] = t[i][3] * g; }
    asm volatile("s_waitcnt lgkmcnt(0)" ::: "memory");
    const int c = lane & 7;
#pragma unroll
    for (int j = 0; j < 4; ++j) { const int n = (lane >> 3) + 8 * j; const LAS float* s = scr + (8 * c) * 33 + n;
        u32x4 o; o.x = pk_bf16(s[0 * 33], s[1 * 33]); o.y = pk_bf16(s[2 * 33], s[3 * 33]); o.z = pk_bf16(s[4 * 33], s[5 * 33]); o.w = pk_bf16(s[6 * 33], s[7 * 33]);
        *(GAS u32x4*)(WT + (size_t)(drow0 + n) * ldt + k0 + 8 * c) = o; }
    asm volatile("s_waitcnt lgkmcnt(0)" ::: "memory");
}
__device__ __forceinline__ void transpose_mat_item(const float* W, int ldw, int K, int N, bf16_t* WT, int r, LAS float* scr, int lane, const float* gk = nullptr) {
    const int nblk = N / 32, kb = r / nblk, nb = r % nblk; transpose_item(W, ldw, 64 * kb, 32 * nb, WT, K, 32 * nb, scr, lane, gk);
}
__device__ __forceinline__ void norm_row(const float* xrow, const float* g, bf16_t* hb, float* xc, float* fo, int lane) {
    const GAS f32x4* xr = (const GAS f32x4*)xrow + lane; const GAS f32x4* gr = (const GAS f32x4*)g + lane;
    f32x4 v[4]; float s = 0.f;
#pragma unroll
    for (int j = 0; j < 4; ++j) { v[j] = xr[64 * j]; s += (v[j].x * v[j].x + v[j].y * v[j].y) + (v[j].z * v[j].z + v[j].w * v[j].w); }
    if (xc) {
#pragma unroll
        for (int j = 0; j < 4; ++j) ((GAS f32x4*)xc + lane)[64 * j] = v[j];
    }
    const float rstd = 1.0f / sqrtf(wave_sum(s, lane) * (1.f / D) + RMS_EPS);
#pragma unroll
    for (int j = 0; j < 4; ++j) { v[j] = v[j] * rstd * gr[64 * j]; }
    if (hb) { GAS u32x2* o8 = (GAS u32x2*)hb + lane;
#pragma unroll
        for (int j = 0; j < 4; ++j) { u32x2 w; w.x = pk_bf16(v[j].x, v[j].y); w.y = pk_bf16(v[j].z, v[j].w); o8[64 * j] = w; } }
    if (fo) {
#pragma unroll
        for (int j = 0; j < 4; ++j) ((GAS f32x4*)fo + lane)[64 * j] = v[j];
    }
}
__device__ __forceinline__ int up_dest_row(int n) { return n < FF ? 256 * (n >> 7) + (n & 127) : 256 * ((n - FF) >> 7) + 128 + ((n - FF) & 127); }

__device__ __forceinline__ void ffn_weight_items(const Frame& F, const Args& a, int l, int wi, int nw) {
    LAS float* scr = (LAS float*)(F.lds + RING_OFF + F.wave * 16384);
    unsigned char* ws = a.ws;
    constexpr int I_UP = 16 * 176, I_DN = 44 * 32;
    for (int r = wi; r < I_UP + I_DN; r += nw) {
        if (r < I_UP) { const int kb = r / 176, nb = r % 176;
            transpose_item(a.in[21] + (size_t)l * D * FF2, FF2, 64 * kb, 32 * nb, (bf16_t*)(ws + WS_WUP) + (size_t)l * FF2 * D, D, up_dest_row(32 * nb), scr, F.lane, a.in[12] + l * D); }
        else transpose_mat_item(a.in[24] + (size_t)l * FF * D, D, FF, D, (bf16_t*)(ws + WS_WDN) + (size_t)l * D * FF, r - I_UP, scr, F.lane);
    }
}
__device__ __forceinline__ void p0_prologue(const Frame& F, const Args& a) {
    LAS float* scr = (LAS float*)(F.lds + RING_OFF + F.wave * 16384);
    unsigned char* ws = a.ws;
    constexpr int I_QKV = 16 * 96, I_SQ = 16 * 32, I_POOL = 4 * 32, I_KV = 16 * 64;
    constexpr int NIT = I_QKV + I_SQ + I_POOL + 2 * I_KV + 2 * I_SQ;
    for (int it = F.gw; it < NIT; it += F.NGW) {
        int r = it;
        if (r < I_QKV) { transpose_mat_item(a.in[14], 3 * D, D, 3 * D, (bf16_t*)(ws + WS_WQKV), r, scr, F.lane, a.in[9]); continue; } r -= I_QKV;
        if (r < I_SQ) { transpose_mat_item(a.in[15], D, D, D, (bf16_t*)(ws + WS_WO), r, scr, F.lane); continue; } r -= I_SQ;
        if (r < I_POOL) { const int g = r >> 5; transpose_mat_item(a.in[16] + (size_t)g * 65536, 256, 256, 256, (bf16_t*)(ws + WS_WPOOL) + (size_t)g * 65536, r & 31, scr, F.lane); continue; } r -= I_POOL;
        if (r < 2 * I_KV) { const int l = r / I_KV; transpose_mat_item(a.in[19] + (size_t)l * D * 2 * D, 2 * D, D, 2 * D, (bf16_t*)(ws + WS_WCAKV) + (size_t)l * 2 * D * D, r % I_KV, scr, F.lane); continue; } r -= 2 * I_KV;
        if (r < 2 * I_SQ) { const int l = r / I_SQ; transpose_mat_item(a.in[20] + (size_t)l * D * D, D, D, D, (bf16_t*)(ws + WS_WCAO) + (size_t)l * D * D, r % I_SQ, scr, F.lane); continue; } r -= 2 * I_SQ;
    }
    { const int n8 = 2 * D * D / 8;
      for (int i = F.bx * 512 + F.tid; i < n8; i += F.G * 512) { const int l = i / (D * D / 8), kk = (i % (D * D / 8)) / (D / 8); const float g = a.in[10][l * D + kk];
          const GAS f32x4* src = (const GAS f32x4*)a.in[18] + 2 * (size_t)i; const f32x4 x = src[0] * g, y = src[1] * g;
          u32x4 w; w.x = pk_bf16(x[0], x[1]); w.y = pk_bf16(x[2], x[3]); w.z = pk_bf16(y[0], y[1]); w.w = pk_bf16(y[2], y[3]); ((GAS u32x4*)(ws + WS_WCAQ))[i] = w; } }
    { const GAS f32x4* src = (const GAS f32x4*)a.in[8]; GAS u32x4* dst = (GAS u32x4*)(ws + WS_VMTS); const int n8 = 2 * DB * NMEM * D / 8;
      for (int i = F.bx * 512 + F.tid; i < n8; i += F.G * 512) { const f32x4 x = src[2 * i], y = src[2 * i + 1]; u32x4 w; w.x = pk_bf16(x[0], x[1]); w.y = pk_bf16(x[2], x[3]); w.z = pk_bf16(y[0], y[1]); w.w = pk_bf16(y[2], y[3]); dst[i] = w; } }
    { const GAS f32x4* src = (const GAS f32x4*)a.in[7]; GAS u32x4* dst = (GAS u32x4*)(ws + WS_KMS); const int n8 = 2 * DB * NMEM * D / 8;
      for (int i = F.bx * 512 + F.tid; i < n8; i += F.G * 512) { const f32x4 x = src[2 * i], y = src[2 * i + 1]; u32x4 w; w.x = pk_bf16(x[0], x[1]); w.y = pk_bf16(x[2], x[3]); w.z = pk_bf16(y[0], y[1]); w.w = pk_bf16(y[2], y[3]); dst[i] = w; } }
    for (int m = F.gw; m < 2 * NB * NMEM; m += F.NGW) { const int l = m / (NB * NMEM), r = m % (NB * NMEM);
        norm_row(a.in[2] + (size_t)r * D, a.in[11] + l * D, (bf16_t*)(ws + WS_MN) + (size_t)m * D, nullptr, nullptr, F.lane); }
    { GAS float* ssz = (GAS float*)(ws + WS_SS) + M; for (int i = F.bx * 512 + F.tid; i < 6 * M; i += F.G * 512) ssz[i] = 0.f; }
    for (int m = F.gw; m < M; m += 2 * F.NGW) {
        const int m2 = m + F.NGW; const bool has2 = m2 < M;
        const float* xr = m < MP ? a.in[0] + (size_t)m * D : a.in[1] + (size_t)(m - MP) * D; const float* xr2 = !has2 ? xr : (m2 < MP ? a.in[0] + (size_t)m2 * D : a.in[1] + (size_t)(m2 - MP) * D);
        const GAS f32x4* xp = (const GAS f32x4*)xr + F.lane; const GAS f32x4* xp2 = (const GAS f32x4*)xr2 + F.lane;
        f32x4 v[4], v2[4];
#pragma unroll
        for (int j = 0; j < 4; ++j) { v[j] = xp[64 * j]; v2[j] = xp2[64 * j]; }
        GAS u32x2* op = (GAS u32x2*)((bf16_t*)(ws + WS_HB) + (size_t)m * D) + F.lane; GAS u32x2* op2 = (GAS u32x2*)((bf16_t*)(ws + WS_HB) + (size_t)(has2 ? m2 : m) * D) + F.lane; float q = 0.f, q2 = 0.f;
#pragma unroll
        for (int j = 0; j < 4; ++j) { u32x2 w; w.x = pk_bf16(v[j].x, v[j].y); w.y = pk_bf16(v[j].z, v[j].w); op[64 * j] = w;
            q += (bf_lo(w.x) * bf_lo(w.x) + bf_hi(w.x) * bf_hi(w.x)) + (bf_lo(w.y) * bf_lo(w.y) + bf_hi(w.y) * bf_hi(w.y));
            u32x2 w2; w2.x = pk_bf16(v2[j].x, v2[j].y); w2.y = pk_bf16(v2[j].z, v2[j].w); if (has2) op2[64 * j] = w2;
            q2 += (bf_lo(w2.x) * bf_lo(w2.x) + bf_hi(w2.x) * bf_hi(w2.x)) + (bf_lo(w2.y) * bf_lo(w2.y) + bf_hi(w2.y) * bf_hi(w2.y)); }
        q = wave_sum(q, F.lane); q2 = wave_sum(q2, F.lane);
        if (F.lane == 0) { ((GAS float*)(ws + WS_SS))[m] = q; if (has2) ((GAS float*)(ws + WS_SS))[m2] = q2; } }
}
__device__ __forceinline__ void final_phase(const Frame& F, const Args& a) {
    const float* ss = (const float*)(a.ws + WS_SS) + (size_t)6 * M; const GAS f32x4* gr = (const GAS f32x4*)a.in[13] + F.lane;
    f32x4 g[4];
#pragma unroll
    for (int j = 0; j < 4; ++j) g[j] = gr[64 * j];
    for (int m0 = F.gw; m0 < MP; m0 += 4 * F.NGW) {
        u32x2 w[4][4]; float rs[4];
#pragma unroll
        for (int r = 0; r < 4; ++r) { const int m = m0 + r * F.NGW < MP ? m0 + r * F.NGW : m0; rs[r] = __builtin_amdgcn_rsqf(ss[m] * (1.f / D) + RMS_EPS);
            const GAS u32x2* xp = (const GAS u32x2*)((const bf16_t*)(a.ws + WS_HB) + (size_t)m * D) + F.lane;
#pragma unroll
            for (int j = 0; j < 4; ++j) w[r][j] = xp[64 * j]; }
#pragma unroll
        for (int r = 0; r < 4; ++r) { const int m = m0 + r * F.NGW; if (m < MP) { GAS f32x4* op = (GAS f32x4*)(a.out + OUT_Y + (size_t)m * D) + F.lane;
#pragma unroll
            for (int j = 0; j < 4; ++j) __builtin_nontemporal_store((f32x4){bf_lo(w[r][j].x), bf_hi(w[r][j].x), bf_lo(w[r][j].y), bf_hi(w[r][j].y)} * rs[r] * g[j], op + 64 * j); } }
    }
    for (int r = F.NGW - 1 - F.gw; r < MS; r += F.NGW) {
        const GAS u32x2* xp = (const GAS u32x2*)((const bf16_t*)(a.ws + WS_HB) + (size_t)(MP + r) * D) + F.lane;
        f32x4 x[4];
#pragma unroll
        for (int j = 0; j < 4; ++j) { const u32x2 w = xp[64 * j]; x[j] = (f32x4){bf_lo(w.x), bf_hi(w.x), bf_lo(w.y), bf_hi(w.y)}; }
#pragma unroll
        for (int p = 0; p < 11; ++p) { const GAS u32x2* pp = (const GAS u32x2*)((const bf16_t*)(a.ws + WS_PART) + ((size_t)p * MS + r) * D) + F.lane;
#pragma unroll
            for (int j = 0; j < 4; ++j) { const u32x2 w = pp[64 * j]; x[j] += (f32x4){bf_lo(w.x), bf_hi(w.x), bf_lo(w.y), bf_hi(w.y)}; } }
        float q = 0.f;
#pragma unroll
        for (int j = 0; j < 4; ++j) q += x[j][0] * x[j][0] + x[j][1] * x[j][1] + x[j][2] * x[j][2] + x[j][3] * x[j][3];
        q = wave_sum(q, F.lane);
        const float rs = __builtin_amdgcn_rsqf(q * (1.f / D) + RMS_EPS);
        GAS f32x4* op = (GAS f32x4*)(a.out + OUT_Y + (size_t)(MP + r) * D) + F.lane;
#pragma unroll
        for (int j = 0; j < 4; ++j) __builtin_nontemporal_store(x[j] * rs * g[j], op + 64 * j);
    }
}
template <int W> __device__ __forceinline__ void pool_load_h(float (&hv)[16], const Args& a, const float* ss, const float (&gn)[16], bool samp, int b, int m0, int t, int c0) {
    if (t >= 0) { const GAS u32x4* p = (const GAS u32x4*)((const bf16_t*)(a.ws + WS_HB) + (size_t)(m0 + t) * D + c0); const u32x4 x = p[0], y = p[1];
        const float rs = __builtin_amdgcn_rsqf(ss[m0 + t] * (1.f / D) + RMS_EPS);
        const float v[16] = {bf_lo(x.x), bf_hi(x.x), bf_lo(x.y), bf_hi(x.y), bf_lo(x.z), bf_hi(x.z), bf_lo(x.w), bf_hi(x.w), bf_lo(y.x), bf_hi(y.x), bf_lo(y.y), bf_hi(y.y), bf_lo(y.z), bf_hi(y.z), bf_lo(y.w), bf_hi(y.w)};
#pragma unroll
        for (int e = 0; e < 16; ++e) hv[e] = v[e] * rs * gn[e]; }
    else if (samp) { const GAS f32x4* p = (const GAS f32x4*)(a.in[5] + ((size_t)b * 15 + (15 + t)) * D + c0);
#pragma unroll
        for (int q = 0; q < 4; ++q) { const f32x4 x = p[q]; hv[4 * q] = x[0]; hv[4 * q + 1] = x[1]; hv[4 * q + 2] = x[2]; hv[4 * q + 3] = x[3]; } }
    else {
#pragma unroll
        for (int e = 0; e < 16; ++e) hv[e] = 0.f; }
}
template <int W> __device__ __forceinline__ void pool_item(const Args& a, int chunk, int g, int lane) {
    bf16_t* PB = (bf16_t*)(a.ws + WS_QB); const float* ss = (const float*)(a.ws + WS_SS) + (size_t)3 * M;
    const bool samp = chunk >= MP / 64;
    const int b = samp ? chunk - MP / 64 : chunk >> 6, m0 = samp ? MP + b * DSEQ : b * SEQ, tl = samp ? DSEQ : SEQ;
    const int ts = (samp ? 0 : (chunk & 63) * 64) + 16 * (lane >> 4), c0 = g * 256 + (lane & 15) * 16;
    float gn[16];
    { const GAS f32x4* gp = (const GAS f32x4*)(a.in[9] + D + c0);
#pragma unroll
      for (int q = 0; q < 4; ++q) { const f32x4 x = gp[q]; gn[4 * q] = x[0]; gn[4 * q + 1] = x[1]; gn[4 * q + 2] = x[2]; gn[4 * q + 3] = x[3]; } }
    float run[16], hv[16];
#pragma unroll
    for (int e = 0; e < 16; ++e) run[e] = 0.f;
#pragma unroll 2
    for (int j = 1; j < W; ++j) { pool_load_h<W>(hv, a, ss, gn, samp, b, m0, ts - j, c0);
#pragma unroll
        for (int e = 0; e < 16; ++e) run[e] += hv[e]; }
#pragma unroll 4
    for (int i = 0; i < 16; ++i) {
        const int t = ts + i;
        pool_load_h<W>(hv, a, ss, gn, samp, b, m0, t, c0);
#pragma unroll
        for (int e = 0; e < 16; ++e) run[e] += hv[e];
        const int pos = samp ? PAST + t : t; const float inv = 1.0f / (float)(pos + 1 < W ? pos + 1 : W);
        u32x4 o0, o1;
        o0.x = pk_bf16(run[0] * inv - hv[0], run[1] * inv - hv[1]); o0.y = pk_bf16(run[2] * inv - hv[2], run[3] * inv - hv[3]); o0.z = pk_bf16(run[4] * inv - hv[4], run[5] * inv - hv[5]); o0.w = pk_bf16(run[6] * inv - hv[6], run[7] * inv - hv[7]);
        o1.x = pk_bf16(run[8] * inv - hv[8], run[9] * inv - hv[9]); o1.y = pk_bf16(run[10] * inv - hv[10], run[11] * inv - hv[11]); o1.z = pk_bf16(run[12] * inv - hv[12], run[13] * inv - hv[13]); o1.w = pk_bf16(run[14] * inv - hv[14], run[15] * inv - hv[15]);
        GAS u32x4* op = (GAS u32x4*)(PB + (size_t)(m0 + t) * D + c0); op[0] = o0; op[1] = o1;
        if (t >= tl - 15) { float* fo = (samp ? a.out + OUT_PSS : a.out + OUT_PSP) + ((size_t)b * 15 + (t - (tl - 15))) * D + c0;
#pragma unroll
            for (int q = 0; q < 4; ++q) ((GAS f32x4*)fo)[q] = (f32x4){hv[4 * q], hv[4 * q + 1], hv[4 * q + 2], hv[4 * q + 3]}; }
        float ho[16]; pool_load_h<W>(ho, a, ss, gn, samp, b, m0, t - (W - 1), c0);
#pragma unroll
        for (int e = 0; e < 16; ++e) run[e] -= ho[e];
    }
}
__device__ __forceinline__ void pool_phase(const Frame& F, const Args& a) {
    constexpr int NCH = MP / 64 + DB;
    for (int it = F.gw, pass = 0; it < NCH * 4; it += F.NGW, ++pass) {
        const int gs = it & 3, g = (pass & 1) ? 3 - gs : gs, chunk = it >> 2;
        if (g == 0) pool_item<2>(a, chunk, 0, F.lane); else if (g == 1) pool_item<4>(a, chunk, 1, F.lane); else if (g == 2) pool_item<8>(a, chunk, 2, F.lane); else pool_item<16>(a, chunk, 3, F.lane);
    }
}
__device__ __forceinline__ void ffn_fix_tile(unsigned char* ws, const float* cw, const float* cb, int pm, int tid) {
    const float* edge = (const float*)(ws + WS_EDGE); const float* first = (const float*)(ws + WS_FIRST); bf16_t* A2 = (bf16_t*)(ws + WS_A2);
    for (int it = tid; it < FF / 4; it += 512) {
        const int c4 = it * 4, dcol = 256 * (c4 >> 7) + (c4 & 127);
        f32x4 wg[3], wv[3];
#pragma unroll
        for (int j = 0; j < 3; ++j) { wg[j] = *(const GAS f32x4*)(cw + (size_t)j * FF2 + c4); wv[j] = *(const GAS f32x4*)(cw + (size_t)j * FF2 + FF + c4); }
        const f32x4 bg = *(const GAS f32x4*)(cb + c4), bv = *(const GAS f32x4*)(cb + FF + c4);
        const float* e = edge + (size_t)(pm - 1) * 2 * FF2 + dcol; const float* f = first + (size_t)pm * 2 * FF2 + dcol;
        const f32x4 g2 = *(const GAS f32x4*)e, v2 = *(const GAS f32x4*)(e + 128), g1 = *(const GAS f32x4*)(e + FF2), v1 = *(const GAS f32x4*)(e + FF2 + 128);
        const f32x4 g0 = *(const GAS f32x4*)f, v0 = *(const GAS f32x4*)(f + 128), gp = *(const GAS f32x4*)(f + FF2), vp = *(const GAS f32x4*)(f + FF2 + 128);
        const f32x4 ga = bg + wg[0] * g2 + wg[1] * g1 + wg[2] * g0, va = bv + wv[0] * v2 + wv[1] * v1 + wv[2] * v0;
        const f32x4 gb = bg + wg[0] * g1 + wg[1] * g0 + wg[2] * gp, vb = bv + wv[0] * v1 + wv[1] * v0 + wv[2] * vp;
        f32x4 ya, yb;
#pragma unroll
        for (int q = 0; q < 4; ++q) { ya[q] = ga[q] * va[q] * __builtin_amdgcn_rcpf(1.f + __builtin_amdgcn_exp2f(-ga[q] * LOG2E)); yb[q] = gb[q] * vb[q] * __builtin_amdgcn_rcpf(1.f + __builtin_amdgcn_exp2f(-gb[q] * LOG2E)); }
        u32x2 wa, wb; wa.x = pk_bf16(ya[0], ya[1]); wa.y = pk_bf16(ya[2], ya[3]); wb.x = pk_bf16(yb[0], yb[1]); wb.y = pk_bf16(yb[2], yb[3]);
        *(GAS u32x2*)(A2 + (size_t)(pm * 256) * FF + c4) = wa; *(GAS u32x2*)(A2 + (size_t)(pm * 256 + 1) * FF + c4) = wb;
    }
}

extern __shared__ __attribute__((aligned(16))) unsigned char lds_raw[];
typedef __attribute__((address_space(4))) const Args CArgs;
__device__ __forceinline__ CArgs* kargs() { CArgs* k = (CArgs*)__builtin_amdgcn_kernarg_segment_ptr(); asm volatile("" : "+s"(k)); return k; }
__device__ __forceinline__ int elect_tid() {
    unsigned ones = ~0u; asm volatile("" : "+s"(ones));
    const int lane = (int)__builtin_amdgcn_mbcnt_hi(ones, __builtin_amdgcn_mbcnt_lo(ones, 0u));
    unsigned t = 0u;
    if (lane == 0) t = __hip_atomic_fetch_add((LAS unsigned*)((LAS unsigned char*)lds_raw + TICKET_OFF), 1u, __ATOMIC_RELAXED, __HIP_MEMORY_SCOPE_WORKGROUP);
    return (int)((__builtin_amdgcn_readfirstlane(t) & 7u) * 64u) + lane;
}
__device__ __forceinline__ Frame make_frame() {
    Frame F; F.lds = (LAS unsigned char*)lds_raw;
    const int tid = elect_tid(); __syncthreads();
    int bx = blockIdx.x, G = gridDim.x; asm volatile("" : "+s"(bx), "+s"(G));
    F.tid = tid; F.lane = F.tid & 63; F.wave = __builtin_amdgcn_readfirstlane(F.tid >> 6);
    F.G = G; F.bx = bx; F.vcu = (F.G % 8 == 0) ? (bx % 8) * (F.G / 8) + bx / 8 : bx;
    F.gw = F.vcu * NWAVES + F.wave; F.NGW = F.G * NWAVES; return F;
}
__device__ __forceinline__ Args load_args() { CArgs* k = kargs(); Args a;
#pragma unroll
    for (int i = 0; i < 25; ++i) a.in[i] = k->in[i];
    a.out = k->out; a.ws = k->ws; a.ph_lo = k->ph_lo; a.ph_hi = k->ph_hi; return a; }
#define PHASE static __device__ __forceinline__ void

PHASE ph_prologue() { const Frame F = make_frame(); const Args a = load_args(); p0_prologue(F, a); }
__device__ __forceinline__ void memkv_part(const Frame& F, CArgs* k, int G2, int c2, int l0, int l1) {
    unsigned char* ws = k->ws; float* out = k->out;
    if (c2 < 0) return;
    for (int l = l0; l < l1; ++l) {
        { pg8::GemmP g{D, D, D}; pg8::SchedMN S{(const char*)(ws + WS_MN) + (size_t)l * NB * NMEM * D * 2, (const char*)(ws + WS_WCAKV) + (size_t)l * 2 * D * D * 2, D, D, 16, 4, G2, (c2 + 128 * l) % G2, 0};
          pg8::EpiMemK E{out + OUT_MKP + (size_t)l * NB * NMEM * D, (bf16_t*)(ws + WS_KMP) + (size_t)l * NB * NMEM * D};
          int t_ = F.tid; asm volatile("" : "+v"(t_)); pg8::gemm_phase(F.lds + RING_OFF, g, S, E, t_); }
        { pg8::GemmP g{D, D, D}; pg8::SchedMN S{(const char*)(ws + WS_MN) + (size_t)l * NB * NMEM * D * 2, (const char*)(ws + WS_WCAKV) + ((size_t)l * 2 * D * D + (size_t)D * D) * 2, D, D, 16, 4, G2, (c2 + 128 * l + 64) % G2, 0};
          pg8::EpiMemK E{out + OUT_MVP + (size_t)l * NB * NMEM * D, (bf16_t*)(ws + WS_VMTP) + (size_t)l * NB * NMEM * D};
          int t_ = F.tid; asm volatile("" : "+v"(t_)); pg8::gemm_phase(F.lds + RING_OFF, g, S, E, t_); }
    }
}
PHASE ph_qkv() {
    const Frame F = make_frame(); CArgs* k = kargs(); unsigned char* ws = k->ws;
    pg8::GemmP g{D, D, D}; pg8::SchedQKV S{(const char*)(ws + WS_HB), (const char*)(ws + WS_WQKV), M / 256, F.G, F.bx};
    pg8::EpiQKV E{(bf16_t*)(ws + WS_QB), (size_t)(WS_KB - WS_QB) / 2, k->out, sba::QSCALE, (const float*)(ws + WS_SS)};
    pg8::gemm_phase(F.lds + RING_OFF, g, S, E, F.tid);
    { const Frame F2 = make_frame();
      const int extra = (M / 256) * 12 - 12 * F2.G;
      int G2 = F2.G, c2 = F2.bx; if (extra > 0 && extra < F2.G) { G2 = F2.G - extra; c2 = F2.bx >= extra ? F2.bx - extra : -1; }
      memkv_part(F2, k, G2, c2, 0, 1); }
}
PHASE ph_sbattn() {
    const Frame F = make_frame(); CArgs* k = kargs(); unsigned char* ws = k->ws;
    sba::Tensors T{(const bf16_t*)(ws + WS_QB), (const bf16_t*)(ws + WS_KB), (const bf16_t*)(ws + WS_VB), (bf16_t*)(ws + WS_OB), k->in[3], k->in[4]};
    LAS char* vimg = (LAS char*)(F.lds + RING_OFF + F.wave * sba::WAVE_LDS);
    LAS unsigned* ctr = (LAS unsigned*)(F.lds + MISC_OFF + 64);
    for (;;) {
        unsigned j = 0u; if (F.lane == 0) j = __hip_atomic_fetch_add(ctr, 1u, __ATOMIC_RELAXED, __HIP_MEMORY_SCOPE_WORKGROUP);
        j = (unsigned)__builtin_amdgcn_readfirstlane(j);
        const int id = F.vcu * NWAVES + (int)(j & 7u) + (int)(j >> 3) * F.NGW;
        if (id >= 32768 + 1024) break;
        sba::unit(id, T, vimg, F.lane);
    }
}
__device__ __forceinline__ size_t ca_base(int layer) { return layer == 0 ? WS_QB : WS_OB; }
__device__ __forceinline__ int ca_vwrow0(int layer) { return layer == 0 ? (int)((WS_VB - WS_QB) / 2048) : (int)((WS_VW1 - WS_OB) / 2048); }
__device__ __forceinline__ void wkvw_part(const Frame& F, CArgs* k, int layer, int G, int c) {
    unsigned char* ws = k->ws;
    pg8::GemmP g{D, D, 256};
    pg8::SchedWKVW S{(const char*)(ws + WS_KMP) + (size_t)layer * NB * NMEM * D * 2, (const char*)(ws + WS_KMS) + (size_t)layer * DB * NMEM * D * 2,
                     (const char*)(ws + WS_VMTP) + (size_t)layer * NB * NMEM * D * 2, (const char*)(ws + WS_VMTS) + (size_t)layer * DB * NMEM * D * 2,
                     (const char*)(ws + WS_WCAQ) + (size_t)layer * D * D * 2, (const char*)(ws + WS_WCAO) + (size_t)layer * D * D * 2, G, c, ca_vwrow0(layer)};
    pg8::EpiBf16 E{(bf16_t*)(ws + ca_base(layer)), D, 1.f, nullptr};
    pg8::gemm_phase(F.lds + RING_OFF, g, S, E, F.tid);
}
PHASE ph_resid_gemm(int which_, int layer_, float alpha) {
    const int which = __builtin_amdgcn_readfirstlane(which_), layer = __builtin_amdgcn_readfirstlane(layer_);
    const Frame F = make_frame(); CArgs* k = kargs(); unsigned char* ws = k->ws;
    const char* A; const char* W; int K, ssi;
    if (which == 0) { A = (const char*)(ws + WS_OB); W = (const char*)(ws + WS_WO); K = D; ssi = 1; }
    else if (which == 1) { A = (const char*)(ws + WS_VB); W = (const char*)(ws + WS_WCAO) + (size_t)layer * D * D * 2; K = D; ssi = layer == 0 ? 2 : 5; }
    else { A = (const char*)(ws + WS_A2); W = (const char*)(ws + WS_WDN) + (size_t)layer * D * FF * 2; K = FF; ssi = layer == 0 ? 3 : 6; }
    const bool splitk = which == 2 && layer == 1;
    pg8::GemmP g{K, K, K}; pg8::SchedMN S{A, W, K, K, splitk ? MP / 256 : M / 256, 4, F.G, F.bx, 0};
    if (which == 2) {
        int last = -1;
        for (int i = 0; ; ++i) { pg8::Unit u; if (!S.next(i, u)) break; const int pm = u.row0 >> 8;
            if (pm != last && pm < MP / 256 && (pm & 15) != 0) ffn_fix_tile(ws, k->in[22] + (size_t)layer * 3 * FF2, k->in[23] + (size_t)layer * FF2, pm, F.tid);
            last = pm; }
        asm volatile("s_waitcnt vmcnt(0)" ::: "memory"); __syncthreads();
    }
    pg8::EpiResid<false> E{(bf16_t*)(ws + WS_HB), (float*)(ws + WS_SS) + (size_t)ssi * M, nullptr, alpha};
    pg8::gemm_phase(F.lds + RING_OFF, g, S, E, F.tid);
    if (splitk && alpha != 0.f) {
        const Frame F2 = make_frame();
        pg8::GemmP g2{FF, FF, 256}; pg8::SchedSplitK S2{A, W, F2.G, F2.bx};
        pg8::EpiBf16 E2{(bf16_t*)(ws + WS_PART), D, 1.f, nullptr};
        pg8::gemm_phase(F2.lds + RING_OFF, g2, S2, E2, F2.tid);
    }
    if (alpha != 0.f && (which == 0 || (which == 2 && layer == 0))) {
        const Frame F2 = make_frame();
        const int extra = (M / 256) * 4 - 4 * F2.G;
        const int nl = which == 0 ? 0 : 1;
        int G2 = F2.G, c2 = F2.bx; if (extra > 0 && extra < F2.G) { G2 = F2.G - extra; c2 = F2.bx >= extra ? F2.bx - extra : -1; }
        wkvw_part(F2, k, nl, G2, c2);
    }
}
PHASE ph_pool_gemm(float alpha) {
    const Frame F = make_frame(); CArgs* k = kargs(); unsigned char* ws = k->ws;
    pg8::GemmP g{D, 256, 256}; pg8::SchedPool S{(const char*)(ws + WS_QB), (const char*)(ws + WS_WPOOL), F.G, F.bx};
    pg8::EpiResid<true> E{(bf16_t*)(ws + WS_HB), (float*)(ws + WS_SS) + (size_t)4 * M, k->in[17], alpha};
    pg8::gemm_phase(F.lds + RING_OFF, g, S, E, F.tid);
}
PHASE ph_final() { const Frame F = make_frame(); const Args a = load_args(); final_phase(F, a); }
PHASE ph_pool() { const Frame F = make_frame(); const Args a = load_args(); pool_phase(F, a); }
__device__ __forceinline__ void ffn_tail(int l) {
    const Frame F2 = make_frame(); const Args a = load_args();
    const int extra = 1152 - 4 * F2.G;
    if (extra > 0 && extra < F2.G) { if (F2.bx >= extra) ffn_weight_items(F2, a, l, (F2.bx - extra) * NWAVES + F2.wave, (F2.G - extra) * NWAVES); }
    else ffn_weight_items(F2, a, l, F2.bx * NWAVES + F2.wave, F2.G * NWAVES);
}
PHASE ph_cascore(int layer_) {
    const int layer = __builtin_amdgcn_readfirstlane(layer_);
    const Frame F = make_frame(); CArgs* k = kargs(); unsigned char* ws = k->ws;
    pg8::GemmP g{D, D, D}; pg8::SchedCA2<0> S{(const char*)(ws + WS_HB), (const char*)(ws + ca_base(layer)), F.G, F.bx, ca_vwrow0(layer)};
    pg8::EpiSoftmax E{(bf16_t*)(ws + WS_KB), XCH_OFF, (const float*)(ws + WS_SS) + (size_t)(layer == 0 ? 1 : 4) * M, 0.0625f * LOG2E};
    pg8::gemm_phase(F.lds + RING_OFF, g, S, E, F.tid);
    if (layer == 0) {
        const Frame F2 = make_frame(); const int extra = 1152 - 4 * F2.G;
        int G2 = F2.G, c2 = F2.bx; if (extra > 0 && extra < F2.G) { G2 = F2.G - extra; c2 = F2.bx >= extra ? F2.bx - extra : -1; }
        memkv_part(F2, k, G2, c2, 1, 2); }
}
PHASE ph_caout(int layer_, float alpha) {
    const int layer = __builtin_amdgcn_readfirstlane(layer_);
    const Frame F = make_frame(); CArgs* k = kargs(); unsigned char* ws = k->ws;
    pg8::GemmP g{D, D, D}; pg8::SchedCA2<1> S{(const char*)(ws + WS_KB), (const char*)(ws + ca_base(layer)), F.G, F.bx, ca_vwrow0(layer)};
    pg8::EpiResid<false> E{(bf16_t*)(ws + WS_HB), (float*)(ws + WS_SS) + (size_t)(layer == 0 ? 2 : 5) * M, nullptr, alpha};
    pg8::gemm_phase(F.lds + RING_OFF, g, S, E, F.tid);
    if (layer == 0 && alpha != 0.f) { ffn_tail(0); ffn_tail(1); }
}
PHASE ph_up(int layer_) {
    const int layer = __builtin_amdgcn_readfirstlane(layer_);
    const Frame F = make_frame(); CArgs* k = kargs(); unsigned char* ws = k->ws; float* out = k->out;
    pg8::GemmP g{D, D, D}; pg8::SchedMN S{(const char*)(ws + WS_HB), (const char*)(ws + WS_WUP) + (size_t)layer * FF2 * D * 2, D, D, M / 256, 22, F.G, F.bx, 0};
    pg8::EpiUpGate E{(bf16_t*)(ws + WS_A2), k->in[22] + (size_t)layer * 3 * FF2, k->in[23] + (size_t)layer * FF2, k->in[6] + (size_t)layer * DB * 2 * FF2,
                     out + OUT_FSP + (size_t)layer * NB * 2 * FF2, out + OUT_FSS + (size_t)layer * DB * 2 * FF2, (float*)(ws + WS_EDGE), (float*)(ws + WS_FIRST), XCH_OFF, (const float*)(ws + WS_SS) + (size_t)(layer == 0 ? 2 : 5) * M};
    pg8::gemm_phase(F.lds + RING_OFF, g, S, E, F.tid);
}

constexpr int N_PHASES = 15;
__global__ void __launch_bounds__(NWAVES * 64, 2) trunk_fwd(Args args_unused) {
    CArgs* k = kargs();
    volatile LAS unsigned* MISC = (volatile LAS unsigned*)((LAS unsigned char*)lds_raw + MISC_OFF);
    { const int tid = elect_tid(); __syncthreads();
      if (tid < 32) MISC[tid] = 0u;
      __syncthreads();
      if (k->ph_hi - k->ph_lo > 1) (void)xcd_barrier_post((unsigned*)(k->ws + WS_CTL) + CW_BAR, MISC + 8, tid); }
#ifndef PHASE_MASK
#define PHASE_MASK 0xffffffffull
#endif
#define IN(p) ((((PHASE_MASK) >> (p)) & 1ull) && k->ph_lo <= (p) && (p) < k->ph_hi)
#define SEAM(p) do { if (IN(p) && IN((p) + 1)) { XcdBarrier bar; bar.bar = (unsigned*)(k->ws + WS_CTL) + CW_BAR; bar.x = xb_xcc_id(); bar.st = MISC + 8; xcd_barrier(bar, elect_tid()); } } while (0)
#ifndef PROBE_REP
#define PROBE_REP 0ull
#endif
#define GBAR() do { XcdBarrier bar; bar.bar = (unsigned*)(k->ws + WS_CTL) + CW_BAR; bar.x = xb_xcc_id(); bar.st = MISC + 8; xcd_barrier(bar, elect_tid()); } while (0)
#define RUN(p, call, recall) do { if (IN(p)) { call; if (((PROBE_REP) >> (p)) & 1ull) { GBAR(); recall; } } SEAM(p); } while (0)
    RUN(0, ph_prologue(), ph_prologue());
    RUN(1, ph_qkv(), ph_qkv());
    RUN(2, ph_sbattn(), ph_sbattn());
    RUN(3, ph_resid_gemm(0, 0, 1.f), ph_resid_gemm(0, 0, 0.f));
    for (int layer = 0; layer < 2; ++layer) {
        const int pb = 4 + 6 * layer;
        if (layer == 1) {
            RUN(8, ph_pool(), ph_pool());
            RUN(9, ph_pool_gemm(1.f), ph_pool_gemm(0.f));
        }
        RUN(pb + 0, ph_cascore(layer), ph_cascore(layer));
        RUN(pb + 1, ph_caout(layer, 1.f), ph_caout(layer, 0.f));
        RUN(pb + 2, ph_up(layer), ph_up(layer));
        RUN(pb + 3, ph_resid_gemm(2, layer, 1.f), ph_resid_gemm(2, layer, 0.f));
    }
    if (IN(14)) ph_final();
#undef IN
#undef SEAM
#undef RUN
#undef GBAR
}

extern "C" void kernel_launch(void* const* d_in, const int* in_sizes, int n_in, void* d_out, int out_size, void* d_ws, size_t ws_size, hipStream_t stream) {
    static int grid = 0;
    if (grid == 0) {
        if (n_in != 25 || (size_t)out_size != OUT_TOTAL || ws_size < WS_END) { fprintf(stderr, "kernel_launch: unexpected shapes: n_in %d out %d ws %zu\n", n_in, out_size, ws_size); grid = -1; return; }
        int dev = 0, cus = 0;
        if (hipGetDevice(&dev) != hipSuccess || hipDeviceGetAttribute(&cus, hipDeviceAttributeMultiprocessorCount, dev) != hipSuccess) { grid = -1; return; }
        if (hipFuncSetAttribute((const void*)trunk_fwd, hipFuncAttributeMaxDynamicSharedMemorySize, LDS_BYTES) != hipSuccess) { fprintf(stderr, "kernel_launch: hipFuncSetAttribute failed\n"); grid = -1; return; }
        int per_cu = 0;
        if (hipOccupancyMaxActiveBlocksPerMultiprocessor(&per_cu, (const void*)trunk_fwd, NWAVES * 64, LDS_BYTES) != hipSuccess || per_cu < 1) fprintf(stderr, "kernel_launch: occupancy query reports %d\n", per_cu);
        (void)hipGetLastError();
        grid = cus;
    }
    if (grid < 0) return;
    (void)hipMemsetAsync((char*)d_ws + WS_CTL, 0, CTL_ZERO_BYTES, stream);
    Args a{};
    for (int i = 0; i < 25; ++i) a.in[i] = (const float*)d_in[i];
    a.out = (float*)d_out; a.ws = (unsigned char*)d_ws;
#if MK_ONE_LAUNCH
    a.ph_lo = 0; a.ph_hi = N_PHASES;
    hipLaunchKernelGGL(trunk_fwd, dim3(grid), dim3(NWAVES * 64), LDS_BYTES, stream, a);
#else
    for (int p = 0; p < N_PHASES; ++p) { a.ph_lo = p; a.ph_hi = p + 1; hipLaunchKernelGGL(trunk_fwd, dim3(grid), dim3(NWAVES * 64), LDS_BYTES, stream, a); }
#endif
}
```

```cpp
#include <hip/hip_runtime.h>
#include <cstdio>
#include <cstdint>

#ifndef MK_ONE_LAUNCH
#define MK_ONE_LAUNCH 1
#endif

#define GAS __attribute__((address_space(1)))
#define LAS __attribute__((address_space(3)))
typedef unsigned short bf16_t;
typedef short bf16x8 __attribute__((ext_vector_type(8)));
typedef short s16x4 __attribute__((ext_vector_type(4)));
typedef float f32x4 __attribute__((ext_vector_type(4)));
typedef float f32x16 __attribute__((ext_vector_type(16)));
typedef unsigned u32x4 __attribute__((ext_vector_type(4)));
typedef unsigned u32x2 __attribute__((ext_vector_type(2)));
typedef float f32x2_t __attribute__((ext_vector_type(2)));
typedef __bf16 bf16x2_t __attribute__((ext_vector_type(2)));
typedef GAS unsigned gu32;

__device__ __forceinline__ unsigned pk_bf16(float lo, float hi) { f32x2_t v = {lo, hi}; bf16x2_t b = __builtin_convertvector(v, bf16x2_t); return __builtin_bit_cast(unsigned, b); }
__device__ __forceinline__ float shx(float v, int mask, int lane) { return __int_as_float(__builtin_amdgcn_ds_bpermute((lane ^ mask) << 2, __float_as_int(v))); }
__device__ __forceinline__ float bf_lo(unsigned u) { return __uint_as_float(u << 16); }
__device__ __forceinline__ float bf_hi(unsigned u) { return __uint_as_float(u & 0xffff0000u); }

constexpr int D = 1024, MP = 65536, MS = 2048, M = MP + MS;
constexpr int SEQ = 4096, NB = 16, DB = 32, DSEQ = 64, PAST = 2048;
constexpr int FF = 2816, FF2 = 5632, NMEM = 256;
constexpr float RMS_EPS = 1e-6f;
constexpr float LOG2E = 1.4426950408889634f;
constexpr size_t OUT_Y = 0, OUT_KP = (size_t)M * D, OUT_VP = OUT_KP + (size_t)MP * D, OUT_KS = OUT_VP + (size_t)MP * D, OUT_VS = OUT_KS + (size_t)MS * D;
constexpr size_t OUT_PSP = OUT_VS + (size_t)MS * D, OUT_PSS = OUT_PSP + (size_t)NB * 15 * D, OUT_FSP = OUT_PSS + (size_t)DB * 15 * D;
constexpr size_t OUT_FSS = OUT_FSP + (size_t)2 * NB * 2 * FF2, OUT_MKP = OUT_FSS + (size_t)2 * DB * 2 * FF2, OUT_MVP = OUT_MKP + (size_t)2 * NB * NMEM * D;
constexpr size_t OUT_TOTAL = OUT_MVP + (size_t)2 * NB * NMEM * D;
static_assert(OUT_TOTAL == 226213888ull, "output size");
constexpr size_t MiB = 1u << 20;
constexpr size_t WS_CTL = 0, CTL_ZERO_BYTES = 1 * MiB;
constexpr size_t WS_WQKV = 2 * MiB, WS_WO = 8 * MiB, WS_WPOOL = 10 * MiB, WS_WCAQ = 11 * MiB, WS_WCAKV = 15 * MiB, WS_WCAO = 23 * MiB, WS_WUP = 27 * MiB, WS_WDN = 49 * MiB;
constexpr size_t WS_MN = 60 * MiB, WS_KMP = 76 * MiB, WS_VMTP = 92 * MiB, WS_KMS = 108 * MiB, WS_VMTS = 140 * MiB;
constexpr size_t WS_HB = 172 * MiB, WS_QB = 304 * MiB, WS_KB = 436 * MiB, WS_VB = 568 * MiB;
constexpr size_t WS_A2 = 304 * MiB, WS_EDGE = 700 * MiB, WS_FIRST = 712 * MiB, WS_OB = 724 * MiB, WS_SS = 856 * MiB, WS_VW1 = 858 * MiB, WS_END = 954 * MiB, WS_PART = WS_OB;
static_assert(WS_A2 + (size_t)M * FF * 2 <= WS_EDGE && WS_EDGE + (size_t)(M / 256) * 2 * FF2 * 4 <= WS_FIRST && WS_FIRST + (size_t)(M / 256) * 2 * FF2 * 4 <= WS_OB && WS_OB + (size_t)M * D * 2 <= WS_SS && WS_SS + (size_t)7 * M * 4 <= WS_END && WS_HB + (size_t)M * D * 2 <= WS_QB && WS_VB + (size_t)M * D * 2 <= WS_EDGE, "ws map");
constexpr int CW_BAR = 4096;

namespace pg8 {
constexpr int BM = 256, BK = 64, HALF = 128, HTB = HALF * BK * 2, STAGE_BYTES = 8 * HTB, NXCD = 8, WGM = 8;
__host__ __device__ __forceinline__ int lds_byte(int r, int c) { const int st = (r >> 4) * 2 + (c >> 5), rr = r & 15, cc = c & 31, ob = rr * 64 + cc * 2; return st * 1024 + (ob ^ (((ob >> 9) & 1) << 5)); }
__host__ __device__ __forceinline__ void stage_rc(int b, int& R, int& C) { const int st = b / 1024, sb = b % 1024, swz = sb ^ (((sb >> 9) & 1) << 5); R = (st >> 1) * 16 + swz / 64; C = (st & 1) * 32 + (swz % 64) / 2; }
__host__ __device__ __forceinline__ int perm32(int rho) { const int n = rho >> 4, i = rho & 15; return 8 * (i >> 2) + 4 * n + (i & 3); }

struct Unit { const char* a; const char* b; int row0, col0, vlo, vhi, aux; };
struct GemmP { int lda, ldb, K; };

__device__ __forceinline__ bool tile_of(long L, int nM, int nN, int& pm, int& pn) {
    const int nwg = nM * nN; if (L >= nwg) return false;
    int wgid = (int)L; { const int q = nwg / NXCD, r = nwg % NXCD, xcd = wgid % NXCD, off = wgid / NXCD; wgid = (xcd < r ? xcd * (q + 1) : r * (q + 1) + (xcd - r) * q) + off; }
    const int nig = WGM * nN, gid = wgid / nig, fm = gid * WGM, gsz = (nM - fm) < WGM ? (nM - fm) : WGM;
    pm = fm + ((wgid % nig) % gsz); pn = (wgid % nig) / gsz; return true;
}

template <class Epi, class Sched>
__device__ __forceinline__ void gemm_phase(LAS unsigned char* lds, const GemmP g, const Sched& S, const Epi& E, int tid) {
    const int wid = __builtin_amdgcn_readfirstlane(tid >> 6), lane = tid & 63, wr = wid >> 2, wc = wid & 3, fr = lane & 15, fq = lane >> 4;
    const int K = g.K, nt = K / BK;
    unsigned voffA[2], voffB[2];
#pragma unroll
    for (int i = 0; i < 2; ++i) { int R, C; stage_rc(tid * 16 + i * 8192, R, C); const int Rb = (R & ~31) + perm32(R & 31);
        voffA[i] = (unsigned)(R * g.lda + C) * 2u; voffB[i] = (unsigned)(Rb * g.ldb + C) * 2u; }
    const size_t kstep = (size_t)(BK * 2);
    const size_t hstepA = (size_t)HALF * g.lda * 2, hstepB = (size_t)HALF * g.ldb * 2;
    const unsigned ldsw = (unsigned)wid * 1024u;
    const int aoff = lds_byte(wr * 64 + fr, fq * 8), boff = lds_byte(wc * 32 + fr, fq * 8);
#define PG8_SA(b, h) (((b) * 2 + (h)) * HTB)
#define PG8_SB(b, h) ((4 + (b) * 2 + (h)) * HTB)
#define PG8_STAGE(bufoff, gbase, voff) do { _Pragma("unroll") for (int _i = 0; _i < 2; ++_i) \
        __builtin_amdgcn_global_load_lds((const unsigned*)((const char*)(gbase) + (voff)[_i]), (LAS unsigned*)(lds + (bufoff) + ldsw + _i * 8192), 16, 0, 0); } while (0)
#define PG8_LDA(dst, b, h) do { _Pragma("unroll") for (int m = 0; m < 4; ++m) _Pragma("unroll") for (int k = 0; k < 2; ++k) dst[m][k] = *(const LAS bf16x8*)(lds + PG8_SA(b, h) + aoff + m * 2048 + k * 1024); } while (0)
#define PG8_LDB(dst, b, h) do { _Pragma("unroll") for (int n = 0; n < 2; ++n) _Pragma("unroll") for (int k = 0; k < 2; ++k) dst[n][k] = *(const LAS bf16x8*)(lds + PG8_SB(b, h) + boff + n * 2048 + k * 1024); } while (0)
#define PG8_MMA(ai, bj, At, Bt) do { __builtin_amdgcn_s_setprio(1); _Pragma("unroll") for (int m = 0; m < 4; ++m) _Pragma("unroll") for (int n = 0; n < 2; ++n) _Pragma("unroll") for (int k = 0; k < 2; ++k) \
        acc[ai][bj][m][n] = __builtin_amdgcn_mfma_f32_16x16x32_bf16(Bt[n][k], At[m][k], acc[ai][bj][m][n], 0, 0, 0); __builtin_amdgcn_s_setprio(0); } while (0)
#define PG8_WAIT_V(n) asm volatile("s_waitcnt vmcnt(" #n ")" ::: "memory")
#define PG8_WAIT_L(n) asm volatile("s_waitcnt lgkmcnt(" #n ")" ::: "memory")
#define PG8_BAR __builtin_amdgcn_s_barrier()
#define PG8_SCHED __builtin_amdgcn_sched_barrier(0)
    Unit cur, nxt; int ui = 0;
    if (!S.next(0, cur)) return;
    f32x4 acc[2][2][4][2];
#pragma unroll
    for (int a = 0; a < 2; ++a)
#pragma unroll
        for (int b = 0; b < 2; ++b)
#pragma unroll
            for (int m = 0; m < 4; ++m)
#pragma unroll
                for (int n = 0; n < 2; ++n) acc[a][b][m][n] = (f32x4){0.f, 0.f, 0.f, 0.f};
    bf16x8 At[4][2], B0[2][2], B1[2][2];
    const char* cA = cur.a; const char* cB = cur.b;
    bool lv0 = true, lv1 = true;
#define PG8_LIVE() do { if (Sched::MASKED) { const int r_ = cur.row0 + wr * 64; lv0 = r_ < cur.vhi && r_ + 64 > cur.vlo; lv1 = r_ + HALF < cur.vhi && r_ + HALF + 64 > cur.vlo; } } while (0)
    PG8_LIVE();
    PG8_STAGE(PG8_SB(0, 0), cB, voffB); PG8_STAGE(PG8_SB(0, 1), cB + hstepB, voffB); PG8_STAGE(PG8_SA(0, 0), cA, voffA); PG8_STAGE(PG8_SA(0, 1), cA + hstepA, voffA);
    if (wr == 1) PG8_BAR;
    PG8_WAIT_V(2); PG8_BAR;
    PG8_STAGE(PG8_SB(1, 0), cB + kstep, voffB); PG8_STAGE(PG8_SA(1, 0), cA + kstep, voffA); PG8_STAGE(PG8_SB(1, 1), cB + hstepB + kstep, voffB);
    PG8_WAIT_V(6); PG8_BAR;
    for (;;) {
        const bool has_next = S.next(ui + 1, nxt);
        const char* nA = has_next ? nxt.a : cA; const char* nB = has_next ? nxt.b : cB;
        for (int t = 0; t < nt; t += 2) {
            const bool last = (t == nt - 2);
            const char* a1 = cA + (size_t)(t + 1) * kstep;
            const char* a2 = last ? nA : cA + (size_t)(t + 2) * kstep; const char* b2 = last ? nB : cB + (size_t)(t + 2) * kstep;
            const char* a3 = a2 + kstep; const char* b3 = b2 + kstep;
            if (lv0 || lv1) { PG8_LDB(B0, 0, 0); PG8_LDB(B1, 0, 1); } PG8_SCHED; if (lv0) PG8_LDA(At, 0, 0); PG8_STAGE(PG8_SA(1, 1), a1 + hstepA, voffA);
            PG8_WAIT_V(8); PG8_WAIT_L(0); PG8_BAR; if (lv0) { PG8_MMA(0, 0, At, B0); PG8_MMA(0, 1, At, B1); } PG8_BAR; PG8_SCHED;
            if (lv1) PG8_LDA(At, 0, 1); PG8_STAGE(PG8_SB(0, 0), b2, voffB); PG8_STAGE(PG8_SB(0, 1), b2 + hstepB, voffB); PG8_STAGE(PG8_SA(0, 0), a2, voffA);
            PG8_WAIT_V(8); PG8_WAIT_L(0); PG8_BAR; if (lv1) { PG8_MMA(1, 0, At, B0); PG8_MMA(1, 1, At, B1); } PG8_BAR; PG8_SCHED;
            if (lv0 || lv1) { PG8_LDB(B0, 1, 0); PG8_LDB(B1, 1, 1); } PG8_SCHED; if (lv0) PG8_LDA(At, 1, 0); PG8_STAGE(PG8_SA(0, 1), a2 + hstepA, voffA);
            PG8_WAIT_V(8); PG8_WAIT_L(0); PG8_BAR; if (lv0) { PG8_MMA(0, 0, At, B0); PG8_MMA(0, 1, At, B1); } PG8_BAR; PG8_SCHED;
            if (lv1) PG8_LDA(At, 1, 1); PG8_STAGE(PG8_SB(1, 0), b3, voffB); PG8_STAGE(PG8_SB(1, 1), b3 + hstepB, voffB); PG8_STAGE(PG8_SA(1, 0), a3, voffA);
            PG8_WAIT_V(8); PG8_WAIT_L(0); PG8_BAR; if (lv1) { PG8_MMA(1, 0, At, B0); PG8_MMA(1, 1, At, B1); } PG8_BAR; PG8_SCHED;
        }
        if (wr == 0) PG8_BAR;
        { unsigned ones = ~0u; asm volatile("" : "+s"(ones));
          const int ln = (int)__builtin_amdgcn_mbcnt_hi(ones, __builtin_amdgcn_mbcnt_lo(ones, 0u));
          E(acc, cur, wr, wc, ln & 15, ln >> 4, lds); }
        if (!has_next) break;
#pragma unroll
        for (int a = 0; a < 2; ++a)
#pragma unroll
            for (int b = 0; b < 2; ++b)
#pragma unroll
                for (int m = 0; m < 4; ++m)
#pragma unroll
                    for (int n = 0; n < 2; ++n) acc[a][b][m][n] = (f32x4){0.f, 0.f, 0.f, 0.f};
        cur = nxt; cA = nA; cB = nB; ++ui; PG8_LIVE();
        if (wr == 1) PG8_BAR;
    }
    PG8_WAIT_V(0);
    PG8_BAR;
#undef PG8_LIVE
#undef PG8_SA
#undef PG8_SB
#undef PG8_STAGE
#undef PG8_LDA
#undef PG8_LDB
#undef PG8_MMA
#undef PG8_WAIT_V
#undef PG8_WAIT_L
#undef PG8_BAR
#undef PG8_SCHED
}

struct SchedMN {
    static constexpr bool MASKED = false;
    const char* A; const char* Bt; int lda, ldb, nM, nN, G, c, col_base;
    __device__ __forceinline__ bool next(int i, Unit& u) const {
        int pm, pn; if (!tile_of((long)i * G + c, nM, nN, pm, pn)) return false;
        u.a = A + (size_t)pm * BM * lda * 2; u.b = Bt + (size_t)pn * BM * ldb * 2; u.row0 = pm * BM; u.col0 = col_base + pn * BM; u.vlo = 0; u.vhi = 0x7fffffff; u.aux = pn; return true;
    }
};
struct SchedWKVW {
    static constexpr bool MASKED = false;
    const char* KMP; const char* KMS; const char* VMP; const char* VMS; const char* WQN; const char* WOT; int G, c, VW_ROW0;
    __device__ __forceinline__ bool next(int i, Unit& u) const {
        const int L = i * G + c; if (c < 0 || L >= 1536) return false;
        const int q = L < 768 ? L : L - 768, bb = q >> 4, h = (q >> 2) & 3, ch = q & 3;
        u.vlo = 0; u.vhi = 0x7fffffff; u.aux = 0; u.col0 = L < 768 ? ch * 256 : h * 256;
        if (L < 768) { const char* Km = bb < NB ? KMP + (size_t)bb * NMEM * D * 2 : KMS + (size_t)(bb - NB) * NMEM * D * 2;
            u.a = Km + h * 256 * 2; u.b = WQN + ((size_t)ch * 256 * D + h * 256) * 2; u.row0 = (bb * 4 + h) * 256; }
        else { const char* Vm = bb < NB ? VMP + (size_t)bb * NMEM * D * 2 : VMS + (size_t)(bb - NB) * NMEM * D * 2;
            u.a = WOT + ((size_t)ch * 256 * D + h * 256) * 2; u.b = Vm + h * 256 * 2; u.row0 = VW_ROW0 + bb * 1024 + ch * 256; }
        return true;
    }
};
template <int MODE, int PART = -1> struct SchedCA2 {
    static constexpr bool MASKED = PART == 1;
    const char* A; const char* W; int G, c, VW_ROW0;
    __device__ __forceinline__ bool next(int i, Unit& u) const {
        const int L = (PART == 1 ? 1024 : 0) + i * G + c; if (L >= (PART == 0 ? 1024 : 1024 + 128)) return false;
        int row0, bb, hp;
        if (L < 1024) { const int pm = L >> 2; hp = L & 3; row0 = pm * BM; bb = pm >> 4; u.vlo = 0; u.vhi = 0x7fffffff; }
        else { const int s = L - 1024, b = s >> 2; hp = s & 3; const int r = MP + DSEQ * b; row0 = r < M - BM ? r : M - BM; bb = NB + b; u.vlo = r; u.vhi = r + DSEQ; }
        u.a = A + (size_t)row0 * D * 2;
        u.b = W + (MODE == 0 ? (size_t)((bb * 4 + hp) * 256) : (size_t)(VW_ROW0 + bb * 1024 + hp * 256)) * D * 2;
        u.row0 = row0; u.col0 = hp * 256; u.aux = 0; return true;
    }
};

#define EPI_ARGS f32x4 (&acc)[2][2][4][2], const Unit& u, int wr, int wc, int fr, int fq, LAS unsigned char* lds
struct EpiBf16 {
    bf16_t* O; int ldc; float scale; const float* ss;
    __device__ __forceinline__ void operator()(EPI_ARGS) const {
        const int row0 = u.row0 + wr * 64 + fr, col0 = u.col0 + wc * 32 + 8 * fq;
#pragma unroll
        for (int ai = 0; ai < 2; ++ai)
#pragma unroll
            for (int m = 0; m < 4; ++m) { const int row = row0 + ai * HALF + m * 16; bf16_t* rowp = O + (size_t)row * ldc + col0;
                const float rs = ss ? scale * __builtin_amdgcn_rsqf(ss[row] * (1.f / D) + RMS_EPS) : scale;
                if (row >= u.vlo && row < u.vhi) {
#pragma unroll
                for (int bj = 0; bj < 2; ++bj) { const f32x4 v0 = acc[ai][bj][m][0] * rs, v1 = acc[ai][bj][m][1] * rs;
                    u32x4 w; w.x = pk_bf16(v0[0], v0[1]); w.y = pk_bf16(v0[2], v0[3]); w.z = pk_bf16(v1[0], v1[1]); w.w = pk_bf16(v1[2], v1[3]);
                    *(u32x4*)(rowp + bj * HALF) = w; } } }
    }
};
struct SchedSplitK {
    static constexpr bool MASKED = false;
    const char* A; const char* Bt; int G, c;
    __device__ __forceinline__ bool next(int i, Unit& u) const {
        const int L = i * G + c; if (L >= 352) return false;
        const int part = L >> 5, t = L & 31, pm = t >> 2, pn = t & 3;
        u.a = A + ((size_t)(MP + pm * BM) * FF + part * 256) * 2; u.b = Bt + ((size_t)(pn * BM) * FF + part * 256) * 2;
        u.row0 = part * MS + pm * BM; u.col0 = pn * BM; u.vlo = 0; u.vhi = 0x7fffffff; u.aux = part; return true;
    }
};
struct EpiQKV {
    bf16_t* Qb; size_t bstride; float* out; float qscale; const float* ss;
    __device__ __forceinline__ void operator()(EPI_ARGS) const {
        const int typ = u.aux >> 2, colt = (u.aux & 3) * BM + wc * 32 + 8 * fq, row0 = u.row0 + wr * 64 + fr;
        bf16_t* B = Qb + (size_t)typ * bstride;
        const bool samp = u.row0 >= MP;
        float* F = typ == 1 ? (samp ? out + OUT_KS - (size_t)MP * D : out + OUT_KP) : (samp ? out + OUT_VS - (size_t)MP * D : out + OUT_VP);
        const float sc = typ == 0 ? qscale : 1.f;
#pragma unroll
        for (int ai = 0; ai < 2; ++ai)
#pragma unroll
            for (int m = 0; m < 4; ++m) { const size_t off = (size_t)(row0 + ai * HALF + m * 16) * D + colt;
                const float rs = __builtin_amdgcn_rsqf(ss[row0 + ai * HALF + m * 16] * (1.f / D) + RMS_EPS);
#pragma unroll
                for (int bj = 0; bj < 2; ++bj) { const f32x4 v0 = acc[ai][bj][m][0] * rs, v1 = acc[ai][bj][m][1] * rs;
                    if (typ != 0) { *(f32x4*)(F + off + bj * HALF) = v0; *(f32x4*)(F + off + bj * HALF + 4) = v1; }
                    u32x4 w; w.x = pk_bf16(v0[0] * sc, v0[1] * sc); w.y = pk_bf16(v0[2] * sc, v0[3] * sc); w.z = pk_bf16(v1[0] * sc, v1[1] * sc); w.w = pk_bf16(v1[2] * sc, v1[3] * sc);
                    *(u32x4*)(B + off + bj * HALF) = w; } }
    }
};
template <bool SC> struct EpiResid {
    bf16_t* XB; float* ssn; const float* cscale; float alpha;
    __device__ __forceinline__ void operator()(EPI_ARGS) const {
        const int row0 = u.row0 + wr * 64 + fr, col0 = u.col0 + wc * 32 + 8 * fq;
        GAS bf16_t* base = (GAS bf16_t*)XB + (size_t)row0 * D + col0;
        u32x4 xo[2][4][2];
#pragma unroll
        for (int ai = 0; ai < 2; ++ai)
#pragma unroll
            for (int m = 0; m < 4; ++m)
#pragma unroll
                for (int bj = 0; bj < 2; ++bj) xo[ai][m][bj] = *(GAS u32x4*)(base + (size_t)(ai * HALF + m * 16) * D + bj * HALF);
        float q[2][4];
#pragma unroll
        for (int ai = 0; ai < 2; ++ai)
#pragma unroll
            for (int m = 0; m < 4; ++m) q[ai][m] = 0.f;
#pragma unroll
        for (int bj = 0; bj < 2; ++bj) {
            const float al = alpha; const f32x4 ones = {1.f, 1.f, 1.f, 1.f};
            const f32x4 sc0 = (SC ? *(const GAS f32x4*)(cscale + col0 + bj * HALF) : ones) * al, sc1 = (SC ? *(const GAS f32x4*)(cscale + col0 + bj * HALF + 4) : ones) * al;
#pragma unroll
            for (int ai = 0; ai < 2; ++ai)
#pragma unroll
                for (int m = 0; m < 4; ++m) { const u32x4 o = xo[ai][m][bj]; const f32x4 d0 = acc[ai][bj][m][0] * sc0, d1 = acc[ai][bj][m][1] * sc1;
                    u32x4 w; w.x = pk_bf16(bf_lo(o.x) + d0[0], bf_hi(o.x) + d0[1]); w.y = pk_bf16(bf_lo(o.y) + d0[2], bf_hi(o.y) + d0[3]); w.z = pk_bf16(bf_lo(o.z) + d1[0], bf_hi(o.z) + d1[1]); w.w = pk_bf16(bf_lo(o.w) + d1[2], bf_hi(o.w) + d1[3]);
                    const int row = row0 + ai * HALF + m * 16;
                    if (row >= u.vlo && row < u.vhi) *(GAS u32x4*)(base + (size_t)(ai * HALF + m * 16) * D + bj * HALF) = w;
                    q[ai][m] += (bf_lo(w.x) * bf_lo(w.x) + bf_hi(w.x) * bf_hi(w.x)) + (bf_lo(w.y) * bf_lo(w.y) + bf_hi(w.y) * bf_hi(w.y)) + (bf_lo(w.z) * bf_lo(w.z) + bf_hi(w.z) * bf_hi(w.z)) + (bf_lo(w.w) * bf_lo(w.w) + bf_hi(w.w) * bf_hi(w.w)); }
        }
#pragma unroll
        for (int ai = 0; ai < 2; ++ai)
#pragma unroll
            for (int m = 0; m < 4; ++m) { float t = q[ai][m]; t += shx(t, 16, fq * 16 + fr); t += shx(t, 32, fq * 16 + fr);
                const int row = row0 + ai * HALF + m * 16;
                if (fq == 0 && alpha != 0.f && row >= u.vlo && row < u.vhi) __builtin_amdgcn_global_atomic_fadd_f32((GAS float*)ssn + row, t); }
    }
};
struct EpiMemK {
    float* F; bf16_t* B;
    __device__ __forceinline__ void operator()(EPI_ARGS) const {
        const int row0 = u.row0 + wr * 64 + fr, col0 = u.col0 + wc * 32 + 8 * fq;
#pragma unroll
        for (int ai = 0; ai < 2; ++ai)
#pragma unroll
            for (int m = 0; m < 4; ++m) { const size_t off = (size_t)(row0 + ai * HALF + m * 16) * D + col0;
#pragma unroll
                for (int bj = 0; bj < 2; ++bj) { const f32x4 v0 = acc[ai][bj][m][0], v1 = acc[ai][bj][m][1];
                    *(f32x4*)(F + off + bj * HALF) = v0; *(f32x4*)(F + off + bj * HALF + 4) = v1;
                    u32x4 w; w.x = pk_bf16(v0[0], v0[1]); w.y = pk_bf16(v0[2], v0[3]); w.z = pk_bf16(v1[0], v1[1]); w.w = pk_bf16(v1[2], v1[3]);
                    *(u32x4*)(B + off + bj * HALF) = w; } }
    }
};
__device__ __forceinline__ float dpp_ror1(float v) { return __int_as_float(__builtin_amdgcn_update_dpp(0, __float_as_int(v), 0x121, 0xf, 0xf, false)); }
__device__ __forceinline__ float dpp_ror2(float v) { return __int_as_float(__builtin_amdgcn_update_dpp(0, __float_as_int(v), 0x122, 0xf, 0xf, false)); }
__device__ __forceinline__ f32x4 ror1(const f32x4 v) { return (f32x4){dpp_ror1(v[0]), dpp_ror1(v[1]), dpp_ror1(v[2]), dpp_ror1(v[3])}; }
__device__ __forceinline__ f32x4 ror2(const f32x4 v) { return (f32x4){dpp_ror2(v[0]), dpp_ror2(v[1]), dpp_ror2(v[2]), dpp_ror2(v[3])}; }
__device__ __forceinline__ f32x4 sel4(bool c, const f32x4 a, const f32x4 b) { return (f32x4){c ? a[0] : b[0], c ? a[1] : b[1], c ? a[2] : b[2], c ? a[3] : b[3]}; }
struct EpiUpGate {
    bf16_t* A2; const float* cw; const float* cb; const float* sfs; float* fsp; float* fss; float* edge; float* first; int xoff; const float* ss;
    __device__ __forceinline__ void operator()(EPI_ARGS) const {
#pragma unroll
        for (int ai = 0; ai < 2; ++ai)
#pragma unroll
            for (int m = 0; m < 4; ++m) { const float rs = __builtin_amdgcn_rsqf(ss[u.row0 + ai * HALF + wr * 64 + m * 16 + fr] * (1.f / D) + RMS_EPS);
#pragma unroll
                for (int bj = 0; bj < 2; ++bj) { acc[ai][bj][m][0] = acc[ai][bj][m][0] * rs; acc[ai][bj][m][1] = acc[ai][bj][m][1] * rs; } }
        LAS float* X = (LAS float*)(lds + xoff);
        const int pn = u.col0 >> 8, pm = u.row0 >> 8, cl = wc * 32 + 8 * fq, ch = pn * 128 + cl;
        const bool samp = u.row0 >= MP;
        if (fr >= 14) {
#pragma unroll
            for (int ai = 0; ai < 2; ++ai) {
#pragma unroll
                for (int bj = 0; bj < 2; ++bj)
#pragma unroll
                    for (int n = 0; n < 2; ++n) *(LAS f32x4*)(X + ((ai * 2 + wr) * 2 + (fr - 14)) * 256 + bj * HALF + cl + 4 * n) = acc[ai][bj][3][n];
                const bool is_state = samp || (ai == 1 && wr == 1 && (pm & 15) == 15);
                if (is_state) {
                    float* st = samp ? fss + ((size_t)((u.row0 + ai * HALF + wr * 64 - MP) >> 6) * 2 + (fr - 14)) * FF2 : fsp + ((size_t)(pm >> 4) * 2 + (fr - 14)) * FF2;
#pragma unroll
                    for (int bj = 0; bj < 2; ++bj) { float* sp = st + bj * FF + ch; *(f32x4*)sp = acc[ai][bj][3][0]; *(f32x4*)(sp + 4) = acc[ai][bj][3][1]; } }
                asm volatile("" ::: "memory");
            }
            if (wr == 1) {
#pragma unroll
                for (int bj = 0; bj < 2; ++bj)
#pragma unroll
                    for (int n = 0; n < 2; ++n) *(f32x4*)(edge + ((size_t)pm * 2 + (fr - 14)) * FF2 + u.col0 + bj * HALF + cl + 4 * n) = acc[1][bj][3][n];
            }
        }
        if (wr == 0 && fr < 2) {
#pragma unroll
            for (int bj = 0; bj < 2; ++bj)
#pragma unroll
                for (int n = 0; n < 2; ++n) *(f32x4*)(first + ((size_t)pm * 2 + fr) * FF2 + u.col0 + bj * HALF + cl + 4 * n) = acc[0][bj][0][n];
        }
        unsigned P[2][2][4][4];
#pragma unroll
        for (int ai = 0; ai < 2; ++ai)
#pragma unroll
            for (int bj = 0; bj < 2; ++bj)
#pragma unroll
                for (int m = 0; m < 4; ++m)
#pragma unroll
                    for (int n = 0; n < 2; ++n) { const f32x4 v = acc[ai][bj][m][n];
                        asm volatile("v_cvt_pk_bf16_f32 %0, %1, %2" : "=v"(P[ai][bj][m][2 * n]) : "v"(v[0]), "v"(v[1])); asm volatile("v_cvt_pk_bf16_f32 %0, %1, %2" : "=v"(P[ai][bj][m][2 * n + 1]) : "v"(v[2]), "v"(v[3])); }
        f32x4 WG[3][2], WV[3][2], BG[2], BV[2];
#pragma unroll
        for (int n = 0; n < 2; ++n) {
#pragma unroll
            for (int j = 0; j < 3; ++j) { WG[j][n] = *(const GAS f32x4*)(cw + (size_t)j * FF2 + ch + 4 * n); WV[j][n] = *(const GAS f32x4*)(cw + (size_t)j * FF2 + FF + ch + 4 * n); }
            BG[n] = *(const GAS f32x4*)(cb + ch + 4 * n); BV[n] = *(const GAS f32x4*)(cb + FF + ch + 4 * n); }
        asm volatile("s_waitcnt lgkmcnt(0)" ::: "memory"); __builtin_amdgcn_s_barrier(); asm volatile("" ::: "memory");
        const bool f0 = fr == 0, f01 = fr < 2;
#pragma unroll
        for (int ai = 0; ai < 2; ++ai) {
            const int brow0 = u.row0 + ai * HALF + wr * 64;
            const int sb = samp ? ((brow0 - MP) >> 6) : 0, pred = (ai * 2 + wr) > 0 ? (ai * 2 + wr - 1) : 0;
            const bool use_x = !samp && (brow0 & (SEQ - 1)) != 0 && (ai | wr) != 0;
            const int hsel = fr >= 14 ? fr - 14 : 0;
            unsigned pk[4][4];
#pragma unroll
            for (int q = 0; q < 4; ++q) {
                const int c2 = ch + 2 * q;
                f32x2_t wg[3], wv[3];
#pragma unroll
                for (int j = 0; j < 3; ++j) { wg[j] = (f32x2_t){WG[j][q >> 1][2 * (q & 1)], WG[j][q >> 1][2 * (q & 1) + 1]}; wv[j] = (f32x2_t){WV[j][q >> 1][2 * (q & 1)], WV[j][q >> 1][2 * (q & 1) + 1]}; }
                const f32x2_t bg = {BG[q >> 1][2 * (q & 1)], BG[q >> 1][2 * (q & 1) + 1]}, bv = {BV[q >> 1][2 * (q & 1)], BV[q >> 1][2 * (q & 1) + 1]};
                const LAS float* xp = X + (pred * 2 + hsel) * 256 + cl + 2 * q;
                const f32x2_t xgv = *(const LAS f32x2_t*)xp, xvv = *(const LAS f32x2_t*)(xp + HALF);
                unsigned hg = use_x ? pk_bf16(xgv.x, xgv.y) : 0u, hv = use_x ? pk_bf16(xvv.x, xvv.y) : 0u;
                if (samp) { const float* sp = sfs + ((size_t)sb * 2 + hsel) * FF2 + c2; const f32x2_t sgv = *(const GAS f32x2_t*)sp, svv = *(const GAS f32x2_t*)(sp + FF); hg = pk_bf16(sgv.x, sgv.y); hv = pk_bf16(svv.x, svv.y); }
                unsigned rg1 = __builtin_amdgcn_mov_dpp(hg, 0x121, 0xf, 0xf, false), rg2 = __builtin_amdgcn_mov_dpp(hg, 0x122, 0xf, 0xf, false);
                unsigned rv1 = __builtin_amdgcn_mov_dpp(hv, 0x121, 0xf, 0xf, false), rv2 = __builtin_amdgcn_mov_dpp(hv, 0x122, 0xf, 0xf, false);
#pragma unroll
                for (int m = 0; m < 4; ++m) {
                    const unsigned ug = P[ai][0][m][q], uv = P[ai][1][m][q];
                    const unsigned cg1 = __builtin_amdgcn_mov_dpp(ug, 0x121, 0xf, 0xf, false), cg2 = __builtin_amdgcn_mov_dpp(ug, 0x122, 0xf, 0xf, false);
                    const unsigned cv1 = __builtin_amdgcn_mov_dpp(uv, 0x121, 0xf, 0xf, false), cv2 = __builtin_amdgcn_mov_dpp(uv, 0x122, 0xf, 0xf, false);
                    const unsigned g1 = f0 ? rg1 : cg1, g2 = f01 ? rg2 : cg2, v1 = f0 ? rv1 : cv1, v2 = f01 ? rv2 : cv2;
                    const float ga = bg.x + wg[0].x * bf_lo(g2) + wg[1].x * bf_lo(g1) + wg[2].x * bf_lo(ug), gb = bg.y + wg[0].y * bf_hi(g2) + wg[1].y * bf_hi(g1) + wg[2].y * bf_hi(ug);
                    const float va = bv.x + wv[0].x * bf_lo(v2) + wv[1].x * bf_lo(v1) + wv[2].x * bf_lo(uv), vb = bv.y + wv[0].y * bf_hi(v2) + wv[1].y * bf_hi(v1) + wv[2].y * bf_hi(uv);
                    const float y0 = ga * va * __builtin_amdgcn_rcpf(1.f + __builtin_amdgcn_exp2f(-ga * LOG2E)), y1 = gb * vb * __builtin_amdgcn_rcpf(1.f + __builtin_amdgcn_exp2f(-gb * LOG2E));
                    pk[m][q] = pk_bf16(y0, y1);
                    rg1 = cg1; rg2 = cg2; rv1 = cv1; rv2 = cv2;
                }
            }
#pragma unroll
            for (int m = 0; m < 4; ++m) { u32x4 w; w.x = pk[m][0]; w.y = pk[m][1]; w.z = pk[m][2]; w.w = pk[m][3];
                *(u32x4*)(A2 + (size_t)(brow0 + m * 16 + fr) * FF + ch) = w; }
            asm volatile("" ::: "memory");
        }
    }
};
struct EpiSoftmax {
    bf16_t* P; int xoff; const float* ss; float scale;
    __device__ __forceinline__ void operator()(EPI_ARGS) const {
        LAS f32x2_t* X = (LAS f32x2_t*)(lds + xoff);
#pragma unroll
        for (int ai = 0; ai < 2; ++ai)
#pragma unroll
            for (int m = 0; m < 4; ++m) { const float rs = scale * __builtin_amdgcn_rsqf(ss[u.row0 + ai * HALF + wr * 64 + m * 16 + fr] * (1.f / D) + RMS_EPS);
#pragma unroll
                for (int bj = 0; bj < 2; ++bj) { acc[ai][bj][m][0] = acc[ai][bj][m][0] * rs; acc[ai][bj][m][1] = acc[ai][bj][m][1] * rs; } }
        float mw[2][4];
#pragma unroll
        for (int ai = 0; ai < 2; ++ai)
#pragma unroll
            for (int m = 0; m < 4; ++m) {
                float mx = -3.0e38f;
#pragma unroll
                for (int bj = 0; bj < 2; ++bj)
#pragma unroll
                    for (int n = 0; n < 2; ++n) { const f32x4 x = acc[ai][bj][m][n]; mx = fmaxf(mx, fmaxf(fmaxf(x[0], x[1]), fmaxf(x[2], x[3]))); }
                mx = fmaxf(mx, shx(mx, 16, fq * 16 + fr)); mx = fmaxf(mx, shx(mx, 32, fq * 16 + fr));
                float s = 0.f;
#pragma unroll
                for (int bj = 0; bj < 2; ++bj)
#pragma unroll
                    for (int n = 0; n < 2; ++n) { f32x4 x = acc[ai][bj][m][n];
#pragma unroll
                        for (int e = 0; e < 4; ++e) { x[e] = __builtin_amdgcn_exp2f(x[e] - mx); s += x[e]; } acc[ai][bj][m][n] = x; }
                s += shx(s, 16, fq * 16 + fr); s += shx(s, 32, fq * 16 + fr);
                mw[ai][m] = mx;
                if (fq == 0) X[(ai * HALF + wr * 64 + m * 16 + fr) * 4 + wc] = (f32x2_t){mx, s};
            }
        asm volatile("s_waitcnt lgkmcnt(0)" ::: "memory"); __builtin_amdgcn_s_barrier(); asm volatile("" ::: "memory");
        const int row0 = u.row0 + wr * 64 + fr, col0 = u.col0 + wc * 32 + 8 * fq;
#pragma unroll
        for (int ai = 0; ai < 2; ++ai)
#pragma unroll
            for (int m = 0; m < 4; ++m) { const int rl = ai * HALF + wr * 64 + m * 16 + fr;
                const f32x2_t a = X[rl * 4 + 0], b = X[rl * 4 + 1], c = X[rl * 4 + 2], d = X[rl * 4 + 3];
                const float mt = fmaxf(fmaxf(a.x, b.x), fmaxf(c.x, d.x));
                const float L = a.y * __builtin_amdgcn_exp2f(a.x - mt) + b.y * __builtin_amdgcn_exp2f(b.x - mt) + c.y * __builtin_amdgcn_exp2f(c.x - mt) + d.y * __builtin_amdgcn_exp2f(d.x - mt);
                const float f = __builtin_amdgcn_exp2f(mw[ai][m] - mt) / L;
                const int row = row0 + ai * HALF + m * 16;
                if (row >= u.vlo && row < u.vhi) {
#pragma unroll
                for (int bj = 0; bj < 2; ++bj) { const f32x4 v0 = acc[ai][bj][m][0] * f, v1 = acc[ai][bj][m][1] * f;
                    u32x4 w; w.x = pk_bf16(v0[0], v0[1]); w.y = pk_bf16(v0[2], v0[3]); w.z = pk_bf16(v1[0], v1[1]); w.w = pk_bf16(v1[2], v1[3]);
                    *(u32x4*)(P + (size_t)row * D + col0 + bj * HALF) = w; } } }
    }
};
struct SchedQKV {
    static constexpr bool MASKED = false;
    const char* A; const char* Bt; int nM, G, c;
    __device__ __forceinline__ bool next(int i, Unit& u) const {
        int pm, pj; if (!tile_of((long)i * G + c, nM, 12, pm, pj)) return false;
        const int pn = (pj % 3) * 4 + pj / 3;
        u.a = A + (size_t)pm * BM * D * 2; u.b = Bt + (size_t)pn * BM * D * 2; u.row0 = pm * BM; u.col0 = pn * BM; u.vlo = 0; u.vhi = 0x7fffffff; u.aux = pn; return true;
    }
};
struct SchedPool {
    static constexpr bool MASKED = false; const char* A; const char* Bt; int G, c;
    __device__ __forceinline__ bool next(int i, Unit& u) const { int pm, pn; if (!tile_of((long)i * G + c, M / 256, 4, pm, pn)) return false;
        u.a = A + ((size_t)pm * 256 * D + pn * 256) * 2; u.b = Bt + (size_t)pn * 65536 * 2; u.row0 = pm * 256; u.col0 = pn * 256; u.vlo = 0; u.vhi = 0x7fffffff; u.aux = 0; return true; } };
}

namespace sba {
constexpr float QSCALE = 0.125f * LOG2E;
constexpr float EXIT_T = 126.f;
constexpr int VDH = 4160, KIMG = 2 * VDH, KROW = 144, WAVE_LDS = KIMG + 64 * KROW;
__device__ __forceinline__ int crow(int r, int hi) { return (r & 3) + 8 * (r >> 2) + 4 * hi; }
__device__ __forceinline__ s16x4 vtr(LAS const char* p) { typedef short v4i16_t __attribute__((ext_vector_type(4))); return __builtin_bit_cast(s16x4, __builtin_amdgcn_ds_read_tr16_b64_v4i16((LAS v4i16_t*)p)); }

__device__ __forceinline__ bf16x8 cvt8(const f32x4 a, const f32x4 b) { u32x4 w; w.x = pk_bf16(a[0], a[1]); w.y = pk_bf16(a[2], a[3]); w.z = pk_bf16(b[0], b[1]); w.w = pk_bf16(b[2], b[3]); return __builtin_bit_cast(bf16x8, w); }
__device__ __forceinline__ void load_bf16(const bf16_t* Kt, const bf16_t* Vt, LAS char* vimg, int lane) {
    const int c = lane & 7;
    LAS char* vdst = vimg + (c >> 2) * VDH + (lane >> 3) * 64 + (c & 3) * 16; LAS char* kdst = vimg + KIMG + (lane >> 3) * KROW + c * 16;
    const unsigned vvo = (unsigned)((lane >> 3) * D + 8 * c) * 2u;
#pragma unroll
    for (int it = 0; it < 8; ++it) { const u32x4 v = *(const GAS u32x4*)((const GAS char*)Vt + (size_t)it * 8 * D * 2 + vvo); *(LAS u32x4*)(vdst + it * 512) = v; }
#pragma unroll
    for (int it = 0; it < 8; ++it) { const u32x4 v = *(const GAS u32x4*)((const GAS char*)Kt + (size_t)it * 8 * D * 2 + vvo); *(LAS u32x4*)(kdst + it * 8 * KROW) = v; }
}
__device__ __forceinline__ void load_f32(const float* Kt, const float* Vt, LAS char* vimg, int lane) {
    const int c = lane & 7;
    LAS char* vdst = vimg + (c >> 2) * VDH + (lane >> 3) * 64 + (c & 3) * 16; LAS char* kdst = vimg + KIMG + (lane >> 3) * KROW + c * 16;
    const unsigned vvo = (unsigned)((lane >> 3) * D + 8 * c) * 4u;
#pragma unroll
    for (int hv = 0; hv < 2; ++hv) {
#pragma unroll
        for (int it = 4 * hv; it < 4 * hv + 4; ++it) { const GAS f32x4* p = (const GAS f32x4*)((const GAS char*)Vt + (size_t)it * 8 * D * 4 + vvo); *(LAS u32x4*)(vdst + it * 512) = __builtin_bit_cast(u32x4, cvt8(p[0], p[1])); }
        asm volatile("" ::: "memory"); }
#pragma unroll
    for (int hv = 0; hv < 2; ++hv) {
#pragma unroll
        for (int it = 4 * hv; it < 4 * hv + 4; ++it) { const GAS f32x4* p = (const GAS f32x4*)((const GAS char*)Kt + (size_t)it * 8 * D * 4 + vvo); *(LAS u32x4*)(kdst + it * 8 * KROW) = __builtin_bit_cast(u32x4, cvt8(p[0], p[1])); }
        asm volatile("" ::: "memory"); }
}
__device__ __forceinline__ void load_bf16_regs(u32x4 (&kr)[8], u32x4 (&vr)[8], const bf16_t* Kt, const bf16_t* Vt, int lane) {
    const unsigned vvo = (unsigned)((lane >> 3) * D + 8 * (lane & 7)) * 2u;
#pragma unroll
    for (int it = 0; it < 8; ++it) vr[it] = *(const GAS u32x4*)((const GAS char*)Vt + (size_t)it * 8 * D * 2 + vvo);
#pragma unroll
    for (int it = 0; it < 8; ++it) kr[it] = *(const GAS u32x4*)((const GAS char*)Kt + (size_t)it * 8 * D * 2 + vvo);
}
template <bool PF>
__device__ __forceinline__ void tile_step(u32x4 (&kr)[8], u32x4 (&vr)[8], const bf16x8 (&qr)[4], f32x16 (&o)[2], float& carry, bool masked, bool upper_dead, int tq, LAS char* vimg, int lane, const bf16_t* nK, const bf16_t* nV, bool do_pf) {
    const int hi = lane >> 5;
    if (PF) { const int c = lane & 7; LAS char* vdst = vimg + (c >> 2) * VDH + (lane >> 3) * 64 + (c & 3) * 16; LAS char* kdst = vimg + KIMG + (lane >> 3) * KROW + c * 16;
#pragma unroll
        for (int it = 0; it < 8; ++it) *(LAS u32x4*)(kdst + it * 8 * KROW) = kr[it];
#pragma unroll
        for (int it = 0; it < 8; ++it) *(LAS u32x4*)(vdst + it * 512) = vr[it]; }
    asm volatile("s_waitcnt lgkmcnt(0)" ::: "memory");
    bf16x8 kf[8];
    { LAS const char* kb = vimg + KIMG + (lane & 31) * KROW + hi * 16;
#pragma unroll
      for (int hf = 0; hf < 2; ++hf)
#pragma unroll
          for (int d0 = 0; d0 < 4; ++d0) kf[hf * 4 + d0] = *(LAS const bf16x8*)(kb + hf * 32 * KROW + d0 * 32); }
    f32x16 p0 = {}, p1 = {};
#pragma unroll
    for (int d0 = 0; d0 < 4; ++d0) p0 = __builtin_amdgcn_mfma_f32_32x32x16_bf16(kf[d0], qr[d0], p0, 0, 0, 0);
    if (!upper_dead) {
#pragma unroll
        for (int d0 = 0; d0 < 4; ++d0) p1 = __builtin_amdgcn_mfma_f32_32x32x16_bf16(kf[4 + d0], qr[d0], p1, 0, 0, 0);
    }
    if (PF && do_pf) { load_bf16_regs(kr, vr, nK, nV, lane); }
    float k0[16], k1[16];
#pragma unroll
    for (int r = 0; r < 16; ++r) {
        const float z = __builtin_amdgcn_fmed3f(p0[r], -100.f, 100.f); const float e = __builtin_amdgcn_exp2f(-z); float sg = __builtin_amdgcn_rcpf(1.f + e); float kp = e * sg;
        if (masked && !(crow(r, hi) < tq)) { sg = 0.f; kp = 1.f; } p0[r] = sg; k0[r] = kp; }
    if (!upper_dead) {
#pragma unroll
        for (int r = 0; r < 16; ++r) {
            const float z = __builtin_amdgcn_fmed3f(p1[r], -100.f, 100.f); const float e = __builtin_amdgcn_exp2f(-z); float sg = __builtin_amdgcn_rcpf(1.f + e); float kp = e * sg;
            if (masked && !(crow(r, hi) + 32 < tq)) { sg = 0.f; kp = 1.f; } p1[r] = sg; k1[r] = kp; }
    } else {
#pragma unroll
        for (int r = 0; r < 16; ++r) { p1[r] = 0.f; k1[r] = 1.f; }
    }
    float Glo[8], Ghi[8];
#pragma unroll
    for (int a = 0; a < 8; ++a) { const float* kk = a < 4 ? k0 + 4 * a : k1 + 4 * (a - 4); const float g = (kk[0] * kk[1]) * (kk[2] * kk[3]);
        auto rr = __builtin_amdgcn_permlane32_swap(__float_as_uint(g), __float_as_uint(g), false, false); Glo[a] = __uint_as_float(rr[0]); Ghi[a] = __uint_as_float(rr[1]); }
    float sx = __builtin_amdgcn_exp2f(-carry);
#pragma unroll
    for (int a = 7; a >= 0; --a) {
        const float base = hi == 0 ? sx * Ghi[a] : sx;
        if (a >= 4) { const int q = 4 * (a - 4);
            const float s3 = base, s2 = s3 * k1[q + 3], s1 = s2 * k1[q + 2], s0 = s1 * k1[q + 1];
            p1[q + 3] *= s3; p1[q + 2] *= s2; p1[q + 1] *= s1; p1[q] *= s0;
        } else { const int q = 4 * a;
            const float s3 = base, s2 = s3 * k0[q + 3], s1 = s2 * k0[q + 2], s0 = s1 * k0[q + 1];
            p0[q + 3] *= s3; p0[q + 2] *= s2; p0[q + 1] *= s1; p0[q] *= s0;
        }
        sx *= Glo[a] * Ghi[a];
    }
    carry = -__builtin_amdgcn_logf(sx);
    bf16x8 pf[4];
#pragma unroll
    for (int s = 0; s < 4; ++s) { const f32x16& p = s < 2 ? p0 : p1; const int q = 8 * (s & 1);
        u32x4 w; w.x = pk_bf16(p[q], p[q + 1]); w.y = pk_bf16(p[q + 2], p[q + 3]); w.z = pk_bf16(p[q + 4], p[q + 5]); w.w = pk_bf16(p[q + 6], p[q + 7]); pf[s] = __builtin_bit_cast(bf16x8, w); }
    LAS const char* vb = vimg + (4 * hi + ((lane & 15) >> 2)) * 64 + ((lane >> 4) & 1) * 32 + (lane & 3) * 8;
#pragma unroll
    for (int dh = 0; dh < 2; ++dh) {
#pragma unroll
        for (int s = 0; s < 2; ++s) { const s16x4 lo = vtr(vb + dh * VDH + s * 1024), hh = vtr(vb + dh * VDH + s * 1024 + 512);
            const bf16x8 vf = (bf16x8){lo[0], lo[1], lo[2], lo[3], hh[0], hh[1], hh[2], hh[3]};
            o[dh] = __builtin_amdgcn_mfma_f32_32x32x16_bf16(vf, pf[s], o[dh], 0, 0, 0); }
        if (!upper_dead) {
#pragma unroll
            for (int s = 2; s < 4; ++s) { const s16x4 lo = vtr(vb + dh * VDH + s * 1024), hh = vtr(vb + dh * VDH + s * 1024 + 512);
                const bf16x8 vf = (bf16x8){lo[0], lo[1], lo[2], lo[3], hh[0], hh[1], hh[2], hh[3]};
                o[dh] = __builtin_amdgcn_mfma_f32_32x32x16_bf16(vf, pf[s], o[dh], 0, 0, 0); }
        }
    }
    asm volatile("s_waitcnt lgkmcnt(0)" ::: "memory");
}

struct Tensors { const bf16_t* Q; const bf16_t* K; const bf16_t* V; bf16_t* O; const float* cK; const float* cV; };

__device__ __forceinline__ void unit(int id, const Tensors& T, LAS char* vimg, int lane) {
    const int r32 = lane & 31, hi = lane >> 5;
    const bool samp = id >= 32768;
    int h, q0; size_t rowb; int b = 0;
    if (!samp) { const int qb = id & 127; h = (id >> 7) & 15; b = id >> 11; rowb = (size_t)b * SEQ; q0 = qb * 32; }
    else { const int s = id - 32768; const int qb = s & 1; h = (s >> 1) & 15; b = s >> 5; rowb = (size_t)MP + (size_t)b * DSEQ; q0 = qb * 32; }
    const bf16_t* Qw = T.Q + (rowb + q0) * D + h * 64; bf16_t* Ow = T.O + (rowb + q0) * D + h * 64;
    asm volatile("" : "+s"(Qw), "+s"(Ow));
    bf16x8 qr[4];
#pragma unroll
    for (int d0 = 0; d0 < 4; ++d0) qr[d0] = *(const GAS bf16x8*)((const GAS char*)Qw + 32 * d0 + (unsigned)(r32 * D + 8 * hi) * 2u);
    f32x16 o[2]; o[0] = f32x16{}; o[1] = f32x16{};
    float carry = 0.f;
    const bf16_t* Kh = T.K + rowb * D + h * 64; const bf16_t* Vh = T.V + rowb * D + h * 64;
    asm volatile("" : "+s"(Kh), "+s"(Vh));
    u32x4 kr[8], vr[8];
    int kt = q0 >> 6;
    if (!samp) {
        int k0 = q0 >= 32 ? q0 - 32 : 0;
        load_bf16_regs(kr, vr, Kh + (size_t)k0 * D, Vh + (size_t)k0 * D, lane);
        { const int kn = k0 >= 64 ? k0 - 64 : 0;
          tile_step<true>(kr, vr, qr, o, carry, true, q0 < 32, q0 + r32 - k0, vimg, lane, Kh + (size_t)kn * D, Vh + (size_t)kn * D, k0 > 0); }
        while (k0 > 0) {
            if (__all(carry > EXIT_T)) break;
            const int prev = k0; k0 = prev >= 64 ? prev - 64 : 0;
            const int kn = k0 >= 64 ? k0 - 64 : 0; const bool clamp = prev < 64;
            tile_step<true>(kr, vr, qr, o, carry, clamp, clamp && prev <= 32, prev - k0, vimg, lane, Kh + (size_t)kn * D, Vh + (size_t)kn * D, k0 > 0);
        }
    } else {
        load_bf16(Kh + (size_t)kt * 64 * D, Vh + (size_t)kt * 64 * D, vimg, lane);
        tile_step<false>(kr, vr, qr, o, carry, true, (q0 & 32) == 0, q0 + r32 - 64 * kt, vimg, lane, nullptr, nullptr, false);
        const float* cKh = T.cK + (size_t)b * PAST * D + h * 64; const float* cVh = T.cV + (size_t)b * PAST * D + h * 64;
        asm volatile("" : "+s"(cKh), "+s"(cVh));
        for (kt = PAST / 64 - 1; kt >= 0; --kt) {
            if (__all(carry > EXIT_T)) break;
            load_f32(cKh + (size_t)kt * 64 * D, cVh + (size_t)kt * 64 * D, vimg, lane);
            tile_step<false>(kr, vr, qr, o, carry, false, false, 64, vimg, lane, nullptr, nullptr, false);
        }
    }
#pragma unroll
    for (int dh = 0; dh < 2; ++dh)
#pragma unroll
        for (int a = 0; a < 4; ++a) { u32x2 w; w.x = pk_bf16(o[dh][4 * a], o[dh][4 * a + 1]); w.y = pk_bf16(o[dh][4 * a + 2], o[dh][4 * a + 3]);
            *(LAS u32x2*)(vimg + r32 * 144 + (32 * dh + 8 * a + 4 * hi) * 2) = w; }
    asm volatile("s_waitcnt lgkmcnt(0)" ::: "memory");
#pragma unroll
    for (int i = 0; i < 4; ++i) { const int row = i * 8 + (lane >> 3), ch = lane & 7; const u32x4 v = *(LAS const u32x4*)(vimg + row * 144 + ch * 16); *(GAS u32x4*)((GAS char*)Ow + (unsigned)(row * D + ch * 8) * 2u) = v; }
    asm volatile("s_waitcnt lgkmcnt(0)" ::: "memory");
}
}

constexpr int NWAVES = 8;
constexpr int RING_OFF = 0, RING_BYTES = 131072, XCH_OFF = RING_BYTES, XCH_BYTES = 8192, MISC_OFF = 143360, TICKET_OFF = MISC_OFF + 256, LDS_BYTES = 147456;
static_assert(sba::WAVE_LDS * NWAVES <= MISC_OFF && XCH_OFF + XCH_BYTES <= MISC_OFF && TICKET_OFF + 64 <= LDS_BYTES, "LDS map");

#define XB_TMO      128
#define XB_XCNT(j)  (256  + 64 * (j))
#define XB_XSUB(j)  (1280 + 64 * (j))
#define XB_XGEN(j)  (2304 + 64 * (j))
#define XB_TOP      3328
#define XB_TOPGEN   3392
#define XCD_BAR_WORDS 3456
#define XB_SPIN_CAP (1u << 18)
__device__ __forceinline__ unsigned xb_ld(unsigned* p)              { return __hip_atomic_load(p, __ATOMIC_RELAXED, __HIP_MEMORY_SCOPE_AGENT); }
__device__ __forceinline__ unsigned xb_add(unsigned* p, unsigned v) { return __hip_atomic_fetch_add(p, v, __ATOMIC_RELAXED, __HIP_MEMORY_SCOPE_AGENT); }
__device__ __forceinline__ unsigned xb_xcc_id() { return (unsigned)__builtin_amdgcn_s_getreg((3 << 11) | 20) & 0xFu; }
#define XB_SPIN(cond, bar) do { unsigned _sp = 0; while (cond) { __builtin_amdgcn_s_sleep(1); \
    if ((++_sp & 255u) == 0u) { if (xb_ld(&(bar)[XB_TMO])) break; if (_sp > XB_SPIN_CAP) { atomicAdd(&(bar)[XB_TMO], 1u); break; } } } } while (0)
struct XcdBarrier { unsigned* bar; unsigned x; volatile LAS unsigned* st; };
__device__ __forceinline__ XcdBarrier xcd_barrier_post(unsigned* bar, volatile LAS unsigned* st, int tid) {
    XcdBarrier b; b.bar = bar; b.x = xb_xcc_id(); b.st = st;
    if (tid == 0) (void)xb_add(&bar[XB_XCNT(b.x)], 1u);
    return b;
}
__device__ __forceinline__ void xcd_barrier_complete(unsigned* bar, unsigned x, unsigned& nloc, unsigned& nx) {
    const unsigned G = gridDim.x * gridDim.y * gridDim.z;
    unsigned sum, cnt, mine, sp = 0u;
    for (;;) {
        sum = 0u; cnt = 0u; mine = 0u;
#pragma unroll
        for (unsigned j = 0; j < 16; ++j) { const unsigned c = xb_ld(&bar[XB_XCNT(j)]); sum += c; cnt += (c > 0u) ? 1u : 0u; mine = (j == x) ? c : mine; }
        if (sum == G) break;
        __builtin_amdgcn_s_sleep(1);
        if ((++sp & 255u) == 0u) { if (xb_ld(&bar[XB_TMO])) break; if (sp > XB_SPIN_CAP) { atomicAdd(&bar[XB_TMO], 1u); break; } }
    }
    nloc = mine > 0u ? mine : 1u; nx = cnt > 0u ? cnt : 1u;
}
__device__ __forceinline__ void xcd_barrier(const XcdBarrier& b, int tid) {
    asm volatile("s_waitcnt vmcnt(0)" ::: "memory");
    __syncthreads();
    if (tid == 0) {
        unsigned* bar = b.bar;
        __builtin_amdgcn_s_waitcnt(0);
        unsigned nloc = b.st[0], nx = b.st[1];
        if (nloc == 0u) { xcd_barrier_complete(bar, b.x, nloc, nx); b.st[0] = nloc; b.st[1] = nx; }
        const unsigned old = xb_add(&bar[XB_XSUB(b.x)], 1u);
        const unsigned gen = old / nloc;
        if (old + 1u == (gen + 1u) * nloc) {
            __builtin_amdgcn_fence(__ATOMIC_RELEASE, "agent");
            asm volatile("s_waitcnt vmcnt(0)" ::: "memory");
            const unsigned og = xb_add(&bar[XB_TOP], 1u);
            const unsigned tg = og / nx;
            if (og + 1u == (tg + 1u) * nx) xb_add(&bar[XB_TOPGEN], 1u);
            else XB_SPIN(xb_ld(&bar[XB_TOPGEN]) == tg, bar);
            __builtin_amdgcn_fence(__ATOMIC_ACQUIRE, "agent");
            xb_add(&bar[XB_XGEN(b.x)], 1u);
            asm volatile("s_waitcnt vmcnt(0)" ::: "memory");
        } else {
            XB_SPIN(xb_ld(&bar[XB_XGEN(b.x)]) == gen, bar);
            __builtin_amdgcn_fence(__ATOMIC_ACQUIRE, "agent");
            asm volatile("s_waitcnt vmcnt(0)" ::: "memory");
        }
    }
    __syncthreads();
}

struct Args { const float* in[25]; float* out; unsigned char* ws; int ph_lo, ph_hi; };
struct Frame { LAS unsigned char* lds; int tid, lane, wave, vcu, G, gw, NGW, bx; };

__device__ __forceinline__ float wave_sum(float v, int lane) {
#pragma unroll
    for (int o = 1; o < 64; o <<= 1) v += shx(v, o, lane);
    return v;
}
__device__ __forceinline__ void transpose_item(const float* W, int ldw, int k0, int n0, bf16_t* WT, int ldt, int drow0, LAS float* scr, int lane, const float* gk = nullptr) {
    f32x4 t[8];
#pragma unroll
    for (int i = 0; i < 8; ++i) { const int kk = 8 * i + (lane >> 3); t[i] = *(const GAS f32x4*)(W + (size_t)(k0 + kk) * ldw + n0 + 4 * (lane & 7)); }
#pragma unroll
    for (int i = 0; i < 8; ++i) { const int kk = 8 * i + (lane >> 3); const float g = gk ? gk[k0 + kk] : 1.f; LAS float* d = scr + kk * 33 + 4 * (lane & 7);
        d[0] = t[i][0] * g; d[1] = t[i][1] * g; d[2] = t[i][2] * g; d[3] = t[i][3] * g; }
    asm volatile("s_waitcnt lgkmcnt(0)" ::: "memory");
    const int c = lane & 7;
#pragma unroll
    for (int j = 0; j < 4; ++j) { const int n = (lane >> 3) + 8 * j; const LAS float* s = scr + (8 * c) * 33 + n;
        u32x4 o; o.x = pk_bf16(s[0 * 33], s[1 * 33]); o.y = pk_bf16(s[2 * 33], s[3 * 33]); o.z = pk_bf16(s[4 * 33], s[5 * 33]); o.w = pk_bf16(s[6 * 33], s[7 * 33]);
        *(GAS u32x4*)(WT + (size_t)(drow0 + n) * ldt + k0 + 8 * c) = o; }
    asm volatile("s_waitcnt lgkmcnt(0)" ::: "memory");
}
__device__ __forceinline__ void transpose_mat_item(const float* W, int ldw, int K, int N, bf16_t* WT, int r, LAS float* scr, int lane, const float* gk = nullptr) {
    const int nblk = N / 32, kb = r / nblk, nb = r % nblk; transpose_item(W, ldw, 64 * kb, 32 * nb, WT, K, 32 * nb, scr, lane, gk);
}
__device__ __forceinline__ void norm_row(const float* xrow, const float* g, bf16_t* hb, float* xc, float* fo, int lane) {
    const GAS f32x4* xr = (const GAS f32x4*)xrow + lane; const GAS f32x4* gr = (const GAS f32x4*)g + lane;
    f32x4 v[4]; float s = 0.f;
#pragma unroll
    for (int j = 0; j < 4; ++j) { v[j] = xr[64 * j]; s += (v[j].x * v[j].x + v[j].y * v[j].y) + (v[j].z * v[j].z + v[j].w * v[j].w); }
    if (xc) {
#pragma unroll
        for (int j = 0; j < 4; ++j) ((GAS f32x4*)xc + lane)[64 * j] = v[j];
    }
    const float rstd = 1.0f / sqrtf(wave_sum(s, lane) * (1.f / D) + RMS_EPS);
#pragma unroll
    for (int j = 0; j < 4; ++j) { v[j] = v[j] * rstd * gr[64 * j]; }
    if (hb) { GAS u32x2* o8 = (GAS u32x2*)hb + lane;
#pragma unroll
        for (int j = 0; j < 4; ++j) { u32x2 w; w.x = pk_bf16(v[j].x, v[j].y); w.y = pk_bf16(v[j].z, v[j].w); o8[64 * j] = w; } }
    if (fo) {
#pragma unroll
        for (int j = 0; j < 4; ++j) ((GAS f32x4*)fo + lane)[64 * j] = v[j];
    }
}
__device__ __forceinline__ int up_dest_row(int n) { return n < FF ? 256 * (n >> 7) + (n & 127) : 256 * ((n - FF) >> 7) + 128 + ((n - FF) & 127); }

__device__ __forceinline__ void ffn_weight_items(const Frame& F, const Args& a, int l, int wi, int nw) {
    LAS float* scr = (LAS float*)(F.lds + RING_OFF + F.wave * 16384);
    unsigned char* ws = a.ws;
    constexpr int I_UP = 16 * 176, I_DN = 44 * 32;
    for (int r = wi; r < I_UP + I_DN; r += nw) {
        if (r < I_UP) { const int kb = r / 176, nb = r % 176;
            transpose_item(a.in[21] + (size_t)l * D * FF2, FF2, 64 * kb, 32 * nb, (bf16_t*)(ws + WS_WUP) + (size_t)l * FF2 * D, D, up_dest_row(32 * nb), scr, F.lane, a.in[12] + l * D); }
        else transpose_mat_item(a.in[24] + (size_t)l * FF * D, D, FF, D, (bf16_t*)(ws + WS_WDN) + (size_t)l * D * FF, r - I_UP, scr, F.lane);
    }
}
__device__ __forceinline__ void p0_prologue(const Frame& F, const Args& a) {
    LAS float* scr = (LAS float*)(F.lds + RING_OFF + F.wave * 16384);
    unsigned char* ws = a.ws;
    constexpr int I_QKV = 16 * 96, I_SQ = 16 * 32, I_POOL = 4 * 32, I_KV = 16 * 64;
    constexpr int NIT = I_QKV + I_SQ + I_POOL + 2 * I_KV + 2 * I_SQ;
    for (int it = F.gw; it < NIT; it += F.NGW) {
        int r = it;
        if (r < I_QKV) { transpose_mat_item(a.in[14], 3 * D, D, 3 * D, (bf16_t*)(ws + WS_WQKV), r, scr, F.lane, a.in[9]); continue; } r -= I_QKV;
        if (r < I_SQ) { transpose_mat_item(a.in[15], D, D, D, (bf16_t*)(ws + WS_WO), r, scr, F.lane); continue; } r -= I_SQ;
        if (r < I_POOL) { const int g = r >> 5; transpose_mat_item(a.in[16] + (size_t)g * 65536, 256, 256, 256, (bf16_t*)(ws + WS_WPOOL) + (size_t)g * 65536, r & 31, scr, F.lane); continue; } r -= I_POOL;
        if (r < 2 * I_KV) { const int l = r / I_KV; transpose_mat_item(a.in[19] + (size_t)l * D * 2 * D, 2 * D, D, 2 * D, (bf16_t*)(ws + WS_WCAKV) + (size_t)l * 2 * D * D, r % I_KV, scr, F.lane); continue; } r -= 2 * I_KV;
        if (r < 2 * I_SQ) { const int l = r / I_SQ; transpose_mat_item(a.in[20] + (size_t)l * D * D, D, D, D, (bf16_t*)(ws + WS_WCAO) + (size_t)l * D * D, r % I_SQ, scr, F.lane); continue; } r -= 2 * I_SQ;
    }
    { const int n8 = 2 * D * D / 8;
      for (int i = F.bx * 512 + F.tid; i < n8; i += F.G * 512) { const int l = i / (D * D / 8), kk = (i % (D * D / 8)) / (D / 8); const float g = a.in[10][l * D + kk];
          const GAS f32x4* src = (const GAS f32x4*)a.in[18] + 2 * (size_t)i; const f32x4 x = src[0] * g, y = src[1] * g;
          u32x4 w; w.x = pk_bf16(x[0], x[1]); w.y = pk_bf16(x[2], x[3]); w.z = pk_bf16(y[0], y[1]); w.w = pk_bf16(y[2], y[3]); ((GAS u32x4*)(ws + WS_WCAQ))[i] = w; } }
    { const GAS f32x4* src = (const GAS f32x4*)a.in[8]; GAS u32x4* dst = (GAS u32x4*)(ws + WS_VMTS); const int n8 = 2 * DB * NMEM * D / 8;
      for (int i = F.bx * 512 + F.tid; i < n8; i += F.G * 512) { const f32x4 x = src[2 * i], y = src[2 * i + 1]; u32x4 w; w.x = pk_bf16(x[0], x[1]); w.y = pk_bf16(x[2], x[3]); w.z = pk_bf16(y[0], y[1]); w.w = pk_bf16(y[2], y[3]); dst[i] = w; } }
    { const GAS f32x4* src = (const GAS f32x4*)a.in[7]; GAS u32x4* dst = (GAS u32x4*)(ws + WS_KMS); const int n8 = 2 * DB * NMEM * D / 8;
      for (int i = F.bx * 512 + F.tid; i < n8; i += F.G * 512) { const f32x4 x = src[2 * i], y = src[2 * i + 1]; u32x4 w; w.x = pk_bf16(x[0], x[1]); w.y = pk_bf16(x[2], x[3]); w.z = pk_bf16(y[0], y[1]); w.w = pk_bf16(y[2], y[3]); dst[i] = w; } }
    for (int m = F.gw; m < 2 * NB * NMEM; m += F.NGW) { const int l = m / (NB * NMEM), r = m % (NB * NMEM);
        norm_row(a.in[2] + (size_t)r * D, a.in[11] + l * D, (bf16_t*)(ws + WS_MN) + (size_t)m * D, nullptr, nullptr, F.lane); }
    { GAS float* ssz = (GAS float*)(ws + WS_SS) + M; for (int i = F.bx * 512 + F.tid; i < 6 * M; i += F.G * 512) ssz[i] = 0.f; }
    for (int m = F.gw; m < M; m += 2 * F.NGW) {
        const int m2 = m + F.NGW; const bool has2 = m2 < M;
        const float* xr = m < MP ? a.in[0] + (size_t)m * D : a.in[1] + (size_t)(m - MP) * D; const float* xr2 = !has2 ? xr : (m2 < MP ? a.in[0] + (size_t)m2 * D : a.in[1] + (size_t)(m2 - MP) * D);
        const GAS f32x4* xp = (const GAS f32x4*)xr + F.lane; const GAS f32x4* xp2 = (const GAS f32x4*)xr2 + F.lane;
        f32x4 v[4], v2[4];
#pragma unroll
        for (int j = 0; j < 4; ++j) { v[j] = xp[64 * j]; v2[j] = xp2[64 * j]; }
        GAS u32x2* op = (GAS u32x2*)((bf16_t*)(ws + WS_HB) + (size_t)m * D) + F.lane; GAS u32x2* op2 = (GAS u32x2*)((bf16_t*)(ws + WS_HB) + (size_t)(has2 ? m2 : m) * D) + F.lane; float q = 0.f, q2 = 0.f;
#pragma unroll
        for (int j = 0; j < 4; ++j) { u32x2 w; w.x = pk_bf16(v[j].x, v[j].y); w.y = pk_bf16(v[j].z, v[j].w); op[64 * j] = w;
            q += (bf_lo(w.x) * bf_lo(w.x) + bf_hi(w.x) * bf_hi(w.x)) + (bf_lo(w.y) * bf_lo(w.y) + bf_hi(w.y) * bf_hi(w.y));
            u32x2 w2; w2.x = pk_bf16(v2[j].x, v2[j].y); w2.y = pk_bf16(v2[j].z, v2[j].w); if (has2) op2[64 * j] = w2;
            q2 += (bf_lo(w2.x) * bf_lo(w2.x) + bf_hi(w2.x) * bf_hi(w2.x)) + (bf_lo(w2.y) * bf_lo(w2.y) + bf_hi(w2.y) * bf_hi(w2.y)); }
        q = wave_sum(q, F.lane); q2 = wave_sum(q2, F.lane);
        if (F.lane == 0) { ((GAS float*)(ws + WS_SS))[m] = q; if (has2) ((GAS float*)(ws + WS_SS))[m2] = q2; } }
}
__device__ __forceinline__ void final_phase(const Frame& F, const Args& a) {
    const float* ss = (const float*)(a.ws + WS_SS) + (size_t)6 * M; const GAS f32x4* gr = (const GAS f32x4*)a.in[13] + F.lane;
    f32x4 g[4];
#pragma unroll
    for (int j = 0; j < 4; ++j) g[j] = gr[64 * j];
    for (int m0 = F.gw; m0 < MP; m0 += 4 * F.NGW) {
        u32x2 w[4][4]; float rs[4];
#pragma unroll
        for (int r = 0; r < 4; ++r) { const int m = m0 + r * F.NGW < MP ? m0 + r * F.NGW : m0; rs[r] = __builtin_amdgcn_rsqf(ss[m] * (1.f / D) + RMS_EPS);
            const GAS u32x2* xp = (const GAS u32x2*)((const bf16_t*)(a.ws + WS_HB) + (size_t)m * D) + F.lane;
#pragma unroll
            for (int j = 0; j < 4; ++j) w[r][j] = xp[64 * j]; }
#pragma unroll
        for (int r = 0; r < 4; ++r) { const int m = m0 + r * F.NGW; if (m < MP) { GAS f32x4* op = (GAS f32x4*)(a.out + OUT_Y + (size_t)m * D) + F.lane;
#pragma unroll
            for (int j = 0; j < 4; ++j) __builtin_nontemporal_store((f32x4){bf_lo(w[r][j].x), bf_hi(w[r][j].x), bf_lo(w[r][j].y), bf_hi(w[r][j].y)} * rs[r] * g[j], op + 64 * j); } }
    }
    for (int r = F.NGW - 1 - F.gw; r < MS; r += F.NGW) {
        const GAS u32x2* xp = (const GAS u32x2*)((const bf16_t*)(a.ws + WS_HB) + (size_t)(MP + r) * D) + F.lane;
        f32x4 x[4];
#pragma unroll
        for (int j = 0; j < 4; ++j) { const u32x2 w = xp[64 * j]; x[j] = (f32x4){bf_lo(w.x), bf_hi(w.x), bf_lo(w.y), bf_hi(w.y)}; }
#pragma unroll
        for (int p = 0; p < 11; ++p) { const GAS u32x2* pp = (const GAS u32x2*)((const bf16_t*)(a.ws + WS_PART) + ((size_t)p * MS + r) * D) + F.lane;
#pragma unroll
            for (int j = 0; j < 4; ++j) { const u32x2 w = pp[64 * j]; x[j] += (f32x4){bf_lo(w.x), bf_hi(w.x), bf_lo(w.y), bf_hi(w.y)}; } }
        float q = 0.f;
#pragma unroll
        for (int j = 0; j < 4; ++j) q += x[j][0] * x[j][0] + x[j][1] * x[j][1] + x[j][2] * x[j][2] + x[j][3] * x[j][3];
        q = wave_sum(q, F.lane);
        const float rs = __builtin_amdgcn_rsqf(q * (1.f / D) + RMS_EPS);
        GAS f32x4* op = (GAS f32x4*)(a.out + OUT_Y + (size_t)(MP + r) * D) + F.lane;
#pragma unroll
        for (int j = 0; j < 4; ++j) __builtin_nontemporal_store(x[j] * rs * g[j], op + 64 * j);
    }
}
template <int W> __device__ __forceinline__ void pool_load_h(float (&hv)[16], const Args& a, const float* ss, const float (&gn)[16], bool samp, int b, int m0, int t, int c0) {
    if (t >= 0) { const GAS u32x4* p = (const GAS u32x4*)((const bf16_t*)(a.ws + WS_HB) + (size_t)(m0 + t) * D + c0); const u32x4 x = p[0], y = p[1];
        const float rs = __builtin_amdgcn_rsqf(ss[m0 + t] * (1.f / D) + RMS_EPS);
        const float v[16] = {bf_lo(x.x), bf_hi(x.x), bf_lo(x.y), bf_hi(x.y), bf_lo(x.z), bf_hi(x.z), bf_lo(x.w), bf_hi(x.w), bf_lo(y.x), bf_hi(y.x), bf_lo(y.y), bf_hi(y.y), bf_lo(y.z), bf_hi(y.z), bf_lo(y.w), bf_hi(y.w)};
#pragma unroll
        for (int e = 0; e < 16; ++e) hv[e] = v[e] * rs * gn[e]; }
    else if (samp) { const GAS f32x4* p = (const GAS f32x4*)(a.in[5] + ((size_t)b * 15 + (15 + t)) * D + c0);
#pragma unroll
        for (int q = 0; q < 4; ++q) { const f32x4 x = p[q]; hv[4 * q] = x[0]; hv[4 * q + 1] = x[1]; hv[4 * q + 2] = x[2]; hv[4 * q + 3] = x[3]; } }
    else {
#pragma unroll
        for (int e = 0; e < 16; ++e) hv[e] = 0.f; }
}
template <int W> __device__ __forceinline__ void pool_item(const Args& a, int chunk, int g, int lane) {
    bf16_t* PB = (bf16_t*)(a.ws + WS_QB); const float* ss = (const float*)(a.ws + WS_SS) + (size_t)3 * M;
    const bool samp = chunk >= MP / 64;
    const int b = samp ? chunk - MP / 64 : chunk >> 6, m0 = samp ? MP + b * DSEQ : b * SEQ, tl = samp ? DSEQ : SEQ;
    const int ts = (samp ? 0 : (chunk & 63) * 64) + 16 * (lane >> 4), c0 = g * 256 + (lane & 15) * 16;
    float gn[16];
    { const GAS f32x4* gp = (const GAS f32x4*)(a.in[9] + D + c0);
#pragma unroll
      for (int q = 0; q < 4; ++q) { const f32x4 x = gp[q]; gn[4 * q] = x[0]; gn[4 * q + 1] = x[1]; gn[4 * q + 2] = x[2]; gn[4 * q + 3] = x[3]; } }
    float run[16], hv[16];
#pragma unroll
    for (int e = 0; e < 16; ++e) run[e] = 0.f;
#pragma unroll 2
    for (int j = 1; j < W; ++j) { pool_load_h<W>(hv, a, ss, gn, samp, b, m0, ts - j, c0);
#pragma unroll
        for (int e = 0; e < 16; ++e) run[e] += hv[e]; }
#pragma unroll 4
    for (int i = 0; i < 16; ++i) {
        const int t = ts + i;
        pool_load_h<W>(hv, a, ss, gn, samp, b, m0, t, c0);
#pragma unroll
        for (int e = 0; e < 16; ++e) run[e] += hv[e];
        const int pos = samp ? PAST + t : t; const float inv = 1.0f / (float)(pos + 1 < W ? pos + 1 : W);
        u32x4 o0, o1;
        o0.x = pk_bf16(run[0] * inv - hv[0], run[1] * inv - hv[1]); o0.y = pk_bf16(run[2] * inv - hv[2], run[3] * inv - hv[3]); o0.z = pk_bf16(run[4] * inv - hv[4], run[5] * inv - hv[5]); o0.w = pk_bf16(run[6] * inv - hv[6], run[7] * inv - hv[7]);
        o1.x = pk_bf16(run[8] * inv - hv[8], run[9] * inv - hv[9]); o1.y = pk_bf16(run[10] * inv - hv[10], run[11] * inv - hv[11]); o1.z = pk_bf16(run[12] * inv - hv[12], run[13] * inv - hv[13]); o1.w = pk_bf16(run[14] * inv - hv[14], run[15] * inv - hv[15]);
        GAS u32x4* op = (GAS u32x4*)(PB + (size_t)(m0 + t) * D + c0); op[0] = o0; op[1] = o1;
        if (t >= tl - 15) { float* fo = (samp ? a.out + OUT_PSS : a.out + OUT_PSP) + ((size_t)b * 15 + (t - (tl - 15))) * D + c0;
#pragma unroll
            for (int q = 0; q < 4; ++q) ((GAS f32x4*)fo)[q] = (f32x4){hv[4 * q], hv[4 * q + 1], hv[4 * q + 2], hv[4 * q + 3]}; }
        float ho[16]; pool_load_h<W>(ho, a, ss, gn, samp, b, m0, t - (W - 1), c0);
#pragma unroll
        for (int e = 0; e < 16; ++e) run[e] -= ho[e];
    }
}
__device__ __forceinline__ void pool_phase(const Frame& F, const Args& a) {
    constexpr int NCH = MP / 64 + DB;
    for (int it = F.gw, pass = 0; it < NCH * 4; it += F.NGW, ++pass) {
        const int gs = it & 3, g = (pass & 1) ? 3 - gs : gs, chunk = it >> 2;
        if (g == 0) pool_item<2>(a, chunk, 0, F.lane); else if (g == 1) pool_item<4>(a, chunk, 1, F.lane); else if (g == 2) pool_item<8>(a, chunk, 2, F.lane); else pool_item<16>(a, chunk, 3, F.lane);
    }
}
__device__ __forceinline__ void ffn_fix_tile(unsigned char* ws, const float* cw, const float* cb, int pm, int tid) {
    const float* edge = (const float*)(ws + WS_EDGE); const float* first = (const float*)(ws + WS_FIRST); bf16_t* A2 = (bf16_t*)(ws + WS_A2);
    for (int it = tid; it < FF / 4; it += 512) {
        const int c4 = it * 4, dcol = 256 * (c4 >> 7) + (c4 & 127);
        f32x4 wg[3], wv[3];
#pragma unroll
        for (int j = 0; j < 3; ++j) { wg[j] = *(const GAS f32x4*)(cw + (size_t)j * FF2 + c4); wv[j] = *(const GAS f32x4*)(cw + (size_t)j * FF2 + FF + c4); }
        const f32x4 bg = *(const GAS f32x4*)(cb + c4), bv = *(const GAS f32x4*)(cb + FF + c4);
        const float* e = edge + (size_t)(pm - 1) * 2 * FF2 + dcol; const float* f = first + (size_t)pm * 2 * FF2 + dcol;
        const f32x4 g2 = *(const GAS f32x4*)e, v2 = *(const GAS f32x4*)(e + 128), g1 = *(const GAS f32x4*)(e + FF2), v1 = *(const GAS f32x4*)(e + FF2 + 128);
        const f32x4 g0 = *(const GAS f32x4*)f, v0 = *(const GAS f32x4*)(f + 128), gp = *(const GAS f32x4*)(f + FF2), vp = *(const GAS f32x4*)(f + FF2 + 128);
        const f32x4 ga = bg + wg[0] * g2 + wg[1] * g1 + wg[2] * g0, va = bv + wv[0] * v2 + wv[1] * v1 + wv[2] * v0;
        const f32x4 gb = bg + wg[0] * g1 + wg[1] * g0 + wg[2] * gp, vb = bv + wv[0] * v1 + wv[1] * v0 + wv[2] * vp;
        f32x4 ya, yb;
#pragma unroll
        for (int q = 0; q < 4; ++q) { ya[q] = ga[q] * va[q] * __builtin_amdgcn_rcpf(1.f + __builtin_amdgcn_exp2f(-ga[q] * LOG2E)); yb[q] = gb[q] * vb[q] * __builtin_amdgcn_rcpf(1.f + __builtin_amdgcn_exp2f(-gb[q] * LOG2E)); }
        u32x2 wa, wb; wa.x = pk_bf16(ya[0], ya[1]); wa.y = pk_bf16(ya[2], ya[3]); wb.x = pk_bf16(yb[0], yb[1]); wb.y = pk_bf16(yb[2], yb[3]);
        *(GAS u32x2*)(A2 + (size_t)(pm * 256) * FF + c4) = wa; *(GAS u32x2*)(A2 + (size_t)(pm * 256 + 1) * FF + c4) = wb;
    }
}

extern __shared__ __attribute__((aligned(16))) unsigned char lds_raw[];
typedef __attribute__((address_space(4))) const Args CArgs;
__device__ __forceinline__ CArgs* kargs() { CArgs* k = (CArgs*)__builtin_amdgcn_kernarg_segment_ptr(); asm volatile("" : "+s"(k)); return k; }
__device__ __forceinline__ int elect_tid() {
    unsigned ones = ~0u; asm volatile("" : "+s"(ones));
    const int lane = (int)__builtin_amdgcn_mbcnt_hi(ones, __builtin_amdgcn_mbcnt_lo(ones, 0u));
    unsigned t = 0u;
    if (lane == 0) t = __hip_atomic_fetch_add((LAS unsigned*)((LAS unsigned char*)lds_raw + TICKET_OFF), 1u, __ATOMIC_RELAXED, __HIP_MEMORY_SCOPE_WORKGROUP);
    return (int)((__builtin_amdgcn_readfirstlane(t) & 7u) * 64u) + lane;
}
__device__ __forceinline__ Frame make_frame() {
    Frame F; F.lds = (LAS unsigned char*)lds_raw;
    const int tid = elect_tid(); __syncthreads();
    int bx = blockIdx.x, G = gridDim.x; asm volatile("" : "+s"(bx), "+s"(G));
    F.tid = tid; F.lane = F.tid & 63; F.wave = __builtin_amdgcn_readfirstlane(F.tid >> 6);
    F.G = G; F.bx = bx; F.vcu = (F.G % 8 == 0) ? (bx % 8) * (F.G / 8) + bx / 8 : bx;
    F.gw = F.vcu * NWAVES + F.wave; F.NGW = F.G * NWAVES; return F;
}
__device__ __forceinline__ Args load_args() { CArgs* k = kargs(); Args a;
#pragma unroll
    for (int i = 0; i < 25; ++i) a.in[i] = k->in[i];
    a.out = k->out; a.ws = k->ws; a.ph_lo = k->ph_lo; a.ph_hi = k->ph_hi; return a; }
#define PHASE static __device__ __forceinline__ void

PHASE ph_prologue() { const Frame F = make_frame(); const Args a = load_args(); p0_prologue(F, a); }
__device__ __forceinline__ void memkv_part(const Frame& F, CArgs* k, int G2, int c2, int l0, int l1) {
    unsigned char* ws = k->ws; float* out = k->out;
    if (c2 < 0) return;
    for (int l = l0; l < l1; ++l) {
        { pg8::GemmP g{D, D, D}; pg8::SchedMN S{(const char*)(ws + WS_MN) + (size_t)l * NB * NMEM * D * 2, (const char*)(ws + WS_WCAKV) + (size_t)l * 2 * D * D * 2, D, D, 16, 4, G2, (c2 + 128 * l) % G2, 0};
          pg8::EpiMemK E{out + OUT_MKP + (size_t)l * NB * NMEM * D, (bf16_t*)(ws + WS_KMP) + (size_t)l * NB * NMEM * D};
          int t_ = F.tid; asm volatile("" : "+v"(t_)); pg8::gemm_phase(F.lds + RING_OFF, g, S, E, t_); }
        { pg8::GemmP g{D, D, D}; pg8::SchedMN S{(const char*)(ws + WS_MN) + (size_t)l * NB * NMEM * D * 2, (const char*)(ws + WS_WCAKV) + ((size_t)l * 2 * D * D + (size_t)D * D) * 2, D, D, 16, 4, G2, (c2 + 128 * l + 64) % G2, 0};
          pg8::EpiMemK E{out + OUT_MVP + (size_t)l * NB * NMEM * D, (bf16_t*)(ws + WS_VMTP) + (size_t)l * NB * NMEM * D};
          int t_ = F.tid; asm volatile("" : "+v"(t_)); pg8::gemm_phase(F.lds + RING_OFF, g, S, E, t_); }
    }
}
PHASE ph_qkv() {
    const Frame F = make_frame(); CArgs* k = kargs(); unsigned char* ws = k->ws;
    pg8::GemmP g{D, D, D}; pg8::SchedQKV S{(const char*)(ws + WS_HB), (const char*)(ws + WS_WQKV), M / 256, F.G, F.bx};
    pg8::EpiQKV E{(bf16_t*)(ws + WS_QB), (size_t)(WS_KB - WS_QB) / 2, k->out, sba::QSCALE, (const float*)(ws + WS_SS)};
    pg8::gemm_phase(F.lds + RING_OFF, g, S, E, F.tid);
    { const Frame F2 = make_frame();
      const int extra = (M / 256) * 12 - 12 * F2.G;
      int G2 = F2.G, c2 = F2.bx; if (extra > 0 && extra < F2.G) { G2 = F2.G - extra; c2 = F2.bx >= extra ? F2.bx - extra : -1; }
      memkv_part(F2, k, G2, c2, 0, 1); }
}
PHASE ph_sbattn() {
    const Frame F = make_frame(); CArgs* k = kargs(); unsigned char* ws = k->ws;
    sba::Tensors T{(const bf16_t*)(ws + WS_QB), (const bf16_t*)(ws + WS_KB), (const bf16_t*)(ws + WS_VB), (bf16_t*)(ws + WS_OB), k->in[3], k->in[4]};
    LAS char* vimg = (LAS char*)(F.lds + RING_OFF + F.wave * sba::WAVE_LDS);
    LAS unsigned* ctr = (LAS unsigned*)(F.lds + MISC_OFF + 64);
    for (;;) {
        unsigned j = 0u; if (F.lane == 0) j = __hip_atomic_fetch_add(ctr, 1u, __ATOMIC_RELAXED, __HIP_MEMORY_SCOPE_WORKGROUP);
        j = (unsigned)__builtin_amdgcn_readfirstlane(j);
        const int id = F.vcu * NWAVES + (int)(j & 7u) + (int)(j >> 3) * F.NGW;
        if (id >= 32768 + 1024) break;
        sba::unit(id, T, vimg, F.lane);
    }
}
__device__ __forceinline__ size_t ca_base(int layer) { return layer == 0 ? WS_QB : WS_OB; }
__device__ __forceinline__ int ca_vwrow0(int layer) { return layer == 0 ? (int)((WS_VB - WS_QB) / 2048) : (int)((WS_VW1 - WS_OB) / 2048); }
__device__ __forceinline__ void wkvw_part(const Frame& F, CArgs* k, int layer, int G, int c) {
    unsigned char* ws = k->ws;
    pg8::GemmP g{D, D, 256};
    pg8::SchedWKVW S{(const char*)(ws + WS_KMP) + (size_t)layer * NB * NMEM * D * 2, (const char*)(ws + WS_KMS) + (size_t)layer * DB * NMEM * D * 2,
                     (const char*)(ws + WS_VMTP) + (size_t)layer * NB * NMEM * D * 2, (const char*)(ws + WS_VMTS) + (size_t)layer * DB * NMEM * D * 2,
                     (const char*)(ws + WS_WCAQ) + (size_t)layer * D * D * 2, (const char*)(ws + WS_WCAO) + (size_t)layer * D * D * 2, G, c, ca_vwrow0(layer)};
    pg8::EpiBf16 E{(bf16_t*)(ws + ca_base(layer)), D, 1.f, nullptr};
    pg8::gemm_phase(F.lds + RING_OFF, g, S, E, F.tid);
}
PHASE ph_resid_gemm(int which_, int layer_, float alpha) {
    const int which = __builtin_amdgcn_readfirstlane(which_), layer = __builtin_amdgcn_readfirstlane(layer_);
    const Frame F = make_frame(); CArgs* k = kargs(); unsigned char* ws = k->ws;
    const char* A; const char* W; int K, ssi;
    if (which == 0) { A = (const char*)(ws + WS_OB); W = (const char*)(ws + WS_WO); K = D; ssi = 1; }
    else if (which == 1) { A = (const char*)(ws + WS_VB); W = (const char*)(ws + WS_WCAO) + (size_t)layer * D * D * 2; K = D; ssi = layer == 0 ? 2 : 5; }
    else { A = (const char*)(ws + WS_A2); W = (const char*)(ws + WS_WDN) + (size_t)layer * D * FF * 2; K = FF; ssi = layer == 0 ? 3 : 6; }
    const bool splitk = which == 2 && layer == 1;
    pg8::GemmP g{K, K, K}; pg8::SchedMN S{A, W, K, K, splitk ? MP / 256 : M / 256, 4, F.G, F.bx, 0};
    if (which == 2) {
        int last = -1;
        for (int i = 0; ; ++i) { pg8::Unit u; if (!S.next(i, u)) break; const int pm = u.row0 >> 8;
            if (pm != last && pm < MP / 256 && (pm & 15) != 0) ffn_fix_tile(ws, k->in[22] + (size_t)layer * 3 * FF2, k->in[23] + (size_t)layer * FF2, pm, F.tid);
            last = pm; }
        asm volatile("s_waitcnt vmcnt(0)" ::: "memory"); __syncthreads();
    }
    pg8::EpiResid<false> E{(bf16_t*)(ws + WS_HB), (float*)(ws + WS_SS) + (size_t)ssi * M, nullptr, alpha};
    pg8::gemm_phase(F.lds + RING_OFF, g, S, E, F.tid);
    if (splitk && alpha != 0.f) {
        const Frame F2 = make_frame();
        pg8::GemmP g2{FF, FF, 256}; pg8::SchedSplitK S2{A, W, F2.G, F2.bx};
        pg8::EpiBf16 E2{(bf16_t*)(ws + WS_PART), D, 1.f, nullptr};
        pg8::gemm_phase(F2.lds + RING_OFF, g2, S2, E2, F2.tid);
    }
    if (alpha != 0.f && (which == 0 || (which == 2 && layer == 0))) {
        const Frame F2 = make_frame();
        const int extra = (M / 256) * 4 - 4 * F2.G;
        const int nl = which == 0 ? 0 : 1;
        int G2 = F2.G, c2 = F2.bx; if (extra > 0 && extra < F2.G) { G2 = F2.G - extra; c2 = F2.bx >= extra ? F2.bx - extra : -1; }
        wkvw_part(F2, k, nl, G2, c2);
    }
}
PHASE ph_pool_gemm(float alpha) {
    const Frame F = make_frame(); CArgs* k = kargs(); unsigned char* ws = k->ws;
    pg8::GemmP g{D, 256, 256}; pg8::SchedPool S{(const char*)(ws + WS_QB), (const char*)(ws + WS_WPOOL), F.G, F.bx};
    pg8::EpiResid<true> E{(bf16_t*)(ws + WS_HB), (float*)(ws + WS_SS) + (size_t)4 * M, k->in[17], alpha};
    pg8::gemm_phase(F.lds + RING_OFF, g, S, E, F.tid);
}
PHASE ph_final() { const Frame F = make_frame(); const Args a = load_args(); final_phase(F, a); }
PHASE ph_pool() { const Frame F = make_frame(); const Args a = load_args(); pool_phase(F, a); }
__device__ __forceinline__ void ffn_tail(int l) {
    const Frame F2 = make_frame(); const Args a = load_args();
    const int extra = 1152 - 4 * F2.G;
    if (extra > 0 && extra < F2.G) { if (F2.bx >= extra) ffn_weight_items(F2, a, l, (F2.bx - extra) * NWAVES + F2.wave, (F2.G - extra) * NWAVES); }
    else ffn_weight_items(F2, a, l, F2.bx * NWAVES + F2.wave, F2.G * NWAVES);
}
PHASE ph_cascore(int layer_) {
    const int layer = __builtin_amdgcn_readfirstlane(layer_);
    const Frame F = make_frame(); CArgs* k = kargs(); unsigned char* ws = k->ws;
    { pg8::GemmP g{D, D, D}; pg8::SchedCA2<0, 0> S{(const char*)(ws + WS_HB), (const char*)(ws + ca_base(layer)), F.G, F.bx, ca_vwrow0(layer)};
      pg8::EpiSoftmax E{(bf16_t*)(ws + WS_KB), XCH_OFF, (const float*)(ws + WS_SS) + (size_t)(layer == 0 ? 1 : 4) * M, 0.0625f * LOG2E};
      pg8::gemm_phase(F.lds + RING_OFF, g, S, E, F.tid); }
    { const Frame F1 = make_frame();
      pg8::GemmP g{D, D, D}; pg8::SchedCA2<0, 1> S{(const char*)(ws + WS_HB), (const char*)(ws + ca_base(layer)), F1.G, F1.bx, ca_vwrow0(layer)};
      pg8::EpiSoftmax E{(bf16_t*)(ws + WS_KB), XCH_OFF, (const float*)(ws + WS_SS) + (size_t)(layer == 0 ? 1 : 4) * M, 0.0625f * LOG2E};
      pg8::gemm_phase(F1.lds + RING_OFF, g, S, E, F1.tid); }
    if (layer == 0) {
        const Frame F2 = make_frame(); const int extra = 1152 - 4 * F2.G;
        int G2 = F2.G, c2 = F2.bx; if (extra > 0 && extra < F2.G) { G2 = F2.G - extra; c2 = F2.bx >= extra ? F2.bx - extra : -1; }
        memkv_part(F2, k, G2, c2, 1, 2); }
}
PHASE ph_caout(int layer_, float alpha) {
    const int layer = __builtin_amdgcn_readfirstlane(layer_);
    const Frame F = make_frame(); CArgs* k = kargs(); unsigned char* ws = k->ws;
    pg8::GemmP g{D, D, D}; pg8::SchedCA2<1> S{(const char*)(ws + WS_KB), (const char*)(ws + ca_base(layer)), F.G, F.bx, ca_vwrow0(layer)};
    pg8::EpiResid<false> E{(bf16_t*)(ws + WS_HB), (float*)(ws + WS_SS) + (size_t)(layer == 0 ? 2 : 5) * M, nullptr, alpha};
    pg8::gemm_phase(F.lds + RING_OFF, g, S, E, F.tid);
    if (layer == 0 && alpha != 0.f) { ffn_tail(0); ffn_tail(1); }
}
PHASE ph_up(int layer_) {
    const int layer = __builtin_amdgcn_readfirstlane(layer_);
    const Frame F = make_frame(); CArgs* k = kargs(); unsigned char* ws = k->ws; float* out = k->out;
    pg8::GemmP g{D, D, D}; pg8::SchedMN S{(const char*)(ws + WS_HB), (const char*)(ws + WS_WUP) + (size_t)layer * FF2 * D * 2, D, D, M / 256, 22, F.G, F.bx, 0};
    pg8::EpiUpGate E{(bf16_t*)(ws + WS_A2), k->in[22] + (size_t)layer * 3 * FF2, k->in[23] + (size_t)layer * FF2, k->in[6] + (size_t)layer * DB * 2 * FF2,
                     out + OUT_FSP + (size_t)layer * NB * 2 * FF2, out + OUT_FSS + (size_t)layer * DB * 2 * FF2, (float*)(ws + WS_EDGE), (float*)(ws + WS_FIRST), XCH_OFF, (const float*)(ws + WS_SS) + (size_t)(layer == 0 ? 2 : 5) * M};
    pg8::gemm_phase(F.lds + RING_OFF, g, S, E, F.tid);
}

constexpr int N_PHASES = 15;
__global__ void __launch_bounds__(NWAVES * 64, 2) trunk_fwd(Args args_unused) {
    CArgs* k = kargs();
    volatile LAS unsigned* MISC = (volatile LAS unsigned*)((LAS unsigned char*)lds_raw + MISC_OFF);
    { const int tid = elect_tid(); __syncthreads();
      if (tid < 32) MISC[tid] = 0u;
      __syncthreads();
      if (k->ph_hi - k->ph_lo > 1) (void)xcd_barrier_post((unsigned*)(k->ws + WS_CTL) + CW_BAR, MISC + 8, tid); }
#ifndef PHASE_MASK
#define PHASE_MASK 0xffffffffull
#endif
#define IN(p) ((((PHASE_MASK) >> (p)) & 1ull) && k->ph_lo <= (p) && (p) < k->ph_hi)
#define SEAM(p) do { if (IN(p) && IN((p) + 1)) { XcdBarrier bar; bar.bar = (unsigned*)(k->ws + WS_CTL) + CW_BAR; bar.x = xb_xcc_id(); bar.st = MISC + 8; xcd_barrier(bar, elect_tid()); } } while (0)
#ifndef PROBE_REP
#define PROBE_REP 0ull
#endif
#define GBAR() do { XcdBarrier bar; bar.bar = (unsigned*)(k->ws + WS_CTL) + CW_BAR; bar.x = xb_xcc_id(); bar.st = MISC + 8; xcd_barrier(bar, elect_tid()); } while (0)
#define RUN(p, call, recall) do { if (IN(p)) { call; if (((PROBE_REP) >> (p)) & 1ull) { GBAR(); recall; } } SEAM(p); } while (0)
    RUN(0, ph_prologue(), ph_prologue());
    RUN(1, ph_qkv(), ph_qkv());
    RUN(2, ph_sbattn(), ph_sbattn());
    RUN(3, ph_resid_gemm(0, 0, 1.f), ph_resid_gemm(0, 0, 0.f));
    for (int layer = 0; layer < 2; ++layer) {
        const int pb = 4 + 6 * layer;
        if (layer == 1) {
            RUN(8, ph_pool(), ph_pool());
            RUN(9, ph_pool_gemm(1.f), ph_pool_gemm(0.f));
        }
        RUN(pb + 0, ph_cascore(layer), ph_cascore(layer));
        RUN(pb + 1, ph_caout(layer, 1.f), ph_caout(layer, 0.f));
        RUN(pb + 2, ph_up(layer), ph_up(layer));
        RUN(pb + 3, ph_resid_gemm(2, layer, 1.f), ph_resid_gemm(2, layer, 0.f));
    }
    if (IN(14)) ph_final();
#undef IN
#undef SEAM
#undef RUN
#undef GBAR
}

extern "C" void kernel_launch(void* const* d_in, const int* in_sizes, int n_in, void* d_out, int out_size, void* d_ws, size_t ws_size, hipStream_t stream) {
    static int grid = 0;
    if (grid == 0) {
        if (n_in != 25 || (size_t)out_size != OUT_TOTAL || ws_size < WS_END) { fprintf(stderr, "kernel_launch: unexpected shapes: n_in %d out %d ws %zu\n", n_in, out_size, ws_size); grid = -1; return; }
        int dev = 0, cus = 0;
        if (hipGetDevice(&dev) != hipSuccess || hipDeviceGetAttribute(&cus, hipDeviceAttributeMultiprocessorCount, dev) != hipSuccess) { grid = -1; return; }
        if (hipFuncSetAttribute((const void*)trunk_fwd, hipFuncAttributeMaxDynamicSharedMemorySize, LDS_BYTES) != hipSuccess) { fprintf(stderr, "kernel_launch: hipFuncSetAttribute failed\n"); grid = -1; return; }
        int per_cu = 0;
        if (hipOccupancyMaxActiveBlocksPerMultiprocessor(&per_cu, (const void*)trunk_fwd, NWAVES * 64, LDS_BYTES) != hipSuccess || per_cu < 1) fprintf(stderr, "kernel_launch: occupancy query reports %d\n", per_cu);
        (void)hipGetLastError();
        grid = cus;
    }
    if (grid < 0) return;
    (void)hipMemsetAsync((char*)d_ws + WS_CTL, 0, CTL_ZERO_BYTES, stream);
    Args a{};
    for (int i = 0; i < 25; ++i) a.in[i] = (const float*)d_in[i];
    a.out = (float*)d_out; a.ws = (unsigned char*)d_ws;
#if MK_ONE_LAUNCH
    a.ph_lo = 0; a.ph_hi = N_PHASES;
    hipLaunchKernelGGL(trunk_fwd, dim3(grid), dim3(NWAVES * 64), LDS_BYTES, stream, a);
#else
    for (int p = 0; p < N_PHASES; ++p) { a.ph_lo = p; a.ph_hi = p + 1; hipLaunchKernelGGL(trunk_fwd, dim3(grid), dim3(NWAVES * 64), LDS_BYTES, stream, a); }
#endif
}
```

```cpp
#include <hip/hip_runtime.h>
#include <cstdio>
#include <cstdint>

#ifndef MK_ONE_LAUNCH
#define MK_ONE_LAUNCH 1
#endif

#define GAS __attribute__((address_space(1)))
#define LAS __attribute__((address_space(3)))
typedef unsigned short bf16_t;
typedef short bf16x8 __attribute__((ext_vector_type(8)));
typedef short s16x4 __attribute__((ext_vector_type(4)));
typedef float f32x4 __attribute__((ext_vector_type(4)));
typedef float f32x16 __attribute__((ext_vector_type(16)));
typedef unsigned u32x4 __attribute__((ext_vector_type(4)));
typedef unsigned u32x2 __attribute__((ext_vector_type(2)));
typedef float f32x2_t __attribute__((ext_vector_type(2)));
typedef __bf16 bf16x2_t __attribute__((ext_vector_type(2)));
typedef GAS unsigned gu32;

__device__ __forceinline__ unsigned pk_bf16(float lo, float hi) { f32x2_t v = {lo, hi}; bf16x2_t b = __builtin_convertvector(v, bf16x2_t); return __builtin_bit_cast(unsigned, b); }
__device__ __forceinline__ float shx(float v, int mask, int lane) { return __int_as_float(__builtin_amdgcn_ds_bpermute((lane ^ mask) << 2, __float_as_int(v))); }
__device__ __forceinline__ float bf_lo(unsigned u) { return __uint_as_float(u << 16); }
__device__ __forceinline__ float bf_hi(unsigned u) { return __uint_as_float(u & 0xffff0000u); }

constexpr int D = 1024, MP = 65536, MS = 2048, M = MP + MS;
constexpr int SEQ = 4096, NB = 16, DB = 32, DSEQ = 64, PAST = 2048;
constexpr int FF = 2816, FF2 = 5632, NMEM = 256;
constexpr float RMS_EPS = 1e-6f;
constexpr float LOG2E = 1.4426950408889634f;
constexpr size_t OUT_Y = 0, OUT_KP = (size_t)M * D, OUT_VP = OUT_KP + (size_t)MP * D, OUT_KS = OUT_VP + (size_t)MP * D, OUT_VS = OUT_KS + (size_t)MS * D;
constexpr size_t OUT_PSP = OUT_VS + (size_t)MS * D, OUT_PSS = OUT_PSP + (size_t)NB * 15 * D, OUT_FSP = OUT_PSS + (size_t)DB * 15 * D;
constexpr size_t OUT_FSS = OUT_FSP + (size_t)2 * NB * 2 * FF2, OUT_MKP = OUT_FSS + (size_t)2 * DB * 2 * FF2, OUT_MVP = OUT_MKP + (size_t)2 * NB * NMEM * D;
constexpr size_t OUT_TOTAL = OUT_MVP + (size_t)2 * NB * NMEM * D;
static_assert(OUT_TOTAL == 226213888ull, "output size");
constexpr size_t MiB = 1u << 20;
constexpr size_t WS_CTL = 0, CTL_ZERO_BYTES = 1 * MiB;
constexpr size_t WS_WQKV = 2 * MiB, WS_WO = 8 * MiB, WS_WPOOL = 10 * MiB, WS_WCAQ = 11 * MiB, WS_WCAKV = 15 * MiB, WS_WCAO = 23 * MiB, WS_WUP = 27 * MiB, WS_WDN = 49 * MiB;
constexpr size_t WS_MN = 60 * MiB, WS_KMP = 76 * MiB, WS_VMTP = 92 * MiB, WS_KMS = 108 * MiB, WS_VMTS = 140 * MiB;
constexpr size_t WS_HB = 172 * MiB, WS_QB = 304 * MiB, WS_KB = 436 * MiB, WS_VB = 568 * MiB;
constexpr size_t WS_A2 = 304 * MiB, WS_EDGE = 700 * MiB, WS_FIRST = 712 * MiB, WS_OB = 724 * MiB, WS_SS = 856 * MiB, WS_VW1 = 858 * MiB, WS_END = 954 * MiB, WS_PART = WS_OB;
static_assert(WS_A2 + (size_t)M * FF * 2 <= WS_EDGE && WS_EDGE + (size_t)(M / 256) * 2 * FF2 * 4 <= WS_FIRST && WS_FIRST + (size_t)(M / 256) * 2 * FF2 * 4 <= WS_OB && WS_OB + (size_t)M * D * 2 <= WS_SS && WS_SS + (size_t)7 * M * 4 <= WS_END && WS_HB + (size_t)M * D * 2 <= WS_QB && WS_VB + (size_t)M * D * 2 <= WS_EDGE, "ws map");
constexpr int CW_BAR = 4096;

namespace pg8 {
constexpr int BM = 256, BK = 64, HALF = 128, HTB = HALF * BK * 2, STAGE_BYTES = 8 * HTB, NXCD = 8, WGM = 8;
__host__ __device__ __forceinline__ int lds_byte(int r, int c) { const int st = (r >> 4) * 2 + (c >> 5), rr = r & 15, cc = c & 31, ob = rr * 64 + cc * 2; return st * 1024 + (ob ^ (((ob >> 9) & 1) << 5)); }
__host__ __device__ __forceinline__ void stage_rc(int b, int& R, int& C) { const int st = b / 1024, sb = b % 1024, swz = sb ^ (((sb >> 9) & 1) << 5); R = (st >> 1) * 16 + swz / 64; C = (st & 1) * 32 + (swz % 64) / 2; }
__host__ __device__ __forceinline__ int perm32(int rho) { const int n = rho >> 4, i = rho & 15; return 8 * (i >> 2) + 4 * n + (i & 3); }

struct Unit { const char* a; const char* b; int row0, col0, vlo, vhi, aux; };
struct GemmP { int lda, ldb, K; };

__device__ __forceinline__ bool tile_of(long L, int nM, int nN, int& pm, int& pn) {
    const int nwg = nM * nN; if (L >= nwg) return false;
    int wgid = (int)L; { const int q = nwg / NXCD, r = nwg % NXCD, xcd = wgid % NXCD, off = wgid / NXCD; wgid = (xcd < r ? xcd * (q + 1) : r * (q + 1) + (xcd - r) * q) + off; }
    const int nig = WGM * nN, gid = wgid / nig, fm = gid * WGM, gsz = (nM - fm) < WGM ? (nM - fm) : WGM;
    pm = fm + ((wgid % nig) % gsz); pn = (wgid % nig) / gsz; return true;
}

template <class Epi, class Sched>
__device__ __forceinline__ void gemm_phase(LAS unsigned char* lds, const GemmP g, const Sched& S, const Epi& E, int tid) {
    const int wid = __builtin_amdgcn_readfirstlane(tid >> 6), lane = tid & 63, wr = wid >> 2, wc = wid & 3, fr = lane & 15, fq = lane >> 4;
    const int K = g.K, nt = K / BK;
    unsigned voffA[2], voffB[2];
#pragma unroll
    for (int i = 0; i < 2; ++i) { int R, C; stage_rc(tid * 16 + i * 8192, R, C); const int Rb = (R & ~31) + perm32(R & 31);
        voffA[i] = (unsigned)(R * g.lda + C) * 2u; voffB[i] = (unsigned)(Rb * g.ldb + C) * 2u; }
    const size_t kstep = (size_t)(BK * 2);
    const size_t hstepA = (size_t)HALF * g.lda * 2, hstepB = (size_t)HALF * g.ldb * 2;
    const unsigned ldsw = (unsigned)wid * 1024u;
    const int aoff = lds_byte(wr * 64 + fr, fq * 8), boff = lds_byte(wc * 32 + fr, fq * 8);
#define PG8_SA(b, h) (((b) * 2 + (h)) * HTB)
#define PG8_SB(b, h) ((4 + (b) * 2 + (h)) * HTB)
#define PG8_STAGE(bufoff, gbase, voff) do { _Pragma("unroll") for (int _i = 0; _i < 2; ++_i) \
        __builtin_amdgcn_global_load_lds((const unsigned*)((const char*)(gbase) + (voff)[_i]), (LAS unsigned*)(lds + (bufoff) + ldsw + _i * 8192), 16, 0, 0); } while (0)
#define PG8_LDA(dst, b, h) do { _Pragma("unroll") for (int m = 0; m < 4; ++m) _Pragma("unroll") for (int k = 0; k < 2; ++k) dst[m][k] = *(const LAS bf16x8*)(lds + PG8_SA(b, h) + aoff + m * 2048 + k * 1024); } while (0)
#define PG8_LDB(dst, b, h) do { _Pragma("unroll") for (int n = 0; n < 2; ++n) _Pragma("unroll") for (int k = 0; k < 2; ++k) dst[n][k] = *(const LAS bf16x8*)(lds + PG8_SB(b, h) + boff + n * 2048 + k * 1024); } while (0)
#define PG8_MMA(ai, bj, At, Bt) do { __builtin_amdgcn_s_setprio(1); _Pragma("unroll") for (int m = 0; m < 4; ++m) _Pragma("unroll") for (int n = 0; n < 2; ++n) _Pragma("unroll") for (int k = 0; k < 2; ++k) \
        acc[ai][bj][m][n] = __builtin_amdgcn_mfma_f32_16x16x32_bf16(Bt[n][k], At[m][k], acc[ai][bj][m][n], 0, 0, 0); __builtin_amdgcn_s_setprio(0); } while (0)
#define PG8_WAIT_V(n) asm volatile("s_waitcnt vmcnt(" #n ")" ::: "memory")
#define PG8_WAIT_L(n) asm volatile("s_waitcnt lgkmcnt(" #n ")" ::: "memory")
#define PG8_BAR __builtin_amdgcn_s_barrier()
#define PG8_SCHED __builtin_amdgcn_sched_barrier(0)
    Unit cur, nxt; int ui = 0;
    if (!S.next(0, cur)) return;
    f32x4 acc[2][2][4][2];
#pragma unroll
    for (int a = 0; a < 2; ++a)
#pragma unroll
        for (int b = 0; b < 2; ++b)
#pragma unroll
            for (int m = 0; m < 4; ++m)
#pragma unroll
                for (int n = 0; n < 2; ++n) acc[a][b][m][n] = (f32x4){0.f, 0.f, 0.f, 0.f};
    bf16x8 At[4][2], B0[2][2], B1[2][2];
    const char* cA = cur.a; const char* cB = cur.b;
    PG8_STAGE(PG8_SB(0, 0), cB, voffB); PG8_STAGE(PG8_SB(0, 1), cB + hstepB, voffB); PG8_STAGE(PG8_SA(0, 0), cA, voffA); PG8_STAGE(PG8_SA(0, 1), cA + hstepA, voffA);
    if (wr == 1) PG8_BAR;
    PG8_WAIT_V(2); PG8_BAR;
    PG8_STAGE(PG8_SB(1, 0), cB + kstep, voffB); PG8_STAGE(PG8_SA(1, 0), cA + kstep, voffA); PG8_STAGE(PG8_SB(1, 1), cB + hstepB + kstep, voffB);
    PG8_WAIT_V(6); PG8_BAR;
    for (;;) {
        const bool has_next = S.next(ui + 1, nxt);
        const char* nA = has_next ? nxt.a : cA; const char* nB = has_next ? nxt.b : cB;
        for (int t = 0; t < nt; t += 2) {
            const bool last = (t == nt - 2);
            const char* a1 = cA + (size_t)(t + 1) * kstep;
            const char* a2 = last ? nA : cA + (size_t)(t + 2) * kstep; const char* b2 = last ? nB : cB + (size_t)(t + 2) * kstep;
            const char* a3 = a2 + kstep; const char* b3 = b2 + kstep;
            PG8_LDB(B0, 0, 0); PG8_LDB(B1, 0, 1); PG8_SCHED; PG8_LDA(At, 0, 0); PG8_STAGE(PG8_SA(1, 1), a1 + hstepA, voffA);
            PG8_WAIT_V(8); PG8_WAIT_L(0); PG8_BAR; PG8_MMA(0, 0, At, B0); PG8_MMA(0, 1, At, B1); PG8_BAR; PG8_SCHED;
            PG8_LDA(At, 0, 1); PG8_STAGE(PG8_SB(0, 0), b2, voffB); PG8_STAGE(PG8_SB(0, 1), b2 + hstepB, voffB); PG8_STAGE(PG8_SA(0, 0), a2, voffA);
            PG8_WAIT_V(8); PG8_WAIT_L(0); PG8_BAR; PG8_MMA(1, 0, At, B0); PG8_MMA(1, 1, At, B1); PG8_BAR; PG8_SCHED;
            PG8_LDB(B0, 1, 0); PG8_LDB(B1, 1, 1); PG8_SCHED; PG8_LDA(At, 1, 0); PG8_STAGE(PG8_SA(0, 1), a2 + hstepA, voffA);
            PG8_WAIT_V(8); PG8_WAIT_L(0); PG8_BAR; PG8_MMA(0, 0, At, B0); PG8_MMA(0, 1, At, B1); PG8_BAR; PG8_SCHED;
            PG8_LDA(At, 1, 1); PG8_STAGE(PG8_SB(1, 0), b3, voffB); PG8_STAGE(PG8_SB(1, 1), b3 + hstepB, voffB); PG8_STAGE(PG8_SA(1, 0), a3, voffA);
            PG8_WAIT_V(8); PG8_WAIT_L(0); PG8_BAR; PG8_MMA(1, 0, At, B0); PG8_MMA(1, 1, At, B1); PG8_BAR; PG8_SCHED;
        }
        if (wr == 0) PG8_BAR;
        { unsigned ones = ~0u; asm volatile("" : "+s"(ones));
          const int ln = (int)__builtin_amdgcn_mbcnt_hi(ones, __builtin_amdgcn_mbcnt_lo(ones, 0u));
          E(acc, cur, wr, wc, ln & 15, ln >> 4, lds); }
        if (!has_next) break;
#pragma unroll
        for (int a = 0; a < 2; ++a)
#pragma unroll
            for (int b = 0; b < 2; ++b)
#pragma unroll
                for (int m = 0; m < 4; ++m)
#pragma unroll
                    for (int n = 0; n < 2; ++n) acc[a][b][m][n] = (f32x4){0.f, 0.f, 0.f, 0.f};
        cur = nxt; cA = nA; cB = nB; ++ui;
        if (wr == 1) PG8_BAR;
    }
    PG8_WAIT_V(0);
    PG8_BAR;
#undef PG8_SA
#undef PG8_SB
#undef PG8_STAGE
#undef PG8_LDA
#undef PG8_LDB
#undef PG8_MMA
#undef PG8_WAIT_V
#undef PG8_WAIT_L
#undef PG8_BAR
#undef PG8_SCHED
}

struct SchedMN {
    const char* A; const char* Bt; int lda, ldb, nM, nN, G, c, col_base;
    __device__ __forceinline__ bool next(int i, Unit& u) const {
        int pm, pn; if (!tile_of((long)i * G + c, nM, nN, pm, pn)) return false;
        u.a = A + (size_t)pm * BM * lda * 2; u.b = Bt + (size_t)pn * BM * ldb * 2; u.row0 = pm * BM; u.col0 = col_base + pn * BM; u.vlo = 0; u.vhi = 0x7fffffff; u.aux = pn; return true;
    }
};
struct SchedWKVW {
    const char* KMP; const char* KMS; const char* VMP; const char* VMS; const char* WQN; const char* WOT; int G, c, VW_ROW0;
    __device__ __forceinline__ bool next(int i, Unit& u) const {
        const int L = i * G + c; if (c < 0 || L >= 1536) return false;
        const int q = L < 768 ? L : L - 768, bb = q >> 4, h = (q >> 2) & 3, ch = q & 3;
        u.vlo = 0; u.vhi = 0x7fffffff; u.aux = 0; u.col0 = L < 768 ? ch * 256 : h * 256;
        if (L < 768) { const char* Km = bb < NB ? KMP + (size_t)bb * NMEM * D * 2 : KMS + (size_t)(bb - NB) * NMEM * D * 2;
            u.a = Km + h * 256 * 2; u.b = WQN + ((size_t)ch * 256 * D + h * 256) * 2; u.row0 = (bb * 4 + h) * 256; }
        else { const char* Vm = bb < NB ? VMP + (size_t)bb * NMEM * D * 2 : VMS + (size_t)(bb - NB) * NMEM * D * 2;
            u.a = WOT + ((size_t)ch * 256 * D + h * 256) * 2; u.b = Vm + h * 256 * 2; u.row0 = VW_ROW0 + bb * 1024 + ch * 256; }
        return true;
    }
};
template <int MODE> struct SchedCA2 {
    const char* A; const char* W; int G, c, VW_ROW0;
    __device__ __forceinline__ bool next(int i, Unit& u) const {
        const int L = i * G + c; if (L >= 1024 + 128) return false;
        int row0, bb, hp;
        if (L < 1024) { const int pm = L >> 2; hp = L & 3; row0 = pm * BM; bb = pm >> 4; u.vlo = 0; u.vhi = 0x7fffffff; }
        else { const int s = L - 1024, b = s >> 2; hp = s & 3; const int r = MP + DSEQ * b; row0 = r < M - BM ? r : M - BM; bb = NB + b; u.vlo = r; u.vhi = r + DSEQ; }
        u.a = A + (size_t)row0 * D * 2;
        u.b = W + (MODE == 0 ? (size_t)((bb * 4 + hp) * 256) : (size_t)(VW_ROW0 + bb * 1024 + hp * 256)) * D * 2;
        u.row0 = row0; u.col0 = hp * 256; u.aux = 0; return true;
    }
};

#define EPI_ARGS f32x4 (&acc)[2][2][4][2], const Unit& u, int wr, int wc, int fr, int fq, LAS unsigned char* lds
struct EpiBf16 {
    bf16_t* O; int ldc; float scale; const float* ss;
    __device__ __forceinline__ void operator()(EPI_ARGS) const {
        const int row0 = u.row0 + wr * 64 + fr, col0 = u.col0 + wc * 32 + 8 * fq;
#pragma unroll
        for (int ai = 0; ai < 2; ++ai)
#pragma unroll
            for (int m = 0; m < 4; ++m) { const int row = row0 + ai * HALF + m * 16; bf16_t* rowp = O + (size_t)row * ldc + col0;
                const float rs = ss ? scale * __builtin_amdgcn_rsqf(ss[row] * (1.f / D) + RMS_EPS) : scale;
                if (row >= u.vlo && row < u.vhi) {
#pragma unroll
                for (int bj = 0; bj < 2; ++bj) { const f32x4 v0 = acc[ai][bj][m][0] * rs, v1 = acc[ai][bj][m][1] * rs;
                    u32x4 w; w.x = pk_bf16(v0[0], v0[1]); w.y = pk_bf16(v0[2], v0[3]); w.z = pk_bf16(v1[0], v1[1]); w.w = pk_bf16(v1[2], v1[3]);
                    *(u32x4*)(rowp + bj * HALF) = w; } } }
    }
};
struct SchedSplitK {
    const char* A; const char* Bt; int G, c;
    __device__ __forceinline__ bool next(int i, Unit& u) const {
        const int L = i * G + c; if (L >= 352) return false;
        const int part = L >> 5, t = L & 31, pm = t >> 2, pn = t & 3;
        u.a = A + ((size_t)(MP + pm * BM) * FF + part * 256) * 2; u.b = Bt + ((size_t)(pn * BM) * FF + part * 256) * 2;
        u.row0 = part * MS + pm * BM; u.col0 = pn * BM; u.vlo = 0; u.vhi = 0x7fffffff; u.aux = part; return true;
    }
};
struct EpiQKV {
    bf16_t* Qb; size_t bstride; float* out; float qscale; const float* ss;
    __device__ __forceinline__ void operator()(EPI_ARGS) const {
        const int typ = u.aux >> 2, colt = (u.aux & 3) * BM + wc * 32 + 8 * fq, row0 = u.row0 + wr * 64 + fr;
        bf16_t* B = Qb + (size_t)typ * bstride;
        const bool samp = u.row0 >= MP;
        float* F = typ == 1 ? (samp ? out + OUT_KS - (size_t)MP * D : out + OUT_KP) : (samp ? out + OUT_VS - (size_t)MP * D : out + OUT_VP);
        const float sc = typ == 0 ? qscale : 1.f;
#pragma unroll
        for (int ai = 0; ai < 2; ++ai)
#pragma unroll
            for (int m = 0; m < 4; ++m) { const size_t off = (size_t)(row0 + ai * HALF + m * 16) * D + colt;
                const float rs = __builtin_amdgcn_rsqf(ss[row0 + ai * HALF + m * 16] * (1.f / D) + RMS_EPS);
#pragma unroll
                for (int bj = 0; bj < 2; ++bj) { const f32x4 v0 = acc[ai][bj][m][0] * rs, v1 = acc[ai][bj][m][1] * rs;
                    if (typ != 0) { *(f32x4*)(F + off + bj * HALF) = v0; *(f32x4*)(F + off + bj * HALF + 4) = v1; }
                    u32x4 w; w.x = pk_bf16(v0[0] * sc, v0[1] * sc); w.y = pk_bf16(v0[2] * sc, v0[3] * sc); w.z = pk_bf16(v1[0] * sc, v1[1] * sc); w.w = pk_bf16(v1[2] * sc, v1[3] * sc);
                    *(u32x4*)(B + off + bj * HALF) = w; } }
    }
};
template <bool SC> struct EpiResid {
    bf16_t* XB; float* ssn; const float* cscale; float alpha;
    __device__ __forceinline__ void operator()(EPI_ARGS) const {
        const int row0 = u.row0 + wr * 64 + fr, col0 = u.col0 + wc * 32 + 8 * fq;
        GAS bf16_t* base = (GAS bf16_t*)XB + (size_t)row0 * D + col0;
        u32x4 xo[2][4][2];
#pragma unroll
        for (int ai = 0; ai < 2; ++ai)
#pragma unroll
            for (int m = 0; m < 4; ++m)
#pragma unroll
                for (int bj = 0; bj < 2; ++bj) xo[ai][m][bj] = *(GAS u32x4*)(base + (size_t)(ai * HALF + m * 16) * D + bj * HALF);
        float q[2][4];
#pragma unroll
        for (int ai = 0; ai < 2; ++ai)
#pragma unroll
            for (int m = 0; m < 4; ++m) q[ai][m] = 0.f;
#pragma unroll
        for (int bj = 0; bj < 2; ++bj) {
            const float al = alpha; const f32x4 ones = {1.f, 1.f, 1.f, 1.f};
            const f32x4 sc0 = (SC ? *(const GAS f32x4*)(cscale + col0 + bj * HALF) : ones) * al, sc1 = (SC ? *(const GAS f32x4*)(cscale + col0 + bj * HALF + 4) : ones) * al;
#pragma unroll
            for (int ai = 0; ai < 2; ++ai)
#pragma unroll
                for (int m = 0; m < 4; ++m) { const u32x4 o = xo[ai][m][bj]; const f32x4 d0 = acc[ai][bj][m][0] * sc0, d1 = acc[ai][bj][m][1] * sc1;
                    u32x4 w; w.x = pk_bf16(bf_lo(o.x) + d0[0], bf_hi(o.x) + d0[1]); w.y = pk_bf16(bf_lo(o.y) + d0[2], bf_hi(o.y) + d0[3]); w.z = pk_bf16(bf_lo(o.z) + d1[0], bf_hi(o.z) + d1[1]); w.w = pk_bf16(bf_lo(o.w) + d1[2], bf_hi(o.w) + d1[3]);
                    const int row = row0 + ai * HALF + m * 16;
                    if (row >= u.vlo && row < u.vhi) *(GAS u32x4*)(base + (size_t)(ai * HALF + m * 16) * D + bj * HALF) = w;
                    q[ai][m] += (bf_lo(w.x) * bf_lo(w.x) + bf_hi(w.x) * bf_hi(w.x)) + (bf_lo(w.y) * bf_lo(w.y) + bf_hi(w.y) * bf_hi(w.y)) + (bf_lo(w.z) * bf_lo(w.z) + bf_hi(w.z) * bf_hi(w.z)) + (bf_lo(w.w) * bf_lo(w.w) + bf_hi(w.w) * bf_hi(w.w)); }
        }
#pragma unroll
        for (int ai = 0; ai < 2; ++ai)
#pragma unroll
            for (int m = 0; m < 4; ++m) { float t = q[ai][m]; t += shx(t, 16, fq * 16 + fr); t += shx(t, 32, fq * 16 + fr);
                const int row = row0 + ai * HALF + m * 16;
                if (fq == 0 && alpha != 0.f && row >= u.vlo && row < u.vhi) __builtin_amdgcn_global_atomic_fadd_f32((GAS float*)ssn + row, t); }
    }
};
struct EpiMemK {
    float* F; bf16_t* B;
    __device__ __forceinline__ void operator()(EPI_ARGS) const {
        const int row0 = u.row0 + wr * 64 + fr, col0 = u.col0 + wc * 32 + 8 * fq;
#pragma unroll
        for (int ai = 0; ai < 2; ++ai)
#pragma unroll
            for (int m = 0; m < 4; ++m) { const size_t off = (size_t)(row0 + ai * HALF + m * 16) * D + col0;
#pragma unroll
                for (int bj = 0; bj < 2; ++bj) { const f32x4 v0 = acc[ai][bj][m][0], v1 = acc[ai][bj][m][1];
                    *(f32x4*)(F + off + bj * HALF) = v0; *(f32x4*)(F + off + bj * HALF + 4) = v1;
                    u32x4 w; w.x = pk_bf16(v0[0], v0[1]); w.y = pk_bf16(v0[2], v0[3]); w.z = pk_bf16(v1[0], v1[1]); w.w = pk_bf16(v1[2], v1[3]);
                    *(u32x4*)(B + off + bj * HALF) = w; } }
    }
};
__device__ __forceinline__ float dpp_ror1(float v) { return __int_as_float(__builtin_amdgcn_update_dpp(0, __float_as_int(v), 0x121, 0xf, 0xf, false)); }
__device__ __forceinline__ float dpp_ror2(float v) { return __int_as_float(__builtin_amdgcn_update_dpp(0, __float_as_int(v), 0x122, 0xf, 0xf, false)); }
__device__ __forceinline__ f32x4 ror1(const f32x4 v) { return (f32x4){dpp_ror1(v[0]), dpp_ror1(v[1]), dpp_ror1(v[2]), dpp_ror1(v[3])}; }
__device__ __forceinline__ f32x4 ror2(const f32x4 v) { return (f32x4){dpp_ror2(v[0]), dpp_ror2(v[1]), dpp_ror2(v[2]), dpp_ror2(v[3])}; }
__device__ __forceinline__ f32x4 sel4(bool c, const f32x4 a, const f32x4 b) { return (f32x4){c ? a[0] : b[0], c ? a[1] : b[1], c ? a[2] : b[2], c ? a[3] : b[3]}; }
struct EpiUpGate {
    bf16_t* A2; const float* cw; const float* cb; const float* sfs; float* fsp; float* fss; float* edge; float* first; int xoff; const float* ss;
    __device__ __forceinline__ void operator()(EPI_ARGS) const {
#pragma unroll
        for (int ai = 0; ai < 2; ++ai)
#pragma unroll
            for (int m = 0; m < 4; ++m) { const float rs = __builtin_amdgcn_rsqf(ss[u.row0 + ai * HALF + wr * 64 + m * 16 + fr] * (1.f / D) + RMS_EPS);
#pragma unroll
                for (int bj = 0; bj < 2; ++bj) { acc[ai][bj][m][0] = acc[ai][bj][m][0] * rs; acc[ai][bj][m][1] = acc[ai][bj][m][1] * rs; } }
        LAS float* X = (LAS float*)(lds + xoff);
        const int pn = u.col0 >> 8, pm = u.row0 >> 8, cl = wc * 32 + 8 * fq, ch = pn * 128 + cl;
        const bool samp = u.row0 >= MP;
        if (fr >= 14) {
#pragma unroll
            for (int ai = 0; ai < 2; ++ai) {
#pragma unroll
                for (int bj = 0; bj < 2; ++bj)
#pragma unroll
                    for (int n = 0; n < 2; ++n) *(LAS f32x4*)(X + ((ai * 2 + wr) * 2 + (fr - 14)) * 256 + bj * HALF + cl + 4 * n) = acc[ai][bj][3][n];
                const bool is_state = samp || (ai == 1 && wr == 1 && (pm & 15) == 15);
                if (is_state) {
                    float* st = samp ? fss + ((size_t)((u.row0 + ai * HALF + wr * 64 - MP) >> 6) * 2 + (fr - 14)) * FF2 : fsp + ((size_t)(pm >> 4) * 2 + (fr - 14)) * FF2;
#pragma unroll
                    for (int bj = 0; bj < 2; ++bj) { float* sp = st + bj * FF + ch; *(f32x4*)sp = acc[ai][bj][3][0]; *(f32x4*)(sp + 4) = acc[ai][bj][3][1]; } }
                asm volatile("" ::: "memory");
            }
            if (wr == 1) {
#pragma unroll
                for (int bj = 0; bj < 2; ++bj)
#pragma unroll
                    for (int n = 0; n < 2; ++n) *(f32x4*)(edge + ((size_t)pm * 2 + (fr - 14)) * FF2 + u.col0 + bj * HALF + cl + 4 * n) = acc[1][bj][3][n];
            }
        }
        if (wr == 0 && fr < 2) {
#pragma unroll
            for (int bj = 0; bj < 2; ++bj)
#pragma unroll
                for (int n = 0; n < 2; ++n) *(f32x4*)(first + ((size_t)pm * 2 + fr) * FF2 + u.col0 + bj * HALF + cl + 4 * n) = acc[0][bj][0][n];
        }
        unsigned P[2][2][4][4];
#pragma unroll
        for (int ai = 0; ai < 2; ++ai)
#pragma unroll
            for (int bj = 0; bj < 2; ++bj)
#pragma unroll
                for (int m = 0; m < 4; ++m)
#pragma unroll
                    for (int n = 0; n < 2; ++n) { const f32x4 v = acc[ai][bj][m][n];
                        asm volatile("v_cvt_pk_bf16_f32 %0, %1, %2" : "=v"(P[ai][bj][m][2 * n]) : "v"(v[0]), "v"(v[1])); asm volatile("v_cvt_pk_bf16_f32 %0, %1, %2" : "=v"(P[ai][bj][m][2 * n + 1]) : "v"(v[2]), "v"(v[3])); }
        f32x4 WG[3][2], WV[3][2], BG[2], BV[2];
#pragma unroll
        for (int n = 0; n < 2; ++n) {
#pragma unroll
            for (int j = 0; j < 3; ++j) { WG[j][n] = *(const GAS f32x4*)(cw + (size_t)j * FF2 + ch + 4 * n); WV[j][n] = *(const GAS f32x4*)(cw + (size_t)j * FF2 + FF + ch + 4 * n); }
            BG[n] = *(const GAS f32x4*)(cb + ch + 4 * n); BV[n] = *(const GAS f32x4*)(cb + FF + ch + 4 * n); }
        asm volatile("s_waitcnt lgkmcnt(0)" ::: "memory"); __builtin_amdgcn_s_barrier(); asm volatile("" ::: "memory");
        const bool f0 = fr == 0, f01 = fr < 2;
#pragma unroll
        for (int ai = 0; ai < 2; ++ai) {
            const int brow0 = u.row0 + ai * HALF + wr * 64;
            const int sb = samp ? ((brow0 - MP) >> 6) : 0, pred = (ai * 2 + wr) > 0 ? (ai * 2 + wr - 1) : 0;
            const bool use_x = !samp && (brow0 & (SEQ - 1)) != 0 && (ai | wr) != 0;
            const int hsel = fr >= 14 ? fr - 14 : 0;
            unsigned pk[4][4];
#pragma unroll
            for (int q = 0; q < 4; ++q) {
                const int c2 = ch + 2 * q;
                f32x2_t wg[3], wv[3];
#pragma unroll
                for (int j = 0; j < 3; ++j) { wg[j] = (f32x2_t){WG[j][q >> 1][2 * (q & 1)], WG[j][q >> 1][2 * (q & 1) + 1]}; wv[j] = (f32x2_t){WV[j][q >> 1][2 * (q & 1)], WV[j][q >> 1][2 * (q & 1) + 1]}; }
                const f32x2_t bg = {BG[q >> 1][2 * (q & 1)], BG[q >> 1][2 * (q & 1) + 1]}, bv = {BV[q >> 1][2 * (q & 1)], BV[q >> 1][2 * (q & 1) + 1]};
                const LAS float* xp = X + (pred * 2 + hsel) * 256 + cl + 2 * q;
                const f32x2_t xgv = *(const LAS f32x2_t*)xp, xvv = *(const LAS f32x2_t*)(xp + HALF);
                unsigned hg = use_x ? pk_bf16(xgv.x, xgv.y) : 0u, hv = use_x ? pk_bf16(xvv.x, xvv.y) : 0u;
                if (samp) { const float* sp = sfs + ((size_t)sb * 2 + hsel) * FF2 + c2; const f32x2_t sgv = *(const GAS f32x2_t*)sp, svv = *(const GAS f32x2_t*)(sp + FF); hg = pk_bf16(sgv.x, sgv.y); hv = pk_bf16(svv.x, svv.y); }
                unsigned rg1 = __builtin_amdgcn_mov_dpp(hg, 0x121, 0xf, 0xf, false), rg2 = __builtin_amdgcn_mov_dpp(hg, 0x122, 0xf, 0xf, false);
                unsigned rv1 = __builtin_amdgcn_mov_dpp(hv, 0x121, 0xf, 0xf, false), rv2 = __builtin_amdgcn_mov_dpp(hv, 0x122, 0xf, 0xf, false);
#pragma unroll
                for (int m = 0; m < 4; ++m) {
                    const unsigned ug = P[ai][0][m][q], uv = P[ai][1][m][q];
                    const unsigned cg1 = __builtin_amdgcn_mov_dpp(ug, 0x121, 0xf, 0xf, false), cg2 = __builtin_amdgcn_mov_dpp(ug, 0x122, 0xf, 0xf, false);
                    const unsigned cv1 = __builtin_amdgcn_mov_dpp(uv, 0x121, 0xf, 0xf, false), cv2 = __builtin_amdgcn_mov_dpp(uv, 0x122, 0xf, 0xf, false);
                    const unsigned g1 = f0 ? rg1 : cg1, g2 = f01 ? rg2 : cg2, v1 = f0 ? rv1 : cv1, v2 = f01 ? rv2 : cv2;
                    const float ga = bg.x + wg[0].x * bf_lo(g2) + wg[1].x * bf_lo(g1) + wg[2].x * bf_lo(ug), gb = bg.y + wg[0].y * bf_hi(g2) + wg[1].y * bf_hi(g1) + wg[2].y * bf_hi(ug);
                    const float va = bv.x + wv[0].x * bf_lo(v2) + wv[1].x * bf_lo(v1) + wv[2].x * bf_lo(uv), vb = bv.y + wv[0].y * bf_hi(v2) + wv[1].y * bf_hi(v1) + wv[2].y * bf_hi(uv);
                    const float y0 = ga * va * __builtin_amdgcn_rcpf(1.f + __builtin_amdgcn_exp2f(-ga * LOG2E)), y1 = gb * vb * __builtin_amdgcn_rcpf(1.f + __builtin_amdgcn_exp2f(-gb * LOG2E));
                    pk[m][q] = pk_bf16(y0, y1);
                    rg1 = cg1; rg2 = cg2; rv1 = cv1; rv2 = cv2;
                }
            }
#pragma unroll
            for (int m = 0; m < 4; ++m) { u32x4 w; w.x = pk[m][0]; w.y = pk[m][1]; w.z = pk[m][2]; w.w = pk[m][3];
                *(u32x4*)(A2 + (size_t)(brow0 + m * 16 + fr) * FF + ch) = w; }
            asm volatile("" ::: "memory");
        }
    }
};
struct EpiSoftmax {
    bf16_t* P; int xoff; const float* ss; float scale;
    __device__ __forceinline__ void operator()(EPI_ARGS) const {
        LAS f32x2_t* X = (LAS f32x2_t*)(lds + xoff);
#pragma unroll
        for (int ai = 0; ai < 2; ++ai)
#pragma unroll
            for (int m = 0; m < 4; ++m) { const float rs = scale * __builtin_amdgcn_rsqf(ss[u.row0 + ai * HALF + wr * 64 + m * 16 + fr] * (1.f / D) + RMS_EPS);
#pragma unroll
                for (int bj = 0; bj < 2; ++bj) { acc[ai][bj][m][0] = acc[ai][bj][m][0] * rs; acc[ai][bj][m][1] = acc[ai][bj][m][1] * rs; } }
        float mw[2][4];
#pragma unroll
        for (int ai = 0; ai < 2; ++ai)
#pragma unroll
            for (int m = 0; m < 4; ++m) {
                float mx = -3.0e38f;
#pragma unroll
                for (int bj = 0; bj < 2; ++bj)
#pragma unroll
                    for (int n = 0; n < 2; ++n) { const f32x4 x = acc[ai][bj][m][n]; mx = fmaxf(mx, fmaxf(fmaxf(x[0], x[1]), fmaxf(x[2], x[3]))); }
                mx = fmaxf(mx, shx(mx, 16, fq * 16 + fr)); mx = fmaxf(mx, shx(mx, 32, fq * 16 + fr));
                float s = 0.f;
#pragma unroll
                for (int bj = 0; bj < 2; ++bj)
#pragma unroll
                    for (int n = 0; n < 2; ++n) { f32x4 x = acc[ai][bj][m][n];
#pragma unroll
                        for (int e = 0; e < 4; ++e) { x[e] = __builtin_amdgcn_exp2f(x[e] - mx); s += x[e]; } acc[ai][bj][m][n] = x; }
                s += shx(s, 16, fq * 16 + fr); s += shx(s, 32, fq * 16 + fr);
                mw[ai][m] = mx;
                if (fq == 0) X[(ai * HALF + wr * 64 + m * 16 + fr) * 4 + wc] = (f32x2_t){mx, s};
            }
        asm volatile("s_waitcnt lgkmcnt(0)" ::: "memory"); __builtin_amdgcn_s_barrier(); asm volatile("" ::: "memory");
        const int row0 = u.row0 + wr * 64 + fr, col0 = u.col0 + wc * 32 + 8 * fq;
#pragma unroll
        for (int ai = 0; ai < 2; ++ai)
#pragma unroll
            for (int m = 0; m < 4; ++m) { const int rl = ai * HALF + wr * 64 + m * 16 + fr;
                const f32x2_t a = X[rl * 4 + 0], b = X[rl * 4 + 1], c = X[rl * 4 + 2], d = X[rl * 4 + 3];
                const float mt = fmaxf(fmaxf(a.x, b.x), fmaxf(c.x, d.x));
                const float L = a.y * __builtin_amdgcn_exp2f(a.x - mt) + b.y * __builtin_amdgcn_exp2f(b.x - mt) + c.y * __builtin_amdgcn_exp2f(c.x - mt) + d.y * __builtin_amdgcn_exp2f(d.x - mt);
                const float f = __builtin_amdgcn_exp2f(mw[ai][m] - mt) / L;
                const int row = row0 + ai * HALF + m * 16;
                if (row >= u.vlo && row < u.vhi) {
#pragma unroll
                for (int bj = 0; bj < 2; ++bj) { const f32x4 v0 = acc[ai][bj][m][0] * f, v1 = acc[ai][bj][m][1] * f;
                    u32x4 w; w.x = pk_bf16(v0[0], v0[1]); w.y = pk_bf16(v0[2], v0[3]); w.z = pk_bf16(v1[0], v1[1]); w.w = pk_bf16(v1[2], v1[3]);
                    *(u32x4*)(P + (size_t)row * D + col0 + bj * HALF) = w; } } }
    }
};
struct SchedQKV {
    const char* A; const char* Bt; int nM, G, c;
    __device__ __forceinline__ bool next(int i, Unit& u) const {
        int pm, pj; if (!tile_of((long)i * G + c, nM, 12, pm, pj)) return false;
        const int pn = (pj % 3) * 4 + pj / 3;
        u.a = A + (size_t)pm * BM * D * 2; u.b = Bt + (size_t)pn * BM * D * 2; u.row0 = pm * BM; u.col0 = pn * BM; u.vlo = 0; u.vhi = 0x7fffffff; u.aux = pn; return true;
    }
};
struct SchedPool { const char* A; const char* Bt; int G, c;
    __device__ __forceinline__ bool next(int i, Unit& u) const { int pm, pn; if (!tile_of((long)i * G + c, M / 256, 4, pm, pn)) return false;
        u.a = A + ((size_t)pm * 256 * D + pn * 256) * 2; u.b = Bt + (size_t)pn * 65536 * 2; u.row0 = pm * 256; u.col0 = pn * 256; u.vlo = 0; u.vhi = 0x7fffffff; u.aux = 0; return true; } };
}

namespace sba {
constexpr float QSCALE = 0.125f * LOG2E;
constexpr float EXIT_T = 126.f;
constexpr int VDH = 4160, KIMG = 2 * VDH, KROW = 144, WAVE_LDS = KIMG + 64 * KROW;
__device__ __forceinline__ int crow(int r, int hi) { return (r & 3) + 8 * (r >> 2) + 4 * hi; }
__device__ __forceinline__ s16x4 vtr(LAS const char* p) { typedef short v4i16_t __attribute__((ext_vector_type(4))); return __builtin_bit_cast(s16x4, __builtin_amdgcn_ds_read_tr16_b64_v4i16((LAS v4i16_t*)p)); }

__device__ __forceinline__ bf16x8 cvt8(const f32x4 a, const f32x4 b) { u32x4 w; w.x = pk_bf16(a[0], a[1]); w.y = pk_bf16(a[2], a[3]); w.z = pk_bf16(b[0], b[1]); w.w = pk_bf16(b[2], b[3]); return __builtin_bit_cast(bf16x8, w); }
__device__ __forceinline__ void load_bf16(const bf16_t* Kt, const bf16_t* Vt, LAS char* vimg, int lane) {
    const int c = lane & 7;
    LAS char* vdst = vimg + (c >> 2) * VDH + (lane >> 3) * 64 + (c & 3) * 16; LAS char* kdst = vimg + KIMG + (lane >> 3) * KROW + c * 16;
    const unsigned vvo = (unsigned)((lane >> 3) * D + 8 * c) * 2u;
#pragma unroll
    for (int it = 0; it < 8; ++it) { const u32x4 v = *(const GAS u32x4*)((const GAS char*)Vt + (size_t)it * 8 * D * 2 + vvo); *(LAS u32x4*)(vdst + it * 512) = v; }
#pragma unroll
    for (int it = 0; it < 8; ++it) { const u32x4 v = *(const GAS u32x4*)((const GAS char*)Kt + (size_t)it * 8 * D * 2 + vvo); *(LAS u32x4*)(kdst + it * 8 * KROW) = v; }
}
__device__ __forceinline__ void load_f32(const float* Kt, const float* Vt, LAS char* vimg, int lane) {
    const int c = lane & 7;
    LAS char* vdst = vimg + (c >> 2) * VDH + (lane >> 3) * 64 + (c & 3) * 16; LAS char* kdst = vimg + KIMG + (lane >> 3) * KROW + c * 16;
    const unsigned vvo = (unsigned)((lane >> 3) * D + 8 * c) * 4u;
#pragma unroll
    for (int hv = 0; hv < 2; ++hv) {
#pragma unroll
        for (int it = 4 * hv; it < 4 * hv + 4; ++it) { const GAS f32x4* p = (const GAS f32x4*)((const GAS char*)Vt + (size_t)it * 8 * D * 4 + vvo); *(LAS u32x4*)(vdst + it * 512) = __builtin_bit_cast(u32x4, cvt8(p[0], p[1])); }
        asm volatile("" ::: "memory"); }
#pragma unroll
    for (int hv = 0; hv < 2; ++hv) {
#pragma unroll
        for (int it = 4 * hv; it < 4 * hv + 4; ++it) { const GAS f32x4* p = (const GAS f32x4*)((const GAS char*)Kt + (size_t)it * 8 * D * 4 + vvo); *(LAS u32x4*)(kdst + it * 8 * KROW) = __builtin_bit_cast(u32x4, cvt8(p[0], p[1])); }
        asm volatile("" ::: "memory"); }
}
__device__ __forceinline__ void load_bf16_regs(u32x4 (&kr)[8], u32x4 (&vr)[8], const bf16_t* Kt, const bf16_t* Vt, int lane) {
    const unsigned vvo = (unsigned)((lane >> 3) * D + 8 * (lane & 7)) * 2u;
#pragma unroll
    for (int it = 0; it < 8; ++it) vr[it] = *(const GAS u32x4*)((const GAS char*)Vt + (size_t)it * 8 * D * 2 + vvo);
#pragma unroll
    for (int it = 0; it < 8; ++it) kr[it] = *(const GAS u32x4*)((const GAS char*)Kt + (size_t)it * 8 * D * 2 + vvo);
}
template <bool PF>
__device__ __forceinline__ void tile_step(u32x4 (&kr)[8], u32x4 (&vr)[8], const bf16x8 (&qr)[4], f32x16 (&o)[2], float& carry, bool masked, bool upper_dead, int tq, LAS char* vimg, int lane, const bf16_t* nK, const bf16_t* nV, bool do_pf) {
    const int hi = lane >> 5;
    if (PF) { const int c = lane & 7; LAS char* vdst = vimg + (c >> 2) * VDH + (lane >> 3) * 64 + (c & 3) * 16; LAS char* kdst = vimg + KIMG + (lane >> 3) * KROW + c * 16;
#pragma unroll
        for (int it = 0; it < 8; ++it) *(LAS u32x4*)(kdst + it * 8 * KROW) = kr[it];
#pragma unroll
        for (int it = 0; it < 8; ++it) *(LAS u32x4*)(vdst + it * 512) = vr[it]; }
    asm volatile("s_waitcnt lgkmcnt(0)" ::: "memory");
    bf16x8 kf[8];
    { LAS const char* kb = vimg + KIMG + (lane & 31) * KROW + hi * 16;
#pragma unroll
      for (int hf = 0; hf < 2; ++hf)
#pragma unroll
          for (int d0 = 0; d0 < 4; ++d0) kf[hf * 4 + d0] = *(LAS const bf16x8*)(kb + hf * 32 * KROW + d0 * 32); }
    f32x16 p0 = {}, p1 = {};
#pragma unroll
    for (int d0 = 0; d0 < 4; ++d0) p0 = __builtin_amdgcn_mfma_f32_32x32x16_bf16(kf[d0], qr[d0], p0, 0, 0, 0);
    if (!upper_dead) {
#pragma unroll
        for (int d0 = 0; d0 < 4; ++d0) p1 = __builtin_amdgcn_mfma_f32_32x32x16_bf16(kf[4 + d0], qr[d0], p1, 0, 0, 0);
    }
    if (PF && do_pf) { load_bf16_regs(kr, vr, nK, nV, lane); }
    float k0[16], k1[16];
#pragma unroll
    for (int r = 0; r < 16; ++r) {
        const float z = __builtin_amdgcn_fmed3f(p0[r], -100.f, 100.f); const float e = __builtin_amdgcn_exp2f(-z); float sg = __builtin_amdgcn_rcpf(1.f + e); float kp = e * sg;
        if (masked && !(crow(r, hi) < tq)) { sg = 0.f; kp = 1.f; } p0[r] = sg; k0[r] = kp; }
    if (!upper_dead) {
#pragma unroll
        for (int r = 0; r < 16; ++r) {
            const float z = __builtin_amdgcn_fmed3f(p1[r], -100.f, 100.f); const float e = __builtin_amdgcn_exp2f(-z); float sg = __builtin_amdgcn_rcpf(1.f + e); float kp = e * sg;
            if (masked && !(crow(r, hi) + 32 < tq)) { sg = 0.f; kp = 1.f; } p1[r] = sg; k1[r] = kp; }
    } else {
#pragma unroll
        for (int r = 0; r < 16; ++r) { p1[r] = 0.f; k1[r] = 1.f; }
    }
    float Glo[8], Ghi[8];
#pragma unroll
    for (int a = 0; a < 8; ++a) { const float* kk = a < 4 ? k0 + 4 * a : k1 + 4 * (a - 4); const float g = (kk[0] * kk[1]) * (kk[2] * kk[3]);
        auto rr = __builtin_amdgcn_permlane32_swap(__float_as_uint(g), __float_as_uint(g), false, false); Glo[a] = __uint_as_float(rr[0]); Ghi[a] = __uint_as_float(rr[1]); }
    float sx = __builtin_amdgcn_exp2f(-carry);
#pragma unroll
    for (int a = 7; a >= 0; --a) {
        const float base = hi == 0 ? sx * Ghi[a] : sx;
        if (a >= 4) { const int q = 4 * (a - 4);
            const float s3 = base, s2 = s3 * k1[q + 3], s1 = s2 * k1[q + 2], s0 = s1 * k1[q + 1];
            p1[q + 3] *= s3; p1[q + 2] *= s2; p1[q + 1] *= s1; p1[q] *= s0;
        } else { const int q = 4 * a;
            const float s3 = base, s2 = s3 * k0[q + 3], s1 = s2 * k0[q + 2], s0 = s1 * k0[q + 1];
            p0[q + 3] *= s3; p0[q + 2] *= s2; p0[q + 1] *= s1; p0[q] *= s0;
        }
        sx *= Glo[a] * Ghi[a];
    }
    carry = -__builtin_amdgcn_logf(sx);
    bf16x8 pf[4];
#pragma unroll
    for (int s = 0; s < 4; ++s) { const f32x16& p = s < 2 ? p0 : p1; const int q = 8 * (s & 1);
        u32x4 w; w.x = pk_bf16(p[q], p[q + 1]); w.y = pk_bf16(p[q + 2], p[q + 3]); w.z = pk_bf16(p[q + 4], p[q + 5]); w.w = pk_bf16(p[q + 6], p[q + 7]); pf[s] = __builtin_bit_cast(bf16x8, w); }
    LAS const char* vb = vimg + (4 * hi + ((lane & 15) >> 2)) * 64 + ((lane >> 4) & 1) * 32 + (lane & 3) * 8;
#pragma unroll
    for (int dh = 0; dh < 2; ++dh) {
#pragma unroll
        for (int s = 0; s < 2; ++s) { const s16x4 lo = vtr(vb + dh * VDH + s * 1024), hh = vtr(vb + dh * VDH + s * 1024 + 512);
            const bf16x8 vf = (bf16x8){lo[0], lo[1], lo[2], lo[3], hh[0], hh[1], hh[2], hh[3]};
            o[dh] = __builtin_amdgcn_mfma_f32_32x32x16_bf16(vf, pf[s], o[dh], 0, 0, 0); }
        if (!upper_dead) {
#pragma unroll
            for (int s = 2; s < 4; ++s) { const s16x4 lo = vtr(vb + dh * VDH + s * 1024), hh = vtr(vb + dh * VDH + s * 1024 + 512);
                const bf16x8 vf = (bf16x8){lo[0], lo[1], lo[2], lo[3], hh[0], hh[1], hh[2], hh[3]};
                o[dh] = __builtin_amdgcn_mfma_f32_32x32x16_bf16(vf, pf[s], o[dh], 0, 0, 0); }
        }
    }
    asm volatile("s_waitcnt lgkmcnt(0)" ::: "memory");
}

struct Tensors { const bf16_t* Q; const bf16_t* K; const bf16_t* V; bf16_t* O; const float* cK; const float* cV; };

__device__ __forceinline__ void unit(int id, const Tensors& T, LAS char* vimg, int lane) {
    const int r32 = lane & 31, hi = lane >> 5;
    const bool samp = id >= 32768;
    int h, q0; size_t rowb; int b = 0;
    if (!samp) { const int qb = id & 127; h = (id >> 7) & 15; b = id >> 11; rowb = (size_t)b * SEQ; q0 = qb * 32; }
    else { const int s = id - 32768; const int qb = s & 1; h = (s >> 1) & 15; b = s >> 5; rowb = (size_t)MP + (size_t)b * DSEQ; q0 = qb * 32; }
    const bf16_t* Qw = T.Q + (rowb + q0) * D + h * 64; bf16_t* Ow = T.O + (rowb + q0) * D + h * 64;
    asm volatile("" : "+s"(Qw), "+s"(Ow));
    bf16x8 qr[4];
#pragma unroll
    for (int d0 = 0; d0 < 4; ++d0) qr[d0] = *(const GAS bf16x8*)((const GAS char*)Qw + 32 * d0 + (unsigned)(r32 * D + 8 * hi) * 2u);
    f32x16 o[2]; o[0] = f32x16{}; o[1] = f32x16{};
    float carry = 0.f;
    const bf16_t* Kh = T.K + rowb * D + h * 64; const bf16_t* Vh = T.V + rowb * D + h * 64;
    asm volatile("" : "+s"(Kh), "+s"(Vh));
    u32x4 kr[8], vr[8];
    int kt = q0 >> 6;
    if (!samp) {
        int k0 = q0 >= 32 ? q0 - 32 : 0;
        load_bf16_regs(kr, vr, Kh + (size_t)k0 * D, Vh + (size_t)k0 * D, lane);
        { const int kn = k0 >= 64 ? k0 - 64 : 0;
          tile_step<true>(kr, vr, qr, o, carry, true, q0 < 32, q0 + r32 - k0, vimg, lane, Kh + (size_t)kn * D, Vh + (size_t)kn * D, k0 > 0); }
        while (k0 > 0) {
            if (__all(carry > EXIT_T)) break;
            const int prev = k0; k0 = prev >= 64 ? prev - 64 : 0;
            const int kn = k0 >= 64 ? k0 - 64 : 0; const bool clamp = prev < 64;
            tile_step<true>(kr, vr, qr, o, carry, clamp, clamp && prev <= 32, prev - k0, vimg, lane, Kh + (size_t)kn * D, Vh + (size_t)kn * D, k0 > 0);
        }
    } else {
        load_bf16(Kh + (size_t)kt * 64 * D, Vh + (size_t)kt * 64 * D, vimg, lane);
        tile_step<false>(kr, vr, qr, o, carry, true, (q0 & 32) == 0, q0 + r32 - 64 * kt, vimg, lane, nullptr, nullptr, false);
        const float* cKh = T.cK + (size_t)b * PAST * D + h * 64; const float* cVh = T.cV + (size_t)b * PAST * D + h * 64;
        asm volatile("" : "+s"(cKh), "+s"(cVh));
        for (kt = PAST / 64 - 1; kt >= 0; --kt) {
            if (__all(carry > EXIT_T)) break;
            load_f32(cKh + (size_t)kt * 64 * D, cVh + (size_t)kt * 64 * D, vimg, lane);
            tile_step<false>(kr, vr, qr, o, carry, false, false, 64, vimg, lane, nullptr, nullptr, false);
        }
    }
#pragma unroll
    for (int dh = 0; dh < 2; ++dh)
#pragma unroll
        for (int a = 0; a < 4; ++a) { u32x2 w; w.x = pk_bf16(o[dh][4 * a], o[dh][4 * a + 1]); w.y = pk_bf16(o[dh][4 * a + 2], o[dh][4 * a + 3]);
            *(LAS u32x2*)(vimg + r32 * 144 + (32 * dh + 8 * a + 4 * hi) * 2) = w; }
    asm volatile("s_waitcnt lgkmcnt(0)" ::: "memory");
#pragma unroll
    for (int i = 0; i < 4; ++i) { const int row = i * 8 + (lane >> 3), ch = lane & 7; const u32x4 v = *(LAS const u32x4*)(vimg + row * 144 + ch * 16); *(GAS u32x4*)((GAS char*)Ow + (unsigned)(row * D + ch * 8) * 2u) = v; }
    asm volatile("s_waitcnt lgkmcnt(0)" ::: "memory");
}
}

constexpr int NWAVES = 8;
constexpr int RING_OFF = 0, RING_BYTES = 131072, XCH_OFF = RING_BYTES, XCH_BYTES = 8192, MISC_OFF = 143360, TICKET_OFF = MISC_OFF + 256, LDS_BYTES = 147456;
static_assert(sba::WAVE_LDS * NWAVES <= MISC_OFF && XCH_OFF + XCH_BYTES <= MISC_OFF && TICKET_OFF + 64 <= LDS_BYTES, "LDS map");

#define XB_TMO      128
#define XB_XCNT(j)  (256  + 64 * (j))
#define XB_XSUB(j)  (1280 + 64 * (j))
#define XB_XGEN(j)  (2304 + 64 * (j))
#define XB_TOP      3328
#define XB_TOPGEN   3392
#define XCD_BAR_WORDS 3456
#define XB_SPIN_CAP (1u << 18)
__device__ __forceinline__ unsigned xb_ld(unsigned* p)              { return __hip_atomic_load(p, __ATOMIC_RELAXED, __HIP_MEMORY_SCOPE_AGENT); }
__device__ __forceinline__ unsigned xb_add(unsigned* p, unsigned v) { return __hip_atomic_fetch_add(p, v, __ATOMIC_RELAXED, __HIP_MEMORY_SCOPE_AGENT); }
__device__ __forceinline__ unsigned xb_xcc_id() { return (unsigned)__builtin_amdgcn_s_getreg((3 << 11) | 20) & 0xFu; }
#define XB_SPIN(cond, bar) do { unsigned _sp = 0; while (cond) { __builtin_amdgcn_s_sleep(1); \
    if ((++_sp & 255u) == 0u) { if (xb_ld(&(bar)[XB_TMO])) break; if (_sp > XB_SPIN_CAP) { atomicAdd(&(bar)[XB_TMO], 1u); break; } } } } while (0)
struct XcdBarrier { unsigned* bar; unsigned x; volatile LAS unsigned* st; };
__device__ __forceinline__ XcdBarrier xcd_barrier_post(unsigned* bar, volatile LAS unsigned* st, int tid) {
    XcdBarrier b; b.bar = bar; b.x = xb_xcc_id(); b.st = st;
    if (tid == 0) (void)xb_add(&bar[XB_XCNT(b.x)], 1u);
    return b;
}
__device__ __forceinline__ void xcd_barrier_complete(unsigned* bar, unsigned x, unsigned& nloc, unsigned& nx) {
    const unsigned G = gridDim.x * gridDim.y * gridDim.z;
    unsigned sum, cnt, mine, sp = 0u;
    for (;;) {
        sum = 0u; cnt = 0u; mine = 0u;
#pragma unroll
        for (unsigned j = 0; j < 16; ++j) { const unsigned c = xb_ld(&bar[XB_XCNT(j)]); sum += c; cnt += (c > 0u) ? 1u : 0u; mine = (j == x) ? c : mine; }
        if (sum == G) break;
        __builtin_amdgcn_s_sleep(1);
        if ((++sp & 255u) == 0u) { if (xb_ld(&bar[XB_TMO])) break; if (sp > XB_SPIN_CAP) { atomicAdd(&bar[XB_TMO], 1u); break; } }
    }
    nloc = mine > 0u ? mine : 1u; nx = cnt > 0u ? cnt : 1u;
}
__device__ __forceinline__ void xcd_barrier(const XcdBarrier& b, int tid) {
    asm volatile("s_waitcnt vmcnt(0)" ::: "memory");
    __syncthreads();
    if (tid == 0) {
        unsigned* bar = b.bar;
        __builtin_amdgcn_s_waitcnt(0);
        unsigned nloc = b.st[0], nx = b.st[1];
        if (nloc == 0u) { xcd_barrier_complete(bar, b.x, nloc, nx); b.st[0] = nloc; b.st[1] = nx; }
        const unsigned old = xb_add(&bar[XB_XSUB(b.x)], 1u);
        const unsigned gen = old / nloc;
        if (old + 1u == (gen + 1u) * nloc) {
            __builtin_amdgcn_fence(__ATOMIC_RELEASE, "agent");
            asm volatile("s_waitcnt vmcnt(0)" ::: "memory");
            const unsigned og = xb_add(&bar[XB_TOP], 1u);
            const unsigned tg = og / nx;
            if (og + 1u == (tg + 1u) * nx) xb_add(&bar[XB_TOPGEN], 1u);
            else XB_SPIN(xb_ld(&bar[XB_TOPGEN]) == tg, bar);
            __builtin_amdgcn_fence(__ATOMIC_ACQUIRE, "agent");
            xb_add(&bar[XB_XGEN(b.x)], 1u);
            asm volatile("s_waitcnt vmcnt(0)" ::: "memory");
        } else {
            XB_SPIN(xb_ld(&bar[XB_XGEN(b.x)]) == gen, bar);
            __builtin_amdgcn_fence(__ATOMIC_ACQUIRE, "agent");
            asm volatile("s_waitcnt vmcnt(0)" ::: "memory");
        }
    }
    __syncthreads();
}

struct Args { const float* in[25]; float* out; unsigned char* ws; int ph_lo, ph_hi; };
struct Frame { LAS unsigned char* lds; int tid, lane, wave, vcu, G, gw, NGW, bx; };

__device__ __forceinline__ float wave_sum(float v, int lane) {
#pragma unroll
    for (int o = 1; o < 64; o <<= 1) v += shx(v, o, lane);
    return v;
}
__device__ __forceinline__ void transpose_item(const float* W, int ldw, int k0, int n0, bf16_t* WT, int ldt, int drow0, LAS float* scr, int lane, const float* gk = nullptr) {
    f32x4 t[8];
#pragma unroll
    for (int i = 0; i < 8; ++i) { const int kk = 8 * i + (lane >> 3); t[i] = *(const GAS f32x4*)(W + (size_t)(k0 + kk) * ldw + n0 + 4 * (lane & 7)); }
#pragma unroll
    for (int i = 0; i < 8; ++i) { const int kk = 8 * i + (lane >> 3); const float g = gk ? gk[k0 + kk] : 1.f; LAS float* d = scr + kk * 33 + 4 * (lane & 7);
        d[0] = t[i][0] * g; d[1] = t[i][1] * g; d[2] = t[i][2] * g; d[3] = t[i][3] * g; }
    asm volatile("s_waitcnt lgkmcnt(0)" ::: "memory");
    const int c = lane & 7;
#pragma unroll
    for (int j = 0; j < 4; ++j) { const int n = (lane >> 3) + 8 * j; const LAS float* s = scr + (8 * c) * 33 + n;
        u32x4 o; o.x = pk_bf16(s[0 * 33], s[1 * 33]); o.y = pk_bf16(s[2 * 33], s[3 * 33]); o.z = pk_bf16(s[4 * 33], s[5 * 33]); o.w = pk_bf16(s[6 * 33], s[7 * 33]);
        *(GAS u32x4*)(WT + (size_t)(drow0 + n) * ldt + k0 + 8 * c) = o; }
    asm volatile("s_waitcnt lgkmcnt(0)" ::: "memory");
}
__device__ __forceinline__ void transpose_mat_item(const float* W, int ldw, int K, int N, bf16_t* WT, int r, LAS float* scr, int lane, const float* gk = nullptr) {
    const int nblk = N / 32, kb = r / nblk, nb = r % nblk; transpose_item(W, ldw, 64 * kb, 32 * nb, WT, K, 32 * nb, scr, lane, gk);
}
__device__ __forceinline__ void norm_row(const float* xrow, const float* g, bf16_t* hb, float* xc, float* fo, int lane) {
    const GAS f32x4* xr = (const GAS f32x4*)xrow + lane; const GAS f32x4* gr = (const GAS f32x4*)g + lane;
    f32x4 v[4]; float s = 0.f;
#pragma unroll
    for (int j = 0; j < 4; ++j) { v[j] = xr[64 * j]; s += (v[j].x * v[j].x + v[j].y * v[j].y) + (v[j].z * v[j].z + v[j].w * v[j].w); }
    if (xc) {
#pragma unroll
        for (int j = 0; j < 4; ++j) ((GAS f32x4*)xc + lane)[64 * j] = v[j];
    }
    const float rstd = 1.0f / sqrtf(wave_sum(s, lane) * (1.f / D) + RMS_EPS);
#pragma unroll
    for (int j = 0; j < 4; ++j) { v[j] = v[j] * rstd * gr[64 * j]; }
    if (hb) { GAS u32x2* o8 = (GAS u32x2*)hb + lane;
#pragma unroll
        for (int j = 0; j < 4; ++j) { u32x2 w; w.x = pk_bf16(v[j].x, v[j].y); w.y = pk_bf16(v[j].z, v[j].w); o8[64 * j] = w; } }
    if (fo) {
#pragma unroll
        for (int j = 0; j < 4; ++j) ((GAS f32x4*)fo + lane)[64 * j] = v[j];
    }
}
__device__ __forceinline__ int up_dest_row(int n) { return n < FF ? 256 * (n >> 7) + (n & 127) : 256 * ((n - FF) >> 7) + 128 + ((n - FF) & 127); }

__device__ __forceinline__ void ffn_weight_items(const Frame& F, const Args& a, int l, int wi, int nw) {
    LAS float* scr = (LAS float*)(F.lds + RING_OFF + F.wave * 16384);
    unsigned char* ws = a.ws;
    constexpr int I_UP = 16 * 176, I_DN = 44 * 32;
    for (int r = wi; r < I_UP + I_DN; r += nw) {
        if (r < I_UP) { const int kb = r / 176, nb = r % 176;
            transpose_item(a.in[21] + (size_t)l * D * FF2, FF2, 64 * kb, 32 * nb, (bf16_t*)(ws + WS_WUP) + (size_t)l * FF2 * D, D, up_dest_row(32 * nb), scr, F.lane, a.in[12] + l * D); }
        else transpose_mat_item(a.in[24] + (size_t)l * FF * D, D, FF, D, (bf16_t*)(ws + WS_WDN) + (size_t)l * D * FF, r - I_UP, scr, F.lane);
    }
}
__device__ __forceinline__ void p0_prologue(const Frame& F, const Args& a) {
    LAS float* scr = (LAS float*)(F.lds + RING_OFF + F.wave * 16384);
    unsigned char* ws = a.ws;
    constexpr int I_QKV = 16 * 96, I_SQ = 16 * 32, I_POOL = 4 * 32, I_KV = 16 * 64;
    constexpr int NIT = I_QKV + I_SQ + I_POOL + 2 * I_KV + 2 * I_SQ;
    for (int it = F.gw; it < NIT; it += F.NGW) {
        int r = it;
        if (r < I_QKV) { transpose_mat_item(a.in[14], 3 * D, D, 3 * D, (bf16_t*)(ws + WS_WQKV), r, scr, F.lane, a.in[9]); continue; } r -= I_QKV;
        if (r < I_SQ) { transpose_mat_item(a.in[15], D, D, D, (bf16_t*)(ws + WS_WO), r, scr, F.lane); continue; } r -= I_SQ;
        if (r < I_POOL) { const int g = r >> 5; transpose_mat_item(a.in[16] + (size_t)g * 65536, 256, 256, 256, (bf16_t*)(ws + WS_WPOOL) + (size_t)g * 65536, r & 31, scr, F.lane); continue; } r -= I_POOL;
        if (r < 2 * I_KV) { const int l = r / I_KV; transpose_mat_item(a.in[19] + (size_t)l * D * 2 * D, 2 * D, D, 2 * D, (bf16_t*)(ws + WS_WCAKV) + (size_t)l * 2 * D * D, r % I_KV, scr, F.lane); continue; } r -= 2 * I_KV;
        if (r < 2 * I_SQ) { const int l = r / I_SQ; transpose_mat_item(a.in[20] + (size_t)l * D * D, D, D, D, (bf16_t*)(ws + WS_WCAO) + (size_t)l * D * D, r % I_SQ, scr, F.lane); continue; } r -= 2 * I_SQ;
    }
    { const int n8 = 2 * D * D / 8;
      for (int i = F.bx * 512 + F.tid; i < n8; i += F.G * 512) { const int l = i / (D * D / 8), kk = (i % (D * D / 8)) / (D / 8); const float g = a.in[10][l * D + kk];
          const GAS f32x4* src = (const GAS f32x4*)a.in[18] + 2 * (size_t)i; const f32x4 x = src[0] * g, y = src[1] * g;
          u32x4 w; w.x = pk_bf16(x[0], x[1]); w.y = pk_bf16(x[2], x[3]); w.z = pk_bf16(y[0], y[1]); w.w = pk_bf16(y[2], y[3]); ((GAS u32x4*)(ws + WS_WCAQ))[i] = w; } }
    { const GAS f32x4* src = (const GAS f32x4*)a.in[8]; GAS u32x4* dst = (GAS u32x4*)(ws + WS_VMTS); const int n8 = 2 * DB * NMEM * D / 8;
      for (int i = F.bx * 512 + F.tid; i < n8; i += F.G * 512) { const f32x4 x = src[2 * i], y = src[2 * i + 1]; u32x4 w; w.x = pk_bf16(x[0], x[1]); w.y = pk_bf16(x[2], x[3]); w.z = pk_bf16(y[0], y[1]); w.w = pk_bf16(y[2], y[3]); dst[i] = w; } }
    { const GAS f32x4* src = (const GAS f32x4*)a.in[7]; GAS u32x4* dst = (GAS u32x4*)(ws + WS_KMS); const int n8 = 2 * DB * NMEM * D / 8;
      for (int i = F.bx * 512 + F.tid; i < n8; i += F.G * 512) { const f32x4 x = src[2 * i], y = src[2 * i + 1]; u32x4 w; w.x = pk_bf16(x[0], x[1]); w.y = pk_bf16(x[2], x[3]); w.z = pk_bf16(y[0], y[1]); w.w = pk_bf16(y[2], y[3]); dst[i] = w; } }
    for (int m = F.gw; m < 2 * NB * NMEM; m += F.NGW) { const int l = m / (NB * NMEM), r = m % (NB * NMEM);
        norm_row(a.in[2] + (size_t)r * D, a.in[11] + l * D, (bf16_t*)(ws + WS_MN) + (size_t)m * D, nullptr, nullptr, F.lane); }
    { GAS float* ssz = (GAS float*)(ws + WS_SS) + M; for (int i = F.bx * 512 + F.tid; i < 6 * M; i += F.G * 512) ssz[i] = 0.f; }
    for (int m = F.gw; m < M; m += 2 * F.NGW) {
        const int m2 = m + F.NGW; const bool has2 = m2 < M;
        const float* xr = m < MP ? a.in[0] + (size_t)m * D : a.in[1] + (size_t)(m - MP) * D; const float* xr2 = !has2 ? xr : (m2 < MP ? a.in[0] + (size_t)m2 * D : a.in[1] + (size_t)(m2 - MP) * D);
        const GAS f32x4* xp = (const GAS f32x4*)xr + F.lane; const GAS f32x4* xp2 = (const GAS f32x4*)xr2 + F.lane;
        f32x4 v[4], v2[4];
#pragma unroll
        for (int j = 0; j < 4; ++j) { v[j] = xp[64 * j]; v2[j] = xp2[64 * j]; }
        GAS u32x2* op = (GAS u32x2*)((bf16_t*)(ws + WS_HB) + (size_t)m * D) + F.lane; GAS u32x2* op2 = (GAS u32x2*)((bf16_t*)(ws + WS_HB) + (size_t)(has2 ? m2 : m) * D) + F.lane; float q = 0.f, q2 = 0.f;
#pragma unroll
        for (int j = 0; j < 4; ++j) { u32x2 w; w.x = pk_bf16(v[j].x, v[j].y); w.y = pk_bf16(v[j].z, v[j].w); op[64 * j] = w;
            q += (bf_lo(w.x) * bf_lo(w.x) + bf_hi(w.x) * bf_hi(w.x)) + (bf_lo(w.y) * bf_lo(w.y) + bf_hi(w.y) * bf_hi(w.y));
            u32x2 w2; w2.x = pk_bf16(v2[j].x, v2[j].y); w2.y = pk_bf16(v2[j].z, v2[j].w); if (has2) op2[64 * j] = w2;
            q2 += (bf_lo(w2.x) * bf_lo(w2.x) + bf_hi(w2.x) * bf_hi(w2.x)) + (bf_lo(w2.y) * bf_lo(w2.y) + bf_hi(w2.y) * bf_hi(w2.y)); }
        q = wave_sum(q, F.lane); q2 = wave_sum(q2, F.lane);
        if (F.lane == 0) { ((GAS float*)(ws + WS_SS))[m] = q; if (has2) ((GAS float*)(ws + WS_SS))[m2] = q2; } }
}
__device__ __forceinline__ void final_phase(const Frame& F, const Args& a) {
    const float* ss = (const float*)(a.ws + WS_SS) + (size_t)6 * M; const GAS f32x4* gr = (const GAS f32x4*)a.in[13] + F.lane;
    f32x4 g[4];
#pragma unroll
    for (int j = 0; j < 4; ++j) g[j] = gr[64 * j];
    for (int m0 = F.gw; m0 < MP; m0 += 4 * F.NGW) {
        u32x2 w[4][4]; float rs[4];
#pragma unroll
        for (int r = 0; r < 4; ++r) { const int m = m0 + r * F.NGW < MP ? m0 + r * F.NGW : m0; rs[r] = __builtin_amdgcn_rsqf(ss[m] * (1.f / D) + RMS_EPS);
            const GAS u32x2* xp = (const GAS u32x2*)((const bf16_t*)(a.ws + WS_HB) + (size_t)m * D) + F.lane;
#pragma unroll
            for (int j = 0; j < 4; ++j) w[r][j] = xp[64 * j]; }
#pragma unroll
        for (int r = 0; r < 4; ++r) { const int m = m0 + r * F.NGW; if (m < MP) { GAS f32x4* op = (GAS f32x4*)(a.out + OUT_Y + (size_t)m * D) + F.lane;
#pragma unroll
            for (int j = 0; j < 4; ++j) __builtin_nontemporal_store((f32x4){bf_lo(w[r][j].x), bf_hi(w[r][j].x), bf_lo(w[r][j].y), bf_hi(w[r][j].y)} * rs[r] * g[j], op + 64 * j); } }
    }
    for (int r = F.NGW - 1 - F.gw; r < MS; r += F.NGW) {
        const GAS u32x2* xp = (const GAS u32x2*)((const bf16_t*)(a.ws + WS_HB) + (size_t)(MP + r) * D) + F.lane;
        f32x4 x[4];
#pragma unroll
        for (int j = 0; j < 4; ++j) { const u32x2 w = xp[64 * j]; x[j] = (f32x4){bf_lo(w.x), bf_hi(w.x), bf_lo(w.y), bf_hi(w.y)}; }
#pragma unroll
        for (int p = 0; p < 11; ++p) { const GAS u32x2* pp = (const GAS u32x2*)((const bf16_t*)(a.ws + WS_PART) + ((size_t)p * MS + r) * D) + F.lane;
#pragma unroll
            for (int j = 0; j < 4; ++j) { const u32x2 w = pp[64 * j]; x[j] += (f32x4){bf_lo(w.x), bf_hi(w.x), bf_lo(w.y), bf_hi(w.y)}; } }
        float q = 0.f;
#pragma unroll
        for (int j = 0; j < 4; ++j) q += x[j][0] * x[j][0] + x[j][1] * x[j][1] + x[j][2] * x[j][2] + x[j][3] * x[j][3];
        q = wave_sum(q, F.lane);
        const float rs = __builtin_amdgcn_rsqf(q * (1.f / D) + RMS_EPS);
        GAS f32x4* op = (GAS f32x4*)(a.out + OUT_Y + (size_t)(MP + r) * D) + F.lane;
#pragma unroll
        for (int j = 0; j < 4; ++j) __builtin_nontemporal_store(x[j] * rs * g[j], op + 64 * j);
    }
}
template <int W> __device__ __forceinline__ void pool_load_h(float (&hv)[16], const Args& a, const float* ss, const float (&gn)[16], bool samp, int b, int m0, int t, int c0) {
    if (t >= 0) { const GAS u32x4* p = (const GAS u32x4*)((const bf16_t*)(a.ws + WS_HB) + (size_t)(m0 + t) * D + c0); const u32x4 x = p[0], y = p[1];
        const float rs = __builtin_amdgcn_rsqf(ss[m0 + t] * (1.f / D) + RMS_EPS);
        const float v[16] = {bf_lo(x.x), bf_hi(x.x), bf_lo(x.y), bf_hi(x.y), bf_lo(x.z), bf_hi(x.z), bf_lo(x.w), bf_hi(x.w), bf_lo(y.x), bf_hi(y.x), bf_lo(y.y), bf_hi(y.y), bf_lo(y.z), bf_hi(y.z), bf_lo(y.w), bf_hi(y.w)};
#pragma unroll
        for (int e = 0; e < 16; ++e) hv[e] = v[e] * rs * gn[e]; }
    else if (samp) { const GAS f32x4* p = (const GAS f32x4*)(a.in[5] + ((size_t)b * 15 + (15 + t)) * D + c0);
#pragma unroll
        for (int q = 0; q < 4; ++q) { const f32x4 x = p[q]; hv[4 * q] = x[0]; hv[4 * q + 1] = x[1]; hv[4 * q + 2] = x[2]; hv[4 * q + 3] = x[3]; } }
    else {
#pragma unroll
        for (int e = 0; e < 16; ++e) hv[e] = 0.f; }
}
template <int W> __device__ __forceinline__ void pool_item(const Args& a, int chunk, int g, int lane) {
    bf16_t* PB = (bf16_t*)(a.ws + WS_QB); const float* ss = (const float*)(a.ws + WS_SS) + (size_t)3 * M;
    const bool samp = chunk >= MP / 64;
    const int b = samp ? chunk - MP / 64 : chunk >> 6, m0 = samp ? MP + b * DSEQ : b * SEQ, tl = samp ? DSEQ : SEQ;
    const int ts = (samp ? 0 : (chunk & 63) * 64) + 16 * (lane >> 4), c0 = g * 256 + (lane & 15) * 16;
    float gn[16];
    { const GAS f32x4* gp = (const GAS f32x4*)(a.in[9] + D + c0);
#pragma unroll
      for (int q = 0; q < 4; ++q) { const f32x4 x = gp[q]; gn[4 * q] = x[0]; gn[4 * q + 1] = x[1]; gn[4 * q + 2] = x[2]; gn[4 * q + 3] = x[3]; } }
    float run[16], hv[16];
#pragma unroll
    for (int e = 0; e < 16; ++e) run[e] = 0.f;
#pragma unroll 2
    for (int j = 1; j < W; ++j) { pool_load_h<W>(hv, a, ss, gn, samp, b, m0, ts - j, c0);
#pragma unroll
        for (int e = 0; e < 16; ++e) run[e] += hv[e]; }
#pragma unroll 4
    for (int i = 0; i < 16; ++i) {
        const int t = ts + i;
        pool_load_h<W>(hv, a, ss, gn, samp, b, m0, t, c0);
#pragma unroll
        for (int e = 0; e < 16; ++e) run[e] += hv[e];
        const int pos = samp ? PAST + t : t; const float inv = 1.0f / (float)(pos + 1 < W ? pos + 1 : W);
        u32x4 o0, o1;
        o0.x = pk_bf16(run[0] * inv - hv[0], run[1] * inv - hv[1]); o0.y = pk_bf16(run[2] * inv - hv[2], run[3] * inv - hv[3]); o0.z = pk_bf16(run[4] * inv - hv[4], run[5] * inv - hv[5]); o0.w = pk_bf16(run[6] * inv - hv[6], run[7] * inv - hv[7]);
        o1.x = pk_bf16(run[8] * inv - hv[8], run[9] * inv - hv[9]); o1.y = pk_bf16(run[10] * inv - hv[10], run[11] * inv - hv[11]); o1.z = pk_bf16(run[12] * inv - hv[12], run[13] * inv - hv[13]); o1.w = pk_bf16(run[14] * inv - hv[14], run[15] * inv - hv[15]);
        GAS u32x4* op = (GAS u32x4*)(PB + (size_t)(m0 + t) * D + c0); op[0] = o0; op[1] = o1;
        if (t >= tl - 15) { float* fo = (samp ? a.out + OUT_PSS : a.out + OUT_PSP) + ((size_t)b * 15 + (t - (tl - 15))) * D + c0;
#pragma unroll
            for (int q = 0; q < 4; ++q) ((GAS f32x4*)fo)[q] = (f32x4){hv[4 * q], hv[4 * q + 1], hv[4 * q + 2], hv[4 * q + 3]}; }
        float ho[16]; pool_load_h<W>(ho, a, ss, gn, samp, b, m0, t - (W - 1), c0);
#pragma unroll
        for (int e = 0; e < 16; ++e) run[e] -= ho[e];
    }
}
__device__ __forceinline__ void pool_phase(const Frame& F, const Args& a) {
    constexpr int NCH = MP / 64 + DB;
    for (int it = F.gw, pass = 0; it < NCH * 4; it += F.NGW, ++pass) {
        const int gs = it & 3, g = (pass & 1) ? 3 - gs : gs, chunk = it >> 2;
        if (g == 0) pool_item<2>(a, chunk, 0, F.lane); else if (g == 1) pool_item<4>(a, chunk, 1, F.lane); else if (g == 2) pool_item<8>(a, chunk, 2, F.lane); else pool_item<16>(a, chunk, 3, F.lane);
    }
}
__device__ __forceinline__ void ffn_fix_tile(unsigned char* ws, const float* cw, const float* cb, int pm, int tid) {
    const float* edge = (const float*)(ws + WS_EDGE); const float* first = (const float*)(ws + WS_FIRST); bf16_t* A2 = (bf16_t*)(ws + WS_A2);
    for (int it = tid; it < FF / 4; it += 512) {
        const int c4 = it * 4, dcol = 256 * (c4 >> 7) + (c4 & 127);
        f32x4 wg[3], wv[3];
#pragma unroll
        for (int j = 0; j < 3; ++j) { wg[j] = *(const GAS f32x4*)(cw + (size_t)j * FF2 + c4); wv[j] = *(const GAS f32x4*)(cw + (size_t)j * FF2 + FF + c4); }
        const f32x4 bg = *(const GAS f32x4*)(cb + c4), bv = *(const GAS f32x4*)(cb + FF + c4);
        const float* e = edge + (size_t)(pm - 1) * 2 * FF2 + dcol; const float* f = first + (size_t)pm * 2 * FF2 + dcol;
        const f32x4 g2 = *(const GAS f32x4*)e, v2 = *(const GAS f32x4*)(e + 128), g1 = *(const GAS f32x4*)(e + FF2), v1 = *(const GAS f32x4*)(e + FF2 + 128);
        const f32x4 g0 = *(const GAS f32x4*)f, v0 = *(const GAS f32x4*)(f + 128), gp = *(const GAS f32x4*)(f + FF2), vp = *(const GAS f32x4*)(f + FF2 + 128);
        const f32x4 ga = bg + wg[0] * g2 + wg[1] * g1 + wg[2] * g0, va = bv + wv[0] * v2 + wv[1] * v1 + wv[2] * v0;
        const f32x4 gb = bg + wg[0] * g1 + wg[1] * g0 + wg[2] * gp, vb = bv + wv[0] * v1 + wv[1] * v0 + wv[2] * vp;
        f32x4 ya, yb;
#pragma unroll
        for (int q = 0; q < 4; ++q) { ya[q] = ga[q] * va[q] * __builtin_amdgcn_rcpf(1.f + __builtin_amdgcn_exp2f(-ga[q] * LOG2E)); yb[q] = gb[q] * vb[q] * __builtin_amdgcn_rcpf(1.f + __builtin_amdgcn_exp2f(-gb[q] * LOG2E)); }
        u32x2 wa, wb; wa.x = pk_bf16(ya[0], ya[1]); wa.y = pk_bf16(ya[2], ya[3]); wb.x = pk_bf16(yb[0], yb[1]); wb.y = pk_bf16(yb[2], yb[3]);
        *(GAS u32x2*)(A2 + (size_t)(pm * 256) * FF + c4) = wa; *(GAS u32x2*)(A2 + (size_t)(pm * 256 + 1) * FF + c4) = wb;
    }
}
__device__ __forceinline__ void ffn_fix_tiles5(unsigned char* ws, const float* cw, const float* cb, int pm0, int pm1, int pm2, int pm3, int pm4, int tid) {
    const float* edge = (const float*)(ws + WS_EDGE); const float* first = (const float*)(ws + WS_FIRST); bf16_t* A2 = (bf16_t*)(ws + WS_A2);
    for (int it = tid; it < FF / 4; it += 512) {
        const int c4 = it * 4, dcol = 256 * (c4 >> 7) + (c4 & 127);
        f32x4 wg[3], wv[3];
#pragma unroll
        for (int j = 0; j < 3; ++j) { wg[j] = *(const GAS f32x4*)(cw + (size_t)j * FF2 + c4); wv[j] = *(const GAS f32x4*)(cw + (size_t)j * FF2 + FF + c4); }
        const f32x4 bg = *(const GAS f32x4*)(cb + c4), bv = *(const GAS f32x4*)(cb + FF + c4);
        f32x4 in[5][8];
#pragma unroll
        for (int i = 0; i < 5; ++i) { const int pm = i == 0 ? pm0 : i == 1 ? pm1 : i == 2 ? pm2 : i == 3 ? pm3 : pm4;
            if (pm >= 0) { const float* e = edge + (size_t)(pm - 1) * 2 * FF2 + dcol; const float* f = first + (size_t)pm * 2 * FF2 + dcol;
                in[i][0] = *(const GAS f32x4*)e; in[i][1] = *(const GAS f32x4*)(e + 128); in[i][2] = *(const GAS f32x4*)(e + FF2); in[i][3] = *(const GAS f32x4*)(e + FF2 + 128);
                in[i][4] = *(const GAS f32x4*)f; in[i][5] = *(const GAS f32x4*)(f + 128); in[i][6] = *(const GAS f32x4*)(f + FF2); in[i][7] = *(const GAS f32x4*)(f + FF2 + 128); } }
#pragma unroll
        for (int i = 0; i < 5; ++i) { const int pm = i == 0 ? pm0 : i == 1 ? pm1 : i == 2 ? pm2 : i == 3 ? pm3 : pm4;
            if (pm >= 0) { const f32x4 g2 = in[i][0], v2 = in[i][1], g1 = in[i][2], v1 = in[i][3], g0 = in[i][4], v0 = in[i][5], gp = in[i][6], vp = in[i][7];
                const f32x4 ga = bg + wg[0] * g2 + wg[1] * g1 + wg[2] * g0, va = bv + wv[0] * v2 + wv[1] * v1 + wv[2] * v0;
                const f32x4 gb = bg + wg[0] * g1 + wg[1] * g0 + wg[2] * gp, vb = bv + wv[0] * v1 + wv[1] * v0 + wv[2] * vp;
                f32x4 ya, yb;
#pragma unroll
                for (int q = 0; q < 4; ++q) { ya[q] = ga[q] * va[q] * __builtin_amdgcn_rcpf(1.f + __builtin_amdgcn_exp2f(-ga[q] * LOG2E)); yb[q] = gb[q] * vb[q] * __builtin_amdgcn_rcpf(1.f + __builtin_amdgcn_exp2f(-gb[q] * LOG2E)); }
                u32x2 wa, wb; wa.x = pk_bf16(ya[0], ya[1]); wa.y = pk_bf16(ya[2], ya[3]); wb.x = pk_bf16(yb[0], yb[1]); wb.y = pk_bf16(yb[2], yb[3]);
                *(GAS u32x2*)(A2 + (size_t)(pm * 256) * FF + c4) = wa; *(GAS u32x2*)(A2 + (size_t)(pm * 256 + 1) * FF + c4) = wb; } }
    }
}

extern __shared__ __attribute__((aligned(16))) unsigned char lds_raw[];
typedef __attribute__((address_space(4))) const Args CArgs;
__device__ __forceinline__ CArgs* kargs() { CArgs* k = (CArgs*)__builtin_amdgcn_kernarg_segment_ptr(); asm volatile("" : "+s"(k)); return k; }
__device__ __forceinline__ int elect_tid() {
    unsigned ones = ~0u; asm volatile("" : "+s"(ones));
    const int lane = (int)__builtin_amdgcn_mbcnt_hi(ones, __builtin_amdgcn_mbcnt_lo(ones, 0u));
    unsigned t = 0u;
    if (lane == 0) t = __hip_atomic_fetch_add((LAS unsigned*)((LAS unsigned char*)lds_raw + TICKET_OFF), 1u, __ATOMIC_RELAXED, __HIP_MEMORY_SCOPE_WORKGROUP);
    return (int)((__builtin_amdgcn_readfirstlane(t) & 7u) * 64u) + lane;
}
__device__ __forceinline__ Frame make_frame() {
    Frame F; F.lds = (LAS unsigned char*)lds_raw;
    const int tid = elect_tid(); __syncthreads();
    int bx = blockIdx.x, G = gridDim.x; asm volatile("" : "+s"(bx), "+s"(G));
    F.tid = tid; F.lane = F.tid & 63; F.wave = __builtin_amdgcn_readfirstlane(F.tid >> 6);
    F.G = G; F.bx = bx; F.vcu = (F.G % 8 == 0) ? (bx % 8) * (F.G / 8) + bx / 8 : bx;
    F.gw = F.vcu * NWAVES + F.wave; F.NGW = F.G * NWAVES; return F;
}
__device__ __forceinline__ Args load_args() { CArgs* k = kargs(); Args a;
#pragma unroll
    for (int i = 0; i < 25; ++i) a.in[i] = k->in[i];
    a.out = k->out; a.ws = k->ws; a.ph_lo = k->ph_lo; a.ph_hi = k->ph_hi; return a; }
#define PHASE static __device__ __forceinline__ void

PHASE ph_prologue() { const Frame F = make_frame(); const Args a = load_args(); p0_prologue(F, a); }
__device__ __forceinline__ void memkv_part(const Frame& F, CArgs* k, int G2, int c2, int l0, int l1) {
    unsigned char* ws = k->ws; float* out = k->out;
    if (c2 < 0) return;
    for (int l = l0; l < l1; ++l) {
        { pg8::GemmP g{D, D, D}; pg8::SchedMN S{(const char*)(ws + WS_MN) + (size_t)l * NB * NMEM * D * 2, (const char*)(ws + WS_WCAKV) + (size_t)l * 2 * D * D * 2, D, D, 16, 4, G2, (c2 + 128 * l) % G2, 0};
          pg8::EpiMemK E{out + OUT_MKP + (size_t)l * NB * NMEM * D, (bf16_t*)(ws + WS_KMP) + (size_t)l * NB * NMEM * D};
          int t_ = F.tid; asm volatile("" : "+v"(t_)); pg8::gemm_phase(F.lds + RING_OFF, g, S, E, t_); }
        { pg8::GemmP g{D, D, D}; pg8::SchedMN S{(const char*)(ws + WS_MN) + (size_t)l * NB * NMEM * D * 2, (const char*)(ws + WS_WCAKV) + ((size_t)l * 2 * D * D + (size_t)D * D) * 2, D, D, 16, 4, G2, (c2 + 128 * l + 64) % G2, 0};
          pg8::EpiMemK E{out + OUT_MVP + (size_t)l * NB * NMEM * D, (bf16_t*)(ws + WS_VMTP) + (size_t)l * NB * NMEM * D};
          int t_ = F.tid; asm volatile("" : "+v"(t_)); pg8::gemm_phase(F.lds + RING_OFF, g, S, E, t_); }
    }
}
PHASE ph_qkv() {
    const Frame F = make_frame(); CArgs* k = kargs(); unsigned char* ws = k->ws;
    pg8::GemmP g{D, D, D}; pg8::SchedQKV S{(const char*)(ws + WS_HB), (const char*)(ws + WS_WQKV), M / 256, F.G, F.bx};
    pg8::EpiQKV E{(bf16_t*)(ws + WS_QB), (size_t)(WS_KB - WS_QB) / 2, k->out, sba::QSCALE, (const float*)(ws + WS_SS)};
    pg8::gemm_phase(F.lds + RING_OFF, g, S, E, F.tid);
    { const Frame F2 = make_frame();
      const int extra = (M / 256) * 12 - 12 * F2.G;
      int G2 = F2.G, c2 = F2.bx; if (extra > 0 && extra < F2.G) { G2 = F2.G - extra; c2 = F2.bx >= extra ? F2.bx - extra : -1; }
      memkv_part(F2, k, G2, c2, 0, 1); }
}
PHASE ph_sbattn() {
    const Frame F = make_frame(); CArgs* k = kargs(); unsigned char* ws = k->ws;
    sba::Tensors T{(const bf16_t*)(ws + WS_QB), (const bf16_t*)(ws + WS_KB), (const bf16_t*)(ws + WS_VB), (bf16_t*)(ws + WS_OB), k->in[3], k->in[4]};
    LAS char* vimg = (LAS char*)(F.lds + RING_OFF + F.wave * sba::WAVE_LDS);
    LAS unsigned* ctr = (LAS unsigned*)(F.lds + MISC_OFF + 64);
    for (;;) {
        unsigned j = 0u; if (F.lane == 0) j = __hip_atomic_fetch_add(ctr, 1u, __ATOMIC_RELAXED, __HIP_MEMORY_SCOPE_WORKGROUP);
        j = (unsigned)__builtin_amdgcn_readfirstlane(j);
        const int id = F.vcu * NWAVES + (int)(j & 7u) + (int)(j >> 3) * F.NGW;
        if (id >= 32768 + 1024) break;
        sba::unit(id, T, vimg, F.lane);
    }
}
__device__ __forceinline__ size_t ca_base(int layer) { return layer == 0 ? WS_QB : WS_OB; }
__device__ __forceinline__ int ca_vwrow0(int layer) { return layer == 0 ? (int)((WS_VB - WS_QB) / 2048) : (int)((WS_VW1 - WS_OB) / 2048); }
__device__ __forceinline__ void wkvw_part(const Frame& F, CArgs* k, int layer, int G, int c) {
    unsigned char* ws = k->ws;
    pg8::GemmP g{D, D, 256};
    pg8::SchedWKVW S{(const char*)(ws + WS_KMP) + (size_t)layer * NB * NMEM * D * 2, (const char*)(ws + WS_KMS) + (size_t)layer * DB * NMEM * D * 2,
                     (const char*)(ws + WS_VMTP) + (size_t)layer * NB * NMEM * D * 2, (const char*)(ws + WS_VMTS) + (size_t)layer * DB * NMEM * D * 2,
                     (const char*)(ws + WS_WCAQ) + (size_t)layer * D * D * 2, (const char*)(ws + WS_WCAO) + (size_t)layer * D * D * 2, G, c, ca_vwrow0(layer)};
    pg8::EpiBf16 E{(bf16_t*)(ws + ca_base(layer)), D, 1.f, nullptr};
    pg8::gemm_phase(F.lds + RING_OFF, g, S, E, F.tid);
}
PHASE ph_resid_gemm(int which_, int layer_, float alpha) {
    const int which = __builtin_amdgcn_readfirstlane(which_), layer = __builtin_amdgcn_readfirstlane(layer_);
    const Frame F = make_frame(); CArgs* k = kargs(); unsigned char* ws = k->ws;
    const char* A; const char* W; int K, ssi;
    if (which == 0) { A = (const char*)(ws + WS_OB); W = (const char*)(ws + WS_WO); K = D; ssi = 1; }
    else if (which == 1) { A = (const char*)(ws + WS_VB); W = (const char*)(ws + WS_WCAO) + (size_t)layer * D * D * 2; K = D; ssi = layer == 0 ? 2 : 5; }
    else { A = (const char*)(ws + WS_A2); W = (const char*)(ws + WS_WDN) + (size_t)layer * D * FF * 2; K = FF; ssi = layer == 0 ? 3 : 6; }
    const bool splitk = which == 2 && layer == 1;
    pg8::GemmP g{K, K, K}; pg8::SchedMN S{A, W, K, K, splitk ? MP / 256 : M / 256, 4, F.G, F.bx, 0};
    if (which == 2) {
        int last = -1, pmv[5];
#pragma unroll
        for (int i = 0; i < 5; ++i) { pg8::Unit u; u.row0 = 0; const bool ok = S.next(i, u); const int pm = u.row0 >> 8;
            pmv[i] = (ok && pm != last && pm < MP / 256 && (pm & 15) != 0) ? pm : -1; if (ok) last = pm; }
        ffn_fix_tiles5(ws, k->in[22] + (size_t)layer * 3 * FF2, k->in[23] + (size_t)layer * FF2, pmv[0], pmv[1], pmv[2], pmv[3], pmv[4], F.tid);
        for (int i = 5; ; ++i) { pg8::Unit u; if (!S.next(i, u)) break; const int pm = u.row0 >> 8;
            if (pm != last && pm < MP / 256 && (pm & 15) != 0) ffn_fix_tile(ws, k->in[22] + (size_t)layer * 3 * FF2, k->in[23] + (size_t)layer * FF2, pm, F.tid);
            last = pm; }
        asm volatile("s_waitcnt vmcnt(0)" ::: "memory"); __syncthreads();
    }
    pg8::EpiResid<false> E{(bf16_t*)(ws + WS_HB), (float*)(ws + WS_SS) + (size_t)ssi * M, nullptr, alpha};
    pg8::gemm_phase(F.lds + RING_OFF, g, S, E, F.tid);
    if (splitk && alpha != 0.f) {
        const Frame F2 = make_frame();
        pg8::GemmP g2{FF, FF, 256}; pg8::SchedSplitK S2{A, W, F2.G, F2.bx};
        pg8::EpiBf16 E2{(bf16_t*)(ws + WS_PART), D, 1.f, nullptr};
        pg8::gemm_phase(F2.lds + RING_OFF, g2, S2, E2, F2.tid);
    }
    if (alpha != 0.f && (which == 0 || (which == 2 && layer == 0))) {
        const Frame F2 = make_frame();
        const int extra = (M / 256) * 4 - 4 * F2.G;
        const int nl = which == 0 ? 0 : 1;
        int G2 = F2.G, c2 = F2.bx; if (extra > 0 && extra < F2.G) { G2 = F2.G - extra; c2 = F2.bx >= extra ? F2.bx - extra : -1; }
        wkvw_part(F2, k, nl, G2, c2);
    }
}
PHASE ph_pool_gemm(float alpha) {
    const Frame F = make_frame(); CArgs* k = kargs(); unsigned char* ws = k->ws;
    pg8::GemmP g{D, 256, 256}; pg8::SchedPool S{(const char*)(ws + WS_QB), (const char*)(ws + WS_WPOOL), F.G, F.bx};
    pg8::EpiResid<true> E{(bf16_t*)(ws + WS_HB), (float*)(ws + WS_SS) + (size_t)4 * M, k->in[17], alpha};
    pg8::gemm_phase(F.lds + RING_OFF, g, S, E, F.tid);
}
PHASE ph_final() { const Frame F = make_frame(); const Args a = load_args(); final_phase(F, a); }
PHASE ph_pool() { const Frame F = make_frame(); const Args a = load_args(); pool_phase(F, a); }
__device__ __forceinline__ void ffn_tail(int l) {
    const Frame F2 = make_frame(); const Args a = load_args();
    const int extra = 1152 - 4 * F2.G;
    if (extra > 0 && extra < F2.G) { if (F2.bx >= extra) ffn_weight_items(F2, a, l, (F2.bx - extra) * NWAVES + F2.wave, (F2.G - extra) * NWAVES); }
    else ffn_weight_items(F2, a, l, F2.bx * NWAVES + F2.wave, F2.G * NWAVES);
}
PHASE ph_cascore(int layer_) {
    const int layer = __builtin_amdgcn_readfirstlane(layer_);
    const Frame F = make_frame(); CArgs* k = kargs(); unsigned char* ws = k->ws;
    pg8::GemmP g{D, D, D}; pg8::SchedCA2<0> S{(const char*)(ws + WS_HB), (const char*)(ws + ca_base(layer)), F.G, F.bx, ca_vwrow0(layer)};
    pg8::EpiSoftmax E{(bf16_t*)(ws + WS_KB), XCH_OFF, (const float*)(ws + WS_SS) + (size_t)(layer == 0 ? 1 : 4) * M, 0.0625f * LOG2E};
    pg8::gemm_phase(F.lds + RING_OFF, g, S, E, F.tid);
    if (layer == 0) {
        const Frame F2 = make_frame(); const int extra = 1152 - 4 * F2.G;
        int G2 = F2.G, c2 = F2.bx; if (extra > 0 && extra < F2.G) { G2 = F2.G - extra; c2 = F2.bx >= extra ? F2.bx - extra : -1; }
        memkv_part(F2, k, G2, c2, 1, 2); }
}
PHASE ph_caout(int layer_, float alpha) {
    const int layer = __builtin_amdgcn_readfirstlane(layer_);
    const Frame F = make_frame(); CArgs* k = kargs(); unsigned char* ws = k->ws;
    pg8::GemmP g{D, D, D}; pg8::SchedCA2<1> S{(const char*)(ws + WS_KB), (const char*)(ws + ca_base(layer)), F.G, F.bx, ca_vwrow0(layer)};
    pg8::EpiResid<false> E{(bf16_t*)(ws + WS_HB), (float*)(ws + WS_SS) + (size_t)(layer == 0 ? 2 : 5) * M, nullptr, alpha};
    pg8::gemm_phase(F.lds + RING_OFF, g, S, E, F.tid);
    if (layer == 0 && alpha != 0.f) { ffn_tail(0); ffn_tail(1); }
}
PHASE ph_up(int layer_) {
    const int layer = __builtin_amdgcn_readfirstlane(layer_);
    const Frame F = make_frame(); CArgs* k = kargs(); unsigned char* ws = k->ws; float* out = k->out;
    pg8::GemmP g{D, D, D}; pg8::SchedMN S{(const char*)(ws + WS_HB), (const char*)(ws + WS_WUP) + (size_t)layer * FF2 * D * 2, D, D, M / 256, 22, F.G, F.bx, 0};
    pg8::EpiUpGate E{(bf16_t*)(ws + WS_A2), k->in[22] + (size_t)layer * 3 * FF2, k->in[23] + (size_t)layer * FF2, k->in[6] + (size_t)layer * DB * 2 * FF2,
                     out + OUT_FSP + (size_t)layer * NB * 2 * FF2, out + OUT_FSS + (size_t)layer * DB * 2 * FF2, (float*)(ws + WS_EDGE), (float*)(ws + WS_FIRST), XCH_OFF, (const float*)(ws + WS_SS) + (size_t)(layer == 0 ? 2 : 5) * M};
    pg8::gemm_phase(F.lds + RING_OFF, g, S, E, F.tid);
}

constexpr int N_PHASES = 15;
__global__ void __launch_bounds__(NWAVES * 64, 2) trunk_fwd(Args args_unused) {
    CArgs* k = kargs();
    volatile LAS unsigned* MISC = (volatile LAS unsigned*)((LAS unsigned char*)lds_raw + MISC_OFF);
    { const int tid = elect_tid(); __syncthreads();
      if (tid < 32) MISC[tid] = 0u;
      __syncthreads();
      if (k->ph_hi - k->ph_lo > 1) (void)xcd_barrier_post((unsigned*)(k->ws + WS_CTL) + CW_BAR, MISC + 8, tid); }
#ifndef PHASE_MASK
#define PHASE_MASK 0xffffffffull
#endif
#define IN(p) ((((PHASE_MASK) >> (p)) & 1ull) && k->ph_lo <= (p) && (p) < k->ph_hi)
#define SEAM(p) do { if (IN(p) && IN((p) + 1)) { XcdBarrier bar; bar.bar = (unsigned*)(k->ws + WS_CTL) + CW_BAR; bar.x = xb_xcc_id(); bar.st = MISC + 8; xcd_barrier(bar, elect_tid()); } } while (0)
#ifndef PROBE_REP
#define PROBE_REP 0ull
#endif
#define GBAR() do { XcdBarrier bar; bar.bar = (unsigned*)(k->ws + WS_CTL) + CW_BAR; bar.x = xb_xcc_id(); bar.st = MISC + 8; xcd_barrier(bar, elect_tid()); } while (0)
#define RUN(p, call, recall) do { if (IN(p)) { call; if (((PROBE_REP) >> (p)) & 1ull) { GBAR(); recall; } } SEAM(p); } while (0)
    RUN(0, ph_prologue(), ph_prologue());
    RUN(1, ph_qkv(), ph_qkv());
    RUN(2, ph_sbattn(), ph_sbattn());
    RUN(3, ph_resid_gemm(0, 0, 1.f), ph_resid_gemm(0, 0, 0.f));
    for (int layer = 0; layer < 2; ++layer) {
        const int pb = 4 + 6 * layer;
        if (layer == 1) {
            RUN(8, ph_pool(), ph_pool());
            RUN(9, ph_pool_gemm(1.f), ph_pool_gemm(0.f));
        }
        RUN(pb + 0, ph_cascore(layer), ph_cascore(layer));
        RUN(pb + 1, ph_caout(layer, 1.f), ph_caout(layer, 0.f));
        RUN(pb + 2, ph_up(layer), ph_up(layer));
        RUN(pb + 3, ph_resid_gemm(2, layer, 1.f), ph_resid_gemm(2, layer, 0.f));
    }
    if (IN(14)) ph_final();
#undef IN
#undef SEAM
#undef RUN
#undef GBAR
}

extern "C" void kernel_launch(void* const* d_in, const int* in_sizes, int n_in, void* d_out, int out_size, void* d_ws, size_t ws_size, hipStream_t stream) {
    static int grid = 0;
    if (grid == 0) {
        if (n_in != 25 || (size_t)out_size != OUT_TOTAL || ws_size < WS_END) { fprintf(stderr, "kernel_launch: unexpected shapes: n_in %d out %d ws %zu\n", n_in, out_size, ws_size); grid = -1; return; }
        int dev = 0, cus = 0;
        if (hipGetDevice(&dev) != hipSuccess || hipDeviceGetAttribute(&cus, hipDeviceAttributeMultiprocessorCount, dev) != hipSuccess) { grid = -1; return; }
        if (hipFuncSetAttribute((const void*)trunk_fwd, hipFuncAttributeMaxDynamicSharedMemorySize, LDS_BYTES) != hipSuccess) { fprintf(stderr, "kernel_launch: hipFuncSetAttribute failed\n"); grid = -1; return; }
        int per_cu = 0;
        if (hipOccupancyMaxActiveBlocksPerMultiprocessor(&per_cu, (const void*)trunk_fwd, NWAVES * 64, LDS_BYTES) != hipSuccess || per_cu < 1) fprintf(stderr, "kernel_launch: occupancy query reports %d\n", per_cu);
        (void)hipGetLastError();
        grid = cus;
    }
    if (grid < 0) return;
    (void)hipMemsetAsync((char*)d_ws + WS_CTL, 0, CTL_ZERO_BYTES, stream);
    Args a{};
    for (int i = 0; i < 25; ++i) a.in[i] = (const float*)d_in[i];
    a.out = (float*)d_out; a.ws = (unsigned char*)d_ws;
#if MK_ONE_LAUNCH
    a.ph_lo = 0; a.ph_hi = N_PHASES;
    hipLaunchKernelGGL(trunk_fwd, dim3(grid), dim3(NWAVES * 64), LDS_BYTES, stream, a);
#else
    for (int p = 0; p < N_PHASES; ++p) { a.ph_lo = p; a.ph_hi = p + 1; hipLaunchKernelGGL(trunk_fwd, dim3(grid), dim3(NWAVES * 64), LDS_BYTES, stream, a); }
#endif
}
```

```cpp
#include <hip/hip_runtime.h>
#include <cstdio>
#include <cstdint>

#ifndef MK_ONE_LAUNCH
#define MK_ONE_LAUNCH 1
#endif

#define GAS __attribute__((address_space(1)))
#define LAS __attribute__((address_space(3)))
typedef unsigned short bf16_t;
typedef short bf16x8 __attribute__((ext_vector_type(8)));
typedef short s16x4 __attribute__((ext_vector_type(4)));
typedef float f32x4 __attribute__((ext_vector_type(4)));
typedef float f32x16 __attribute__((ext_vector_type(16)));
typedef unsigned u32x4 __attribute__((ext_vector_type(4)));
typedef unsigned u32x2 __attribute__((ext_vector_type(2)));
typedef float f32x2_t __attribute__((ext_vector_type(2)));
typedef __bf16 bf16x2_t __attribute__((ext_vector_type(2)));
typedef GAS unsigned gu32;

__device__ __forceinline__ unsigned pk_bf16(float lo, float hi) { f32x2_t v = {lo, hi}; bf16x2_t b = __builtin_convertvector(v, bf16x2_t); return __builtin_bit_cast(unsigned, b); }
__device__ __forceinline__ float shx(float v, int mask, int lane) { return __int_as_float(__builtin_amdgcn_ds_bpermute((lane ^ mask) << 2, __float_as_int(v))); }
__device__ __forceinline__ float bf_lo(unsigned u) { return __uint_as_float(u << 16); }
__device__ __forceinline__ float bf_hi(unsigned u) { return __uint_as_float(u & 0xffff0000u); }

constexpr int D = 1024, MP = 65536, MS = 2048, M = MP + MS;
constexpr int SEQ = 4096, NB = 16, DB = 32, DSEQ = 64, PAST = 2048;
constexpr int FF = 2816, FF2 = 5632, NMEM = 256;
constexpr float RMS_EPS = 1e-6f;
constexpr float LOG2E = 1.4426950408889634f;
constexpr size_t OUT_Y = 0, OUT_KP = (size_t)M * D, OUT_VP = OUT_KP + (size_t)MP * D, OUT_KS = OUT_VP + (size_t)MP * D, OUT_VS = OUT_KS + (size_t)MS * D;
constexpr size_t OUT_PSP = OUT_VS + (size_t)MS * D, OUT_PSS = OUT_PSP + (size_t)NB * 15 * D, OUT_FSP = OUT_PSS + (size_t)DB * 15 * D;
constexpr size_t OUT_FSS = OUT_FSP + (size_t)2 * NB * 2 * FF2, OUT_MKP = OUT_FSS + (size_t)2 * DB * 2 * FF2, OUT_MVP = OUT_MKP + (size_t)2 * NB * NMEM * D;
constexpr size_t OUT_TOTAL = OUT_MVP + (size_t)2 * NB * NMEM * D;
static_assert(OUT_TOTAL == 226213888ull, "output size");
constexpr size_t MiB = 1u << 20;
constexpr size_t WS_CTL = 0, CTL_ZERO_BYTES = 1 * MiB;
constexpr size_t WS_WQKV = 2 * MiB, WS_WO = 8 * MiB, WS_WPOOL = 10 * MiB, WS_WCAQ = 11 * MiB, WS_WCAKV = 15 * MiB, WS_WCAO = 23 * MiB, WS_WUP = 27 * MiB, WS_WDN = 49 * MiB;
constexpr size_t WS_MN = 60 * MiB, WS_KMP = 76 * MiB, WS_VMTP = 92 * MiB, WS_KMS = 108 * MiB, WS_VMTS = 140 * MiB;
constexpr size_t WS_HB = 172 * MiB, WS_QB = 304 * MiB, WS_KB = 436 * MiB, WS_VB = 568 * MiB;
constexpr size_t WS_A2 = 304 * MiB, WS_EDGE = 700 * MiB, WS_FIRST = 712 * MiB, WS_OB = 724 * MiB, WS_SS = 856 * MiB, WS_VW1 = 858 * MiB, WS_END = 954 * MiB, WS_PART = WS_OB;
static_assert(WS_A2 + (size_t)M * FF * 2 <= WS_EDGE && WS_EDGE + (size_t)(M / 256) * 2 * FF2 * 4 <= WS_FIRST && WS_FIRST + (size_t)(M / 256) * 2 * FF2 * 4 <= WS_OB && WS_OB + (size_t)M * D * 2 <= WS_SS && WS_SS + (size_t)7 * M * 4 <= WS_END && WS_HB + (size_t)M * D * 2 <= WS_QB && WS_VB + (size_t)M * D * 2 <= WS_EDGE, "ws map");
constexpr int CW_BAR = 4096;

namespace pg8 {
constexpr int BM = 256, BK = 64, HALF = 128, HTB = HALF * BK * 2, STAGE_BYTES = 8 * HTB, NXCD = 8, WGM = 8;
__host__ __device__ __forceinline__ int lds_byte(int r, int c) { const int st = (r >> 4) * 2 + (c >> 5), rr = r & 15, cc = c & 31, ob = rr * 64 + cc * 2; return st * 1024 + (ob ^ (((ob >> 9) & 1) << 5)); }
__host__ __device__ __forceinline__ void stage_rc(int b, int& R, int& C) { const int st = b / 1024, sb = b % 1024, swz = sb ^ (((sb >> 9) & 1) << 5); R = (st >> 1) * 16 + swz / 64; C = (st & 1) * 32 + (swz % 64) / 2; }
__host__ __device__ __forceinline__ int perm32(int rho) { const int n = rho >> 4, i = rho & 15; return 8 * (i >> 2) + 4 * n + (i & 3); }

struct Unit { const char* a; const char* b; int row0, col0, vlo, vhi, aux; };
struct GemmP { int lda, ldb, K; };

__device__ __forceinline__ bool tile_of(long L, int nM, int nN, int& pm, int& pn) {
    const int nwg = nM * nN; if (L >= nwg) return false;
    int wgid = (int)L; { const int q = nwg / NXCD, r = nwg % NXCD, xcd = wgid % NXCD, off = wgid / NXCD; wgid = (xcd < r ? xcd * (q + 1) : r * (q + 1) + (xcd - r) * q) + off; }
    const int nig = WGM * nN, gid = wgid / nig, fm = gid * WGM, gsz = (nM - fm) < WGM ? (nM - fm) : WGM;
    pm = fm + ((wgid % nig) % gsz); pn = (wgid % nig) / gsz; return true;
}

template <class Epi, class Sched>
__device__ __forceinline__ void gemm_phase(LAS unsigned char* lds, const GemmP g, const Sched& S, const Epi& E, int tid) {
    const int wid = __builtin_amdgcn_readfirstlane(tid >> 6), lane = tid & 63, wr = wid >> 2, wc = wid & 3, fr = lane & 15, fq = lane >> 4;
    const int K = g.K, nt = K / BK;
    unsigned voffA[2], voffB[2];
#pragma unroll
    for (int i = 0; i < 2; ++i) { int R, C; stage_rc(tid * 16 + i * 8192, R, C); const int Rb = (R & ~31) + perm32(R & 31);
        voffA[i] = (unsigned)(R * g.lda + C) * 2u; voffB[i] = (unsigned)(Rb * g.ldb + C) * 2u; }
    const size_t kstep = (size_t)(BK * 2);
    const size_t hstepA = (size_t)HALF * g.lda * 2, hstepB = (size_t)HALF * g.ldb * 2;
    const unsigned ldsw = (unsigned)wid * 1024u;
    const int aoff = lds_byte(wr * 64 + fr, fq * 8), boff = lds_byte(wc * 32 + fr, fq * 8);
#define PG8_SA(b, h) (((b) * 2 + (h)) * HTB)
#define PG8_SB(b, h) ((4 + (b) * 2 + (h)) * HTB)
#define PG8_STAGE(bufoff, gbase, voff) do { _Pragma("unroll") for (int _i = 0; _i < 2; ++_i) \
        __builtin_amdgcn_global_load_lds((const unsigned*)((const char*)(gbase) + (voff)[_i]), (LAS unsigned*)(lds + (bufoff) + ldsw + _i * 8192), 16, 0, 0); } while (0)
#define PG8_LDA(dst, b, h) do { _Pragma("unroll") for (int m = 0; m < 4; ++m) _Pragma("unroll") for (int k = 0; k < 2; ++k) dst[m][k] = *(const LAS bf16x8*)(lds + PG8_SA(b, h) + aoff + m * 2048 + k * 1024); } while (0)
#define PG8_LDB(dst, b, h) do { _Pragma("unroll") for (int n = 0; n < 2; ++n) _Pragma("unroll") for (int k = 0; k < 2; ++k) dst[n][k] = *(const LAS bf16x8*)(lds + PG8_SB(b, h) + boff + n * 2048 + k * 1024); } while (0)
#define PG8_MMA(ai, bj, At, Bt) do { __builtin_amdgcn_s_setprio(1); _Pragma("unroll") for (int m = 0; m < 4; ++m) _Pragma("unroll") for (int n = 0; n < 2; ++n) _Pragma("unroll") for (int k = 0; k < 2; ++k) \
        acc[ai][bj][m][n] = __builtin_amdgcn_mfma_f32_16x16x32_bf16(Bt[n][k], At[m][k], acc[ai][bj][m][n], 0, 0, 0); __builtin_amdgcn_s_setprio(0); } while (0)
#define PG8_WAIT_V(n) asm volatile("s_waitcnt vmcnt(" #n ")" ::: "memory")
#define PG8_WAIT_L(n) asm volatile("s_waitcnt lgkmcnt(" #n ")" ::: "memory")
#define PG8_BAR __builtin_amdgcn_s_barrier()
#define PG8_SCHED __builtin_amdgcn_sched_barrier(0)
    Unit cur, nxt; int ui = 0;
    if (!S.next(0, cur)) return;
    f32x4 acc[2][2][4][2];
#pragma unroll
    for (int a = 0; a < 2; ++a)
#pragma unroll
        for (int b = 0; b < 2; ++b)
#pragma unroll
            for (int m = 0; m < 4; ++m)
#pragma unroll
                for (int n = 0; n < 2; ++n) acc[a][b][m][n] = (f32x4){0.f, 0.f, 0.f, 0.f};
    bf16x8 At[4][2], B0[2][2], B1[2][2];
    const char* cA = cur.a; const char* cB = cur.b;
    PG8_STAGE(PG8_SB(0, 0), cB, voffB); PG8_STAGE(PG8_SB(0, 1), cB + hstepB, voffB); PG8_STAGE(PG8_SA(0, 0), cA, voffA); PG8_STAGE(PG8_SA(0, 1), cA + hstepA, voffA);
    if (wr == 1) PG8_BAR;
    PG8_WAIT_V(2); PG8_BAR;
    PG8_STAGE(PG8_SB(1, 0), cB + kstep, voffB); PG8_STAGE(PG8_SA(1, 0), cA + kstep, voffA); PG8_STAGE(PG8_SB(1, 1), cB + hstepB + kstep, voffB);
    PG8_WAIT_V(6); PG8_BAR;
    for (;;) {
        const bool has_next = S.next(ui + 1, nxt);
        const char* nA = has_next ? nxt.a : cA; const char* nB = has_next ? nxt.b : cB;
        for (int t = 0; t < nt; t += 2) {
            const bool last = (t == nt - 2);
            const char* a1 = cA + (size_t)(t + 1) * kstep;
            const char* a2 = last ? nA : cA + (size_t)(t + 2) * kstep; const char* b2 = last ? nB : cB + (size_t)(t + 2) * kstep;
            const char* a3 = a2 + kstep; const char* b3 = b2 + kstep;
            PG8_LDB(B0, 0, 0); PG8_LDB(B1, 0, 1); PG8_SCHED; PG8_LDA(At, 0, 0); PG8_STAGE(PG8_SA(1, 1), a1 + hstepA, voffA);
            PG8_WAIT_V(8); PG8_WAIT_L(0); PG8_BAR; PG8_MMA(0, 0, At, B0); PG8_MMA(0, 1, At, B1); PG8_BAR; PG8_SCHED;
            PG8_LDA(At, 0, 1); PG8_STAGE(PG8_SB(0, 0), b2, voffB); PG8_STAGE(PG8_SB(0, 1), b2 + hstepB, voffB); PG8_STAGE(PG8_SA(0, 0), a2, voffA);
            PG8_WAIT_V(8); PG8_WAIT_L(0); PG8_BAR; PG8_MMA(1, 0, At, B0); PG8_MMA(1, 1, At, B1); PG8_BAR; PG8_SCHED;
            PG8_LDB(B0, 1, 0); PG8_LDB(B1, 1, 1); PG8_SCHED; PG8_LDA(At, 1, 0); PG8_STAGE(PG8_SA(0, 1), a2 + hstepA, voffA);
            PG8_WAIT_V(8); PG8_WAIT_L(0); PG8_BAR; PG8_MMA(0, 0, At, B0); PG8_MMA(0, 1, At, B1); PG8_BAR; PG8_SCHED;
            PG8_LDA(At, 1, 1); PG8_STAGE(PG8_SB(1, 0), b3, voffB); PG8_STAGE(PG8_SB(1, 1), b3 + hstepB, voffB); PG8_STAGE(PG8_SA(1, 0), a3, voffA);
            PG8_WAIT_V(8); PG8_WAIT_L(0); PG8_BAR; PG8_MMA(1, 0, At, B0); PG8_MMA(1, 1, At, B1); PG8_BAR; PG8_SCHED;
        }
        if (wr == 0) PG8_BAR;
        { unsigned ones = ~0u; asm volatile("" : "+s"(ones));
          const int ln = (int)__builtin_amdgcn_mbcnt_hi(ones, __builtin_amdgcn_mbcnt_lo(ones, 0u));
          E(acc, cur, wr, wc, ln & 15, ln >> 4, lds); }
        if (!has_next) break;
#pragma unroll
        for (int a = 0; a < 2; ++a)
#pragma unroll
            for (int b = 0; b < 2; ++b)
#pragma unroll
                for (int m = 0; m < 4; ++m)
#pragma unroll
                    for (int n = 0; n < 2; ++n) acc[a][b][m][n] = (f32x4){0.f, 0.f, 0.f, 0.f};
        cur = nxt; cA = nA; cB = nB; ++ui;
        if (wr == 1) PG8_BAR;
    }
    PG8_WAIT_V(0);
    PG8_BAR;
#undef PG8_SA
#undef PG8_SB
#undef PG8_STAGE
#undef PG8_LDA
#undef PG8_LDB
#undef PG8_MMA
#undef PG8_WAIT_V
#undef PG8_WAIT_L
#undef PG8_BAR
#undef PG8_SCHED
}

struct SchedMN {
    const char* A; const char* Bt; int lda, ldb, nM, nN, G, c, col_base;
    __device__ __forceinline__ bool next(int i, Unit& u) const {
        int pm, pn; if (!tile_of((long)i * G + c, nM, nN, pm, pn)) return false;
        u.a = A + (size_t)pm * BM * lda * 2; u.b = Bt + (size_t)pn * BM * ldb * 2; u.row0 = pm * BM; u.col0 = col_base + pn * BM; u.vlo = 0; u.vhi = 0x7fffffff; u.aux = pn; return true;
    }
};
struct SchedWKVW {
    const char* KMP; const char* KMS; const char* VMP; const char* VMS; const char* WQN; const char* WOT; int G, c, VW_ROW0;
    __device__ __forceinline__ bool next(int i, Unit& u) const {
        const int L = i * G + c; if (c < 0 || L >= 1536) return false;
        const int q = L < 768 ? L : L - 768, bb = q >> 4, h = (q >> 2) & 3, ch = q & 3;
        u.vlo = 0; u.vhi = 0x7fffffff; u.aux = 0; u.col0 = L < 768 ? ch * 256 : h * 256;
        if (L < 768) { const char* Km = bb < NB ? KMP + (size_t)bb * NMEM * D * 2 : KMS + (size_t)(bb - NB) * NMEM * D * 2;
            u.a = Km + h * 256 * 2; u.b = WQN + ((size_t)ch * 256 * D + h * 256) * 2; u.row0 = (bb * 4 + h) * 256; }
        else { const char* Vm = bb < NB ? VMP + (size_t)bb * NMEM * D * 2 : VMS + (size_t)(bb - NB) * NMEM * D * 2;
            u.a = WOT + ((size_t)ch * 256 * D + h * 256) * 2; u.b = Vm + h * 256 * 2; u.row0 = VW_ROW0 + bb * 1024 + ch * 256; }
        return true;
    }
};
template <int MODE> struct SchedCA2 {
    const char* A; const char* W; int G, c, VW_ROW0;
    __device__ __forceinline__ bool next(int i, Unit& u) const {
        const int L = i * G + c; if (L >= 1024 + 128) return false;
        int row0, bb, hp;
        if (L < 1024) { const int pm = L >> 2; hp = L & 3; row0 = pm * BM; bb = pm >> 4; u.vlo = 0; u.vhi = 0x7fffffff; }
        else { const int s = L - 1024, b = s >> 2; hp = s & 3; const int r = MP + DSEQ * b; row0 = r < M - BM ? r : M - BM; bb = NB + b; u.vlo = r; u.vhi = r + DSEQ; }
        u.a = A + (size_t)row0 * D * 2;
        u.b = W + (MODE == 0 ? (size_t)((bb * 4 + hp) * 256) : (size_t)(VW_ROW0 + bb * 1024 + hp * 256)) * D * 2;
        u.row0 = row0; u.col0 = hp * 256; u.aux = 0; return true;
    }
};

#define EPI_ARGS f32x4 (&acc)[2][2][4][2], const Unit& u, int wr, int wc, int fr, int fq, LAS unsigned char* lds
struct EpiBf16 {
    bf16_t* O; int ldc; float scale; const float* ss;
    __device__ __forceinline__ void operator()(EPI_ARGS) const {
        const int row0 = u.row0 + wr * 64 + fr, col0 = u.col0 + wc * 32 + 8 * fq;
#pragma unroll
        for (int ai = 0; ai < 2; ++ai)
#pragma unroll
            for (int m = 0; m < 4; ++m) { const int row = row0 + ai * HALF + m * 16; bf16_t* rowp = O + (size_t)row * ldc + col0;
                const float rs = ss ? scale * __builtin_amdgcn_rsqf(ss[row] * (1.f / D) + RMS_EPS) : scale;
                if (row >= u.vlo && row < u.vhi) {
#pragma unroll
                for (int bj = 0; bj < 2; ++bj) { const f32x4 v0 = acc[ai][bj][m][0] * rs, v1 = acc[ai][bj][m][1] * rs;
                    u32x4 w; w.x = pk_bf16(v0[0], v0[1]); w.y = pk_bf16(v0[2], v0[3]); w.z = pk_bf16(v1[0], v1[1]); w.w = pk_bf16(v1[2], v1[3]);
                    *(u32x4*)(rowp + bj * HALF) = w; } } }
    }
};
struct SchedSplitK {
    const char* A; const char* Bt; int G, c;
    __device__ __forceinline__ bool next(int i, Unit& u) const {
        const int L = i * G + c; if (L >= 352) return false;
        const int part = L >> 5, t = L & 31, pm = t >> 2, pn = t & 3;
        u.a = A + ((size_t)(MP + pm * BM) * FF + part * 256) * 2; u.b = Bt + ((size_t)(pn * BM) * FF + part * 256) * 2;
        u.row0 = part * MS + pm * BM; u.col0 = pn * BM; u.vlo = 0; u.vhi = 0x7fffffff; u.aux = part; return true;
    }
};
struct EpiQKV {
    bf16_t* Qb; size_t bstride; float* out; float qscale; const float* ss;
    __device__ __forceinline__ void operator()(EPI_ARGS) const {
        const int typ = u.aux >> 2, colt = (u.aux & 3) * BM + wc * 32 + 8 * fq, row0 = u.row0 + wr * 64 + fr;
        bf16_t* B = Qb + (size_t)typ * bstride;
        const bool samp = u.row0 >= MP;
        float* F = typ == 1 ? (samp ? out + OUT_KS - (size_t)MP * D : out + OUT_KP) : (samp ? out + OUT_VS - (size_t)MP * D : out + OUT_VP);
        const float sc = typ == 0 ? qscale : 1.f;
#pragma unroll
        for (int ai = 0; ai < 2; ++ai)
#pragma unroll
            for (int m = 0; m < 4; ++m) { const size_t off = (size_t)(row0 + ai * HALF + m * 16) * D + colt;
                const float rs = __builtin_amdgcn_rsqf(ss[row0 + ai * HALF + m * 16] * (1.f / D) + RMS_EPS);
#pragma unroll
                for (int bj = 0; bj < 2; ++bj) { const f32x4 v0 = acc[ai][bj][m][0] * rs, v1 = acc[ai][bj][m][1] * rs;
                    if (typ != 0) { *(f32x4*)(F + off + bj * HALF) = v0; *(f32x4*)(F + off + bj * HALF + 4) = v1; }
                    u32x4 w; w.x = pk_bf16(v0[0] * sc, v0[1] * sc); w.y = pk_bf16(v0[2] * sc, v0[3] * sc); w.z = pk_bf16(v1[0] * sc, v1[1] * sc); w.w = pk_bf16(v1[2] * sc, v1[3] * sc);
                    *(u32x4*)(B + off + bj * HALF) = w; } }
    }
};
template <bool SC> struct EpiResid {
    bf16_t* XB; float* ssn; const float* cscale; float alpha;
    __device__ __forceinline__ void operator()(EPI_ARGS) const {
        const int row0 = u.row0 + wr * 64 + fr, col0 = u.col0 + wc * 32 + 8 * fq;
        GAS bf16_t* base = (GAS bf16_t*)XB + (size_t)row0 * D + col0;
        u32x4 xo[2][4][2];
#pragma unroll
        for (int ai = 0; ai < 2; ++ai)
#pragma unroll
            for (int m = 0; m < 4; ++m)
#pragma unroll
                for (int bj = 0; bj < 2; ++bj) xo[ai][m][bj] = *(GAS u32x4*)(base + (size_t)(ai * HALF + m * 16) * D + bj * HALF);
        float q[2][4];
#pragma unroll
        for (int ai = 0; ai < 2; ++ai)
#pragma unroll
            for (int m = 0; m < 4; ++m) q[ai][m] = 0.f;
#pragma unroll
        for (int bj = 0; bj < 2; ++bj) {
            const float al = alpha; const f32x4 ones = {1.f, 1.f, 1.f, 1.f};
            const f32x4 sc0 = (SC ? *(const GAS f32x4*)(cscale + col0 + bj * HALF) : ones) * al, sc1 = (SC ? *(const GAS f32x4*)(cscale + col0 + bj * HALF + 4) : ones) * al;
#pragma unroll
            for (int ai = 0; ai < 2; ++ai)
#pragma unroll
                for (int m = 0; m < 4; ++m) { const u32x4 o = xo[ai][m][bj]; const f32x4 d0 = acc[ai][bj][m][0] * sc0, d1 = acc[ai][bj][m][1] * sc1;
                    u32x4 w; w.x = pk_bf16(bf_lo(o.x) + d0[0], bf_hi(o.x) + d0[1]); w.y = pk_bf16(bf_lo(o.y) + d0[2], bf_hi(o.y) + d0[3]); w.z = pk_bf16(bf_lo(o.z) + d1[0], bf_hi(o.z) + d1[1]); w.w = pk_bf16(bf_lo(o.w) + d1[2], bf_hi(o.w) + d1[3]);
                    const int row = row0 + ai * HALF + m * 16;
                    if (row >= u.vlo && row < u.vhi) *(GAS u32x4*)(base + (size_t)(ai * HALF + m * 16) * D + bj * HALF) = w;
                    q[ai][m] += (bf_lo(w.x) * bf_lo(w.x) + bf_hi(w.x) * bf_hi(w.x)) + (bf_lo(w.y) * bf_lo(w.y) + bf_hi(w.y) * bf_hi(w.y)) + (bf_lo(w.z) * bf_lo(w.z) + bf_hi(w.z) * bf_hi(w.z)) + (bf_lo(w.w) * bf_lo(w.w) + bf_hi(w.w) * bf_hi(w.w)); }
        }
#pragma unroll
        for (int ai = 0; ai < 2; ++ai)
#pragma unroll
            for (int m = 0; m < 4; ++m) { float t = q[ai][m]; t += shx(t, 16, fq * 16 + fr); t += shx(t, 32, fq * 16 + fr);
                const int row = row0 + ai * HALF + m * 16;
                if (fq == 0 && alpha != 0.f && row >= u.vlo && row < u.vhi) __builtin_amdgcn_global_atomic_fadd_f32((GAS float*)ssn + row, t); }
    }
};
struct EpiMemK {
    float* F; bf16_t* B;
    __device__ __forceinline__ void operator()(EPI_ARGS) const {
        const int row0 = u.row0 + wr * 64 + fr, col0 = u.col0 + wc * 32 + 8 * fq;
#pragma unroll
        for (int ai = 0; ai < 2; ++ai)
#pragma unroll
            for (int m = 0; m < 4; ++m) { const size_t off = (size_t)(row0 + ai * HALF + m * 16) * D + col0;
#pragma unroll
                for (int bj = 0; bj < 2; ++bj) { const f32x4 v0 = acc[ai][bj][m][0], v1 = acc[ai][bj][m][1];
                    *(f32x4*)(F + off + bj * HALF) = v0; *(f32x4*)(F + off + bj * HALF + 4) = v1;
                    u32x4 w; w.x = pk_bf16(v0[0], v0[1]); w.y = pk_bf16(v0[2], v0[3]); w.z = pk_bf16(v1[0], v1[1]); w.w = pk_bf16(v1[2], v1[3]);
                    *(u32x4*)(B + off + bj * HALF) = w; } }
    }
};
__device__ __forceinline__ float dpp_ror1(float v) { return __int_as_float(__builtin_amdgcn_update_dpp(0, __float_as_int(v), 0x121, 0xf, 0xf, false)); }
__device__ __forceinline__ float dpp_ror2(float v) { return __int_as_float(__builtin_amdgcn_update_dpp(0, __float_as_int(v), 0x122, 0xf, 0xf, false)); }
__device__ __forceinline__ f32x4 ror1(const f32x4 v) { return (f32x4){dpp_ror1(v[0]), dpp_ror1(v[1]), dpp_ror1(v[2]), dpp_ror1(v[3])}; }
__device__ __forceinline__ f32x4 ror2(const f32x4 v) { return (f32x4){dpp_ror2(v[0]), dpp_ror2(v[1]), dpp_ror2(v[2]), dpp_ror2(v[3])}; }
__device__ __forceinline__ f32x4 sel4(bool c, const f32x4 a, const f32x4 b) { return (f32x4){c ? a[0] : b[0], c ? a[1] : b[1], c ? a[2] : b[2], c ? a[3] : b[3]}; }
typedef __bf16 bf2v_t __attribute__((ext_vector_type(2)));
__device__ __forceinline__ float dot2bf(unsigned x, unsigned w, float c) { return __builtin_amdgcn_fdot2_f32_bf16(__builtin_bit_cast(bf2v_t, x), __builtin_bit_cast(bf2v_t, w), c, false); }
struct EpiUpGate {
    bf16_t* A2; const float* cw; const float* cb; const float* sfs; float* fsp; float* fss; float* edge; float* first; int xoff; const float* ss;
    __device__ __forceinline__ void operator()(EPI_ARGS) const {
#pragma unroll
        for (int ai = 0; ai < 2; ++ai)
#pragma unroll
            for (int m = 0; m < 4; ++m) { const float rs = __builtin_amdgcn_rsqf(ss[u.row0 + ai * HALF + wr * 64 + m * 16 + fr] * (1.f / D) + RMS_EPS);
#pragma unroll
                for (int bj = 0; bj < 2; ++bj) { acc[ai][bj][m][0] = acc[ai][bj][m][0] * rs; acc[ai][bj][m][1] = acc[ai][bj][m][1] * rs; } }
        LAS float* X = (LAS float*)(lds + xoff);
        const int pn = u.col0 >> 8, pm = u.row0 >> 8, cl = wc * 32 + 8 * fq, ch = pn * 128 + cl;
        const bool samp = u.row0 >= MP;
        if (fr >= 14) {
#pragma unroll
            for (int ai = 0; ai < 2; ++ai) {
#pragma unroll
                for (int bj = 0; bj < 2; ++bj)
#pragma unroll
                    for (int n = 0; n < 2; ++n) *(LAS f32x4*)(X + ((ai * 2 + wr) * 2 + (fr - 14)) * 256 + bj * HALF + cl + 4 * n) = acc[ai][bj][3][n];
                const bool is_state = samp || (ai == 1 && wr == 1 && (pm & 15) == 15);
                if (is_state) {
                    float* st = samp ? fss + ((size_t)((u.row0 + ai * HALF + wr * 64 - MP) >> 6) * 2 + (fr - 14)) * FF2 : fsp + ((size_t)(pm >> 4) * 2 + (fr - 14)) * FF2;
#pragma unroll
                    for (int bj = 0; bj < 2; ++bj) { float* sp = st + bj * FF + ch; *(f32x4*)sp = acc[ai][bj][3][0]; *(f32x4*)(sp + 4) = acc[ai][bj][3][1]; } }
                asm volatile("" ::: "memory");
            }
            if (wr == 1) {
#pragma unroll
                for (int bj = 0; bj < 2; ++bj)
#pragma unroll
                    for (int n = 0; n < 2; ++n) *(f32x4*)(edge + ((size_t)pm * 2 + (fr - 14)) * FF2 + u.col0 + bj * HALF + cl + 4 * n) = acc[1][bj][3][n];
            }
        }
        if (wr == 0 && fr < 2) {
#pragma unroll
            for (int bj = 0; bj < 2; ++bj)
#pragma unroll
                for (int n = 0; n < 2; ++n) *(f32x4*)(first + ((size_t)pm * 2 + fr) * FF2 + u.col0 + bj * HALF + cl + 4 * n) = acc[0][bj][0][n];
        }
        unsigned P[2][2][4][4];
#pragma unroll
        for (int ai = 0; ai < 2; ++ai)
#pragma unroll
            for (int bj = 0; bj < 2; ++bj)
#pragma unroll
                for (int m = 0; m < 4; ++m)
#pragma unroll
                    for (int n = 0; n < 2; ++n) { const f32x4 v = acc[ai][bj][m][n];
                        asm volatile("v_cvt_pk_bf16_f32 %0, %1, %2" : "=v"(P[ai][bj][m][2 * n]) : "v"(v[0]), "v"(v[1])); asm volatile("v_cvt_pk_bf16_f32 %0, %1, %2" : "=v"(P[ai][bj][m][2 * n + 1]) : "v"(v[2]), "v"(v[3])); }
        f32x4 WG[3][2], WV[3][2], BG[2], BV[2];
#pragma unroll
        for (int n = 0; n < 2; ++n) {
#pragma unroll
            for (int j = 0; j < 3; ++j) { WG[j][n] = *(const GAS f32x4*)(cw + (size_t)j * FF2 + ch + 4 * n); WV[j][n] = *(const GAS f32x4*)(cw + (size_t)j * FF2 + FF + ch + 4 * n); }
            BG[n] = *(const GAS f32x4*)(cb + ch + 4 * n); BV[n] = *(const GAS f32x4*)(cb + FF + ch + 4 * n); }
        unsigned TG[3][4][2], TV[3][4][2];
#pragma unroll
        for (int j = 0; j < 3; ++j)
#pragma unroll
            for (int q = 0; q < 4; ++q) { TG[j][q][0] = pk_bf16(WG[j][q >> 1][2 * (q & 1)], 0.f); TG[j][q][1] = pk_bf16(0.f, WG[j][q >> 1][2 * (q & 1) + 1]);
                TV[j][q][0] = pk_bf16(WV[j][q >> 1][2 * (q & 1)], 0.f); TV[j][q][1] = pk_bf16(0.f, WV[j][q >> 1][2 * (q & 1) + 1]); }
        asm volatile("s_waitcnt lgkmcnt(0)" ::: "memory"); __builtin_amdgcn_s_barrier(); asm volatile("" ::: "memory");
        const bool f0 = fr == 0, f01 = fr < 2;
#pragma unroll
        for (int ai = 0; ai < 2; ++ai) {
            const int brow0 = u.row0 + ai * HALF + wr * 64;
            const int sb = samp ? ((brow0 - MP) >> 6) : 0, pred = (ai * 2 + wr) > 0 ? (ai * 2 + wr - 1) : 0;
            const bool use_x = !samp && (brow0 & (SEQ - 1)) != 0 && (ai | wr) != 0;
            const int hsel = fr >= 14 ? fr - 14 : 0;
            unsigned pk[4][4];
#pragma unroll
            for (int q = 0; q < 4; ++q) {
                const int c2 = ch + 2 * q;
                const f32x2_t bg = {BG[q >> 1][2 * (q & 1)], BG[q >> 1][2 * (q & 1) + 1]}, bv = {BV[q >> 1][2 * (q & 1)], BV[q >> 1][2 * (q & 1) + 1]};
                const LAS float* xp = X + (pred * 2 + hsel) * 256 + cl + 2 * q;
                const f32x2_t xgv = *(const LAS f32x2_t*)xp, xvv = *(const LAS f32x2_t*)(xp + HALF);
                unsigned hg = use_x ? pk_bf16(xgv.x, xgv.y) : 0u, hv = use_x ? pk_bf16(xvv.x, xvv.y) : 0u;
                if (samp) { const float* sp = sfs + ((size_t)sb * 2 + hsel) * FF2 + c2; const f32x2_t sgv = *(const GAS f32x2_t*)sp, svv = *(const GAS f32x2_t*)(sp + FF); hg = pk_bf16(sgv.x, sgv.y); hv = pk_bf16(svv.x, svv.y); }
                unsigned rg1 = __builtin_amdgcn_mov_dpp(hg, 0x121, 0xf, 0xf, false), rg2 = __builtin_amdgcn_mov_dpp(hg, 0x122, 0xf, 0xf, false);
                unsigned rv1 = __builtin_amdgcn_mov_dpp(hv, 0x121, 0xf, 0xf, false), rv2 = __builtin_amdgcn_mov_dpp(hv, 0x122, 0xf, 0xf, false);
#pragma unroll
                for (int m = 0; m < 4; ++m) {
                    const unsigned ug = P[ai][0][m][q], uv = P[ai][1][m][q];
                    const unsigned cg1 = __builtin_amdgcn_mov_dpp(ug, 0x121, 0xf, 0xf, false), cg2 = __builtin_amdgcn_mov_dpp(ug, 0x122, 0xf, 0xf, false);
                    const unsigned cv1 = __builtin_amdgcn_mov_dpp(uv, 0x121, 0xf, 0xf, false), cv2 = __builtin_amdgcn_mov_dpp(uv, 0x122, 0xf, 0xf, false);
                    const unsigned g1 = f0 ? rg1 : cg1, g2 = f01 ? rg2 : cg2, v1 = f0 ? rv1 : cv1, v2 = f01 ? rv2 : cv2;
                    const float ga = dot2bf(ug, TG[2][q][0], dot2bf(g1, TG[1][q][0], dot2bf(g2, TG[0][q][0], bg.x))), gb = dot2bf(ug, TG[2][q][1], dot2bf(g1, TG[1][q][1], dot2bf(g2, TG[0][q][1], bg.y)));
                    const float va = dot2bf(uv, TV[2][q][0], dot2bf(v1, TV[1][q][0], dot2bf(v2, TV[0][q][0], bv.x))), vb = dot2bf(uv, TV[2][q][1], dot2bf(v1, TV[1][q][1], dot2bf(v2, TV[0][q][1], bv.y)));
                    const float y0 = ga * va * __builtin_amdgcn_rcpf(1.f + __builtin_amdgcn_exp2f(-ga * LOG2E)), y1 = gb * vb * __builtin_amdgcn_rcpf(1.f + __builtin_amdgcn_exp2f(-gb * LOG2E));
                    pk[m][q] = pk_bf16(y0, y1);
                    rg1 = cg1; rg2 = cg2; rv1 = cv1; rv2 = cv2;
                }
            }
#pragma unroll
            for (int m = 0; m < 4; ++m) { u32x4 w; w.x = pk[m][0]; w.y = pk[m][1]; w.z = pk[m][2]; w.w = pk[m][3];
                *(u32x4*)(A2 + (size_t)(brow0 + m * 16 + fr) * FF + ch) = w; }
            asm volatile("" ::: "memory");
        }
    }
};
struct EpiSoftmax {
    bf16_t* P; int xoff; const float* ss; float scale;
    __device__ __forceinline__ void operator()(EPI_ARGS) const {
        LAS f32x2_t* X = (LAS f32x2_t*)(lds + xoff);
#pragma unroll
        for (int ai = 0; ai < 2; ++ai)
#pragma unroll
            for (int m = 0; m < 4; ++m) { const float rs = scale * __builtin_amdgcn_rsqf(ss[u.row0 + ai * HALF + wr * 64 + m * 16 + fr] * (1.f / D) + RMS_EPS);
#pragma unroll
                for (int bj = 0; bj < 2; ++bj) { acc[ai][bj][m][0] = acc[ai][bj][m][0] * rs; acc[ai][bj][m][1] = acc[ai][bj][m][1] * rs; } }
        float mw[2][4];
#pragma unroll
        for (int ai = 0; ai < 2; ++ai)
#pragma unroll
            for (int m = 0; m < 4; ++m) {
                float mx = -3.0e38f;
#pragma unroll
                for (int bj = 0; bj < 2; ++bj)
#pragma unroll
                    for (int n = 0; n < 2; ++n) { const f32x4 x = acc[ai][bj][m][n]; mx = fmaxf(mx, fmaxf(fmaxf(x[0], x[1]), fmaxf(x[2], x[3]))); }
                mx = fmaxf(mx, shx(mx, 16, fq * 16 + fr)); mx = fmaxf(mx, shx(mx, 32, fq * 16 + fr));
                float s = 0.f;
#pragma unroll
                for (int bj = 0; bj < 2; ++bj)
#pragma unroll
                    for (int n = 0; n < 2; ++n) { f32x4 x = acc[ai][bj][m][n];
#pragma unroll
                        for (int e = 0; e < 4; ++e) { x[e] = __builtin_amdgcn_exp2f(x[e] - mx); s += x[e]; } acc[ai][bj][m][n] = x; }
                s += shx(s, 16, fq * 16 + fr); s += shx(s, 32, fq * 16 + fr);
                mw[ai][m] = mx;
                if (fq == 0) X[(ai * HALF + wr * 64 + m * 16 + fr) * 4 + wc] = (f32x2_t){mx, s};
            }
        asm volatile("s_waitcnt lgkmcnt(0)" ::: "memory"); __builtin_amdgcn_s_barrier(); asm volatile("" ::: "memory");
        const int row0 = u.row0 + wr * 64 + fr, col0 = u.col0 + wc * 32 + 8 * fq;
#pragma unroll
        for (int ai = 0; ai < 2; ++ai)
#pragma unroll
            for (int m = 0; m < 4; ++m) { const int rl = ai * HALF + wr * 64 + m * 16 + fr;
                const f32x2_t a = X[rl * 4 + 0], b = X[rl * 4 + 1], c = X[rl * 4 + 2], d = X[rl * 4 + 3];
                const float mt = fmaxf(fmaxf(a.x, b.x), fmaxf(c.x, d.x));
                const float L = a.y * __builtin_amdgcn_exp2f(a.x - mt) + b.y * __builtin_amdgcn_exp2f(b.x - mt) + c.y * __builtin_amdgcn_exp2f(c.x - mt) + d.y * __builtin_amdgcn_exp2f(d.x - mt);
                const float f = __builtin_amdgcn_exp2f(mw[ai][m] - mt) / L;
                const int row = row0 + ai * HALF + m * 16;
                if (row >= u.vlo && row < u.vhi) {
#pragma unroll
                for (int bj = 0; bj < 2; ++bj) { const f32x4 v0 = acc[ai][bj][m][0] * f, v1 = acc[ai][bj][m][1] * f;
                    u32x4 w; w.x = pk_bf16(v0[0], v0[1]); w.y = pk_bf16(v0[2], v0[3]); w.z = pk_bf16(v1[0], v1[1]); w.w = pk_bf16(v1[2], v1[3]);
                    *(u32x4*)(P + (size_t)row * D + col0 + bj * HALF) = w; } } }
    }
};
struct SchedQKV {
    const char* A; const char* Bt; int nM, G, c;
    __device__ __forceinline__ bool next(int i, Unit& u) const {
        int pm, pj; if (!tile_of((long)i * G + c, nM, 12, pm, pj)) return false;
        const int pn = (pj % 3) * 4 + pj / 3;
        u.a = A + (size_t)pm * BM * D * 2; u.b = Bt + (size_t)pn * BM * D * 2; u.row0 = pm * BM; u.col0 = pn * BM; u.vlo = 0; u.vhi = 0x7fffffff; u.aux = pn; return true;
    }
};
struct SchedPool { const char* A; const char* Bt; int G, c;
    __device__ __forceinline__ bool next(int i, Unit& u) const { int pm, pn; if (!tile_of((long)i * G + c, M / 256, 4, pm, pn)) return false;
        u.a = A + ((size_t)pm * 256 * D + pn * 256) * 2; u.b = Bt + (size_t)pn * 65536 * 2; u.row0 = pm * 256; u.col0 = pn * 256; u.vlo = 0; u.vhi = 0x7fffffff; u.aux = 0; return true; } };
}

namespace sba {
constexpr float QSCALE = 0.125f * LOG2E;
constexpr float EXIT_T = 126.f;
constexpr int VDH = 4160, KIMG = 2 * VDH, KROW = 144, WAVE_LDS = KIMG + 64 * KROW;
__device__ __forceinline__ int crow(int r, int hi) { return (r & 3) + 8 * (r >> 2) + 4 * hi; }
__device__ __forceinline__ s16x4 vtr(LAS const char* p) { typedef short v4i16_t __attribute__((ext_vector_type(4))); return __builtin_bit_cast(s16x4, __builtin_amdgcn_ds_read_tr16_b64_v4i16((LAS v4i16_t*)p)); }

__device__ __forceinline__ bf16x8 cvt8(const f32x4 a, const f32x4 b) { u32x4 w; w.x = pk_bf16(a[0], a[1]); w.y = pk_bf16(a[2], a[3]); w.z = pk_bf16(b[0], b[1]); w.w = pk_bf16(b[2], b[3]); return __builtin_bit_cast(bf16x8, w); }
__device__ __forceinline__ void load_bf16(const bf16_t* Kt, const bf16_t* Vt, LAS char* vimg, int lane) {
    const int c = lane & 7;
    LAS char* vdst = vimg + (c >> 2) * VDH + (lane >> 3) * 64 + (c & 3) * 16; LAS char* kdst = vimg + KIMG + (lane >> 3) * KROW + c * 16;
    const unsigned vvo = (unsigned)((lane >> 3) * D + 8 * c) * 2u;
#pragma unroll
    for (int it = 0; it < 8; ++it) { const u32x4 v = *(const GAS u32x4*)((const GAS char*)Vt + (size_t)it * 8 * D * 2 + vvo); *(LAS u32x4*)(vdst + it * 512) = v; }
#pragma unroll
    for (int it = 0; it < 8; ++it) { const u32x4 v = *(const GAS u32x4*)((const GAS char*)Kt + (size_t)it * 8 * D * 2 + vvo); *(LAS u32x4*)(kdst + it * 8 * KROW) = v; }
}
__device__ __forceinline__ void load_f32(const float* Kt, const float* Vt, LAS char* vimg, int lane) {
    const int c = lane & 7;
    LAS char* vdst = vimg + (c >> 2) * VDH + (lane >> 3) * 64 + (c & 3) * 16; LAS char* kdst = vimg + KIMG + (lane >> 3) * KROW + c * 16;
    const unsigned vvo = (unsigned)((lane >> 3) * D + 8 * c) * 4u;
#pragma unroll
    for (int hv = 0; hv < 2; ++hv) {
#pragma unroll
        for (int it = 4 * hv; it < 4 * hv + 4; ++it) { const GAS f32x4* p = (const GAS f32x4*)((const GAS char*)Vt + (size_t)it * 8 * D * 4 + vvo); *(LAS u32x4*)(vdst + it * 512) = __builtin_bit_cast(u32x4, cvt8(p[0], p[1])); }
        asm volatile("" ::: "memory"); }
#pragma unroll
    for (int hv = 0; hv < 2; ++hv) {
#pragma unroll
        for (int it = 4 * hv; it < 4 * hv + 4; ++it) { const GAS f32x4* p = (const GAS f32x4*)((const GAS char*)Kt + (size_t)it * 8 * D * 4 + vvo); *(LAS u32x4*)(kdst + it * 8 * KROW) = __builtin_bit_cast(u32x4, cvt8(p[0], p[1])); }
        asm volatile("" ::: "memory"); }
}
__device__ __forceinline__ void load_bf16_regs(u32x4 (&kr)[8], u32x4 (&vr)[8], const bf16_t* Kt, const bf16_t* Vt, int lane) {
    const unsigned vvo = (unsigned)((lane >> 3) * D + 8 * (lane & 7)) * 2u;
#pragma unroll
    for (int it = 0; it < 8; ++it) vr[it] = *(const GAS u32x4*)((const GAS char*)Vt + (size_t)it * 8 * D * 2 + vvo);
#pragma unroll
    for (int it = 0; it < 8; ++it) kr[it] = *(const GAS u32x4*)((const GAS char*)Kt + (size_t)it * 8 * D * 2 + vvo);
}
template <bool PF>
__device__ __forceinline__ void tile_step(u32x4 (&kr)[8], u32x4 (&vr)[8], const bf16x8 (&qr)[4], f32x16 (&o)[2], float& carry, bool masked, bool upper_dead, int tq, LAS char* vimg, int lane, const bf16_t* nK, const bf16_t* nV, bool do_pf) {
    const int hi = lane >> 5;
    if (PF) { const int c = lane & 7; LAS char* vdst = vimg + (c >> 2) * VDH + (lane >> 3) * 64 + (c & 3) * 16; LAS char* kdst = vimg + KIMG + (lane >> 3) * KROW + c * 16;
#pragma unroll
        for (int it = 0; it < 8; ++it) *(LAS u32x4*)(kdst + it * 8 * KROW) = kr[it];
#pragma unroll
        for (int it = 0; it < 8; ++it) *(LAS u32x4*)(vdst + it * 512) = vr[it]; }
    asm volatile("s_waitcnt lgkmcnt(0)" ::: "memory");
    bf16x8 kf[8];
    { LAS const char* kb = vimg + KIMG + (lane & 31) * KROW + hi * 16;
#pragma unroll
      for (int hf = 0; hf < 2; ++hf)
#pragma unroll
          for (int d0 = 0; d0 < 4; ++d0) kf[hf * 4 + d0] = *(LAS const bf16x8*)(kb + hf * 32 * KROW + d0 * 32); }
    f32x16 p0 = {}, p1 = {};
#pragma unroll
    for (int d0 = 0; d0 < 4; ++d0) p0 = __builtin_amdgcn_mfma_f32_32x32x16_bf16(kf[d0], qr[d0], p0, 0, 0, 0);
    if (!upper_dead) {
#pragma unroll
        for (int d0 = 0; d0 < 4; ++d0) p1 = __builtin_amdgcn_mfma_f32_32x32x16_bf16(kf[4 + d0], qr[d0], p1, 0, 0, 0);
    }
    if (PF && do_pf) { load_bf16_regs(kr, vr, nK, nV, lane); }
    float k0[16], k1[16];
#pragma unroll
    for (int r = 0; r < 16; ++r) {
        const float z = __builtin_amdgcn_fmed3f(p0[r], -100.f, 100.f); const float e = __builtin_amdgcn_exp2f(-z); float sg = __builtin_amdgcn_rcpf(1.f + e); float kp = e * sg;
        if (masked && !(crow(r, hi) < tq)) { sg = 0.f; kp = 1.f; } p0[r] = sg; k0[r] = kp; }
    if (!upper_dead) {
#pragma unroll
        for (int r = 0; r < 16; ++r) {
            const float z = __builtin_amdgcn_fmed3f(p1[r], -100.f, 100.f); const float e = __builtin_amdgcn_exp2f(-z); float sg = __builtin_amdgcn_rcpf(1.f + e); float kp = e * sg;
            if (masked && !(crow(r, hi) + 32 < tq)) { sg = 0.f; kp = 1.f; } p1[r] = sg; k1[r] = kp; }
    } else {
#pragma unroll
        for (int r = 0; r < 16; ++r) { p1[r] = 0.f; k1[r] = 1.f; }
    }
    float Glo[8], Ghi[8];
#pragma unroll
    for (int a = 0; a < 8; ++a) { const float* kk = a < 4 ? k0 + 4 * a : k1 + 4 * (a - 4); const float g = (kk[0] * kk[1]) * (kk[2] * kk[3]);
        auto rr = __builtin_amdgcn_permlane32_swap(__float_as_uint(g), __float_as_uint(g), false, false); Glo[a] = __uint_as_float(rr[0]); Ghi[a] = __uint_as_float(rr[1]); }
    float sx = __builtin_amdgcn_exp2f(-carry);
#pragma unroll
    for (int a = 7; a >= 0; --a) {
        const float base = hi == 0 ? sx * Ghi[a] : sx;
        if (a >= 4) { const int q = 4 * (a - 4);
            const float s3 = base, s2 = s3 * k1[q + 3], s1 = s2 * k1[q + 2], s0 = s1 * k1[q + 1];
            p1[q + 3] *= s3; p1[q + 2] *= s2; p1[q + 1] *= s1; p1[q] *= s0;
        } else { const int q = 4 * a;
            const float s3 = base, s2 = s3 * k0[q + 3], s1 = s2 * k0[q + 2], s0 = s1 * k0[q + 1];
            p0[q + 3] *= s3; p0[q + 2] *= s2; p0[q + 1] *= s1; p0[q] *= s0;
        }
        sx *= Glo[a] * Ghi[a];
    }
    carry = -__builtin_amdgcn_logf(sx);
    bf16x8 pf[4];
#pragma unroll
    for (int s = 0; s < 4; ++s) { const f32x16& p = s < 2 ? p0 : p1; const int q = 8 * (s & 1);
        u32x4 w; w.x = pk_bf16(p[q], p[q + 1]); w.y = pk_bf16(p[q + 2], p[q + 3]); w.z = pk_bf16(p[q + 4], p[q + 5]); w.w = pk_bf16(p[q + 6], p[q + 7]); pf[s] = __builtin_bit_cast(bf16x8, w); }
    LAS const char* vb = vimg + (4 * hi + ((lane & 15) >> 2)) * 64 + ((lane >> 4) & 1) * 32 + (lane & 3) * 8;
#pragma unroll
    for (int dh = 0; dh < 2; ++dh) {
#pragma unroll
        for (int s = 0; s < 2; ++s) { const s16x4 lo = vtr(vb + dh * VDH + s * 1024), hh = vtr(vb + dh * VDH + s * 1024 + 512);
            const bf16x8 vf = (bf16x8){lo[0], lo[1], lo[2], lo[3], hh[0], hh[1], hh[2], hh[3]};
            o[dh] = __builtin_amdgcn_mfma_f32_32x32x16_bf16(vf, pf[s], o[dh], 0, 0, 0); }
        if (!upper_dead) {
#pragma unroll
            for (int s = 2; s < 4; ++s) { const s16x4 lo = vtr(vb + dh * VDH + s * 1024), hh = vtr(vb + dh * VDH + s * 1024 + 512);
                const bf16x8 vf = (bf16x8){lo[0], lo[1], lo[2], lo[3], hh[0], hh[1], hh[2], hh[3]};
                o[dh] = __builtin_amdgcn_mfma_f32_32x32x16_bf16(vf, pf[s], o[dh], 0, 0, 0); }
        }
    }
    asm volatile("s_waitcnt lgkmcnt(0)" ::: "memory");
}

struct Tensors { const bf16_t* Q; const bf16_t* K; const bf16_t* V; bf16_t* O; const float* cK; const float* cV; };

__device__ __forceinline__ void unit(int id, const Tensors& T, LAS char* vimg, int lane) {
    const int r32 = lane & 31, hi = lane >> 5;
    const bool samp = id >= 32768;
    int h, q0; size_t rowb; int b = 0;
    if (!samp) { const int qb = id & 127; h = (id >> 7) & 15; b = id >> 11; rowb = (size_t)b * SEQ; q0 = qb * 32; }
    else { const int s = id - 32768; const int qb = s & 1; h = (s >> 1) & 15; b = s >> 5; rowb = (size_t)MP + (size_t)b * DSEQ; q0 = qb * 32; }
    const bf16_t* Qw = T.Q + (rowb + q0) * D + h * 64; bf16_t* Ow = T.O + (rowb + q0) * D + h * 64;
    asm volatile("" : "+s"(Qw), "+s"(Ow));
    bf16x8 qr[4];
#pragma unroll
    for (int d0 = 0; d0 < 4; ++d0) qr[d0] = *(const GAS bf16x8*)((const GAS char*)Qw + 32 * d0 + (unsigned)(r32 * D + 8 * hi) * 2u);
    f32x16 o[2]; o[0] = f32x16{}; o[1] = f32x16{};
    float carry = 0.f;
    const bf16_t* Kh = T.K + rowb * D + h * 64; const bf16_t* Vh = T.V + rowb * D + h * 64;
    asm volatile("" : "+s"(Kh), "+s"(Vh));
    u32x4 kr[8], vr[8];
    int kt = q0 >> 6;
    if (!samp) {
        int k0 = q0 >= 32 ? q0 - 32 : 0;
        load_bf16_regs(kr, vr, Kh + (size_t)k0 * D, Vh + (size_t)k0 * D, lane);
        { const int kn = k0 >= 64 ? k0 - 64 : 0;
          tile_step<true>(kr, vr, qr, o, carry, true, q0 < 32, q0 + r32 - k0, vimg, lane, Kh + (size_t)kn * D, Vh + (size_t)kn * D, k0 > 0); }
        while (k0 > 0) {
            if (__all(carry > EXIT_T)) break;
            const int prev = k0; k0 = prev >= 64 ? prev - 64 : 0;
            const int kn = k0 >= 64 ? k0 - 64 : 0; const bool clamp = prev < 64;
            tile_step<true>(kr, vr, qr, o, carry, clamp, clamp && prev <= 32, prev - k0, vimg, lane, Kh + (size_t)kn * D, Vh + (size_t)kn * D, k0 > 0);
        }
    } else {
        load_bf16(Kh + (size_t)kt * 64 * D, Vh + (size_t)kt * 64 * D, vimg, lane);
        tile_step<false>(kr, vr, qr, o, carry, true, (q0 & 32) == 0, q0 + r32 - 64 * kt, vimg, lane, nullptr, nullptr, false);
        const float* cKh = T.cK + (size_t)b * PAST * D + h * 64; const float* cVh = T.cV + (size_t)b * PAST * D + h * 64;
        asm volatile("" : "+s"(cKh), "+s"(cVh));
        for (kt = PAST / 64 - 1; kt >= 0; --kt) {
            if (__all(carry > EXIT_T)) break;
            load_f32(cKh + (size_t)kt * 64 * D, cVh + (size_t)kt * 64 * D, vimg, lane);
            tile_step<false>(kr, vr, qr, o, carry, false, false, 64, vimg, lane, nullptr, nullptr, false);
        }
    }
#pragma unroll
    for (int dh = 0; dh < 2; ++dh)
#pragma unroll
        for (int a = 0; a < 4; ++a) { u32x2 w; w.x = pk_bf16(o[dh][4 * a], o[dh][4 * a + 1]); w.y = pk_bf16(o[dh][4 * a + 2], o[dh][4 * a + 3]);
            *(LAS u32x2*)(vimg + r32 * 144 + (32 * dh + 8 * a + 4 * hi) * 2) = w; }
    asm volatile("s_waitcnt lgkmcnt(0)" ::: "memory");
#pragma unroll
    for (int i = 0; i < 4; ++i) { const int row = i * 8 + (lane >> 3), ch = lane & 7; const u32x4 v = *(LAS const u32x4*)(vimg + row * 144 + ch * 16); *(GAS u32x4*)((GAS char*)Ow + (unsigned)(row * D + ch * 8) * 2u) = v; }
    asm volatile("s_waitcnt lgkmcnt(0)" ::: "memory");
}
}

constexpr int NWAVES = 8;
constexpr int RING_OFF = 0, RING_BYTES = 131072, XCH_OFF = RING_BYTES, XCH_BYTES = 8192, MISC_OFF = 143360, TICKET_OFF = MISC_OFF + 256, LDS_BYTES = 147456;
static_assert(sba::WAVE_LDS * NWAVES <= MISC_OFF && XCH_OFF + XCH_BYTES <= MISC_OFF && TICKET_OFF + 64 <= LDS_BYTES, "LDS map");

#define XB_TMO      128
#define XB_XCNT(j)  (256  + 64 * (j))
#define XB_XSUB(j)  (1280 + 64 * (j))
#define XB_XGEN(j)  (2304 + 64 * (j))
#define XB_TOP      3328
#define XB_TOPGEN   3392
#define XCD_BAR_WORDS 3456
#define XB_SPIN_CAP (1u << 18)
__device__ __forceinline__ unsigned xb_ld(unsigned* p)              { return __hip_atomic_load(p, __ATOMIC_RELAXED, __HIP_MEMORY_SCOPE_AGENT); }
__device__ __forceinline__ unsigned xb_add(unsigned* p, unsigned v) { return __hip_atomic_fetch_add(p, v, __ATOMIC_RELAXED, __HIP_MEMORY_SCOPE_AGENT); }
__device__ __forceinline__ unsigned xb_xcc_id() { return (unsigned)__builtin_amdgcn_s_getreg((3 << 11) | 20) & 0xFu; }
#define XB_SPIN(cond, bar) do { unsigned _sp = 0; while (cond) { __builtin_amdgcn_s_sleep(1); \
    if ((++_sp & 255u) == 0u) { if (xb_ld(&(bar)[XB_TMO])) break; if (_sp > XB_SPIN_CAP) { atomicAdd(&(bar)[XB_TMO], 1u); break; } } } } while (0)
struct XcdBarrier { unsigned* bar; unsigned x; volatile LAS unsigned* st; };
__device__ __forceinline__ XcdBarrier xcd_barrier_post(unsigned* bar, volatile LAS unsigned* st, int tid) {
    XcdBarrier b; b.bar = bar; b.x = xb_xcc_id(); b.st = st;
    if (tid == 0) (void)xb_add(&bar[XB_XCNT(b.x)], 1u);
    return b;
}
__device__ __forceinline__ void xcd_barrier_complete(unsigned* bar, unsigned x, unsigned& nloc, unsigned& nx) {
    const unsigned G = gridDim.x * gridDim.y * gridDim.z;
    unsigned sum, cnt, mine, sp = 0u;
    for (;;) {
        sum = 0u; cnt = 0u; mine = 0u;
#pragma unroll
        for (unsigned j = 0; j < 16; ++j) { const unsigned c = xb_ld(&bar[XB_XCNT(j)]); sum += c; cnt += (c > 0u) ? 1u : 0u; mine = (j == x) ? c : mine; }
        if (sum == G) break;
        __builtin_amdgcn_s_sleep(1);
        if ((++sp & 255u) == 0u) { if (xb_ld(&bar[XB_TMO])) break; if (sp > XB_SPIN_CAP) { atomicAdd(&bar[XB_TMO], 1u); break; } }
    }
    nloc = mine > 0u ? mine : 1u; nx = cnt > 0u ? cnt : 1u;
}
__device__ __forceinline__ void xcd_barrier(const XcdBarrier& b, int tid) {
    asm volatile("s_waitcnt vmcnt(0)" ::: "memory");
    __syncthreads();
    if (tid == 0) {
        unsigned* bar = b.bar;
        __builtin_amdgcn_s_waitcnt(0);
        unsigned nloc = b.st[0], nx = b.st[1];
        if (nloc == 0u) { xcd_barrier_complete(bar, b.x, nloc, nx); b.st[0] = nloc; b.st[1] = nx; }
        const unsigned old = xb_add(&bar[XB_XSUB(b.x)], 1u);
        const unsigned gen = old / nloc;
        if (old + 1u == (gen + 1u) * nloc) {
            __builtin_amdgcn_fence(__ATOMIC_RELEASE, "agent");
            asm volatile("s_waitcnt vmcnt(0)" ::: "memory");
            const unsigned og = xb_add(&bar[XB_TOP], 1u);
            const unsigned tg = og / nx;
            if (og + 1u == (tg + 1u) * nx) xb_add(&bar[XB_TOPGEN], 1u);
            else XB_SPIN(xb_ld(&bar[XB_TOPGEN]) == tg, bar);
            __builtin_amdgcn_fence(__ATOMIC_ACQUIRE, "agent");
            xb_add(&bar[XB_XGEN(b.x)], 1u);
            asm volatile("s_waitcnt vmcnt(0)" ::: "memory");
        } else {
            XB_SPIN(xb_ld(&bar[XB_XGEN(b.x)]) == gen, bar);
            __builtin_amdgcn_fence(__ATOMIC_ACQUIRE, "agent");
            asm volatile("s_waitcnt vmcnt(0)" ::: "memory");
        }
    }
    __syncthreads();
}

struct Args { const float* in[25]; float* out; unsigned char* ws; int ph_lo, ph_hi; };
struct Frame { LAS unsigned char* lds; int tid, lane, wave, vcu, G, gw, NGW, bx; };

__device__ __forceinline__ float wave_sum(float v, int lane) {
#pragma unroll
    for (int o = 1; o < 64; o <<= 1) v += shx(v, o, lane);
    return v;
}
__device__ __forceinline__ void transpose_item(const float* W, int ldw, int k0, int n0, bf16_t* WT, int ldt, int drow0, LAS float* scr, int lane, const float* gk = nullptr) {
    f32x4 t[8];
#pragma unroll
    for (int i = 0; i < 8; ++i) { const int kk = 8 * i + (lane >> 3); t[i] = *(const GAS f32x4*)(W + (size_t)(k0 + kk) * ldw + n0 + 4 * (lane & 7)); }
#pragma unroll
    for (int i = 0; i < 8; ++i) { const int kk = 8 * i + (lane >> 3); const float g = gk ? gk[k0 + kk] : 1.f; LAS float* d = scr + kk * 33 + 4 * (lane & 7);
        d[0] = t[i][0] * g; d[1] = t[i][1] * g; d[2] = t[i][2] * g; d[3] = t[i][3] * g; }
    asm volatile("s_waitcnt lgkmcnt(0)" ::: "memory");
    const int c = lane & 7;
#pragma unroll
    for (int j = 0; j < 4; ++j) { const int n = (lane >> 3) + 8 * j; const LAS float* s = scr + (8 * c) * 33 + n;
        u32x4 o; o.x = pk_bf16(s[0 * 33], s[1 * 33]); o.y = pk_bf16(s[2 * 33], s[3 * 33]); o.z = pk_bf16(s[4 * 33], s[5 * 33]); o.w = pk_bf16(s[6 * 33], s[7 * 33]);
        *(GAS u32x4*)(WT + (size_t)(drow0 + n) * ldt + k0 + 8 * c) = o; }
    asm volatile("s_waitcnt lgkmcnt(0)" ::: "memory");
}
__device__ __forceinline__ void transpose_mat_item(const float* W, int ldw, int K, int N, bf16_t* WT, int r, LAS float* scr, int lane, const float* gk = nullptr) {
    const int nblk = N / 32, kb = r / nblk, nb = r % nblk; transpose_item(W, ldw, 64 * kb, 32 * nb, WT, K, 32 * nb, scr, lane, gk);
}
__device__ __forceinline__ void norm_row(const float* xrow, const float* g, bf16_t* hb, float* xc, float* fo, int lane) {
    const GAS f32x4* xr = (const GAS f32x4*)xrow + lane; const GAS f32x4* gr = (const GAS f32x4*)g + lane;
    f32x4 v[4]; float s = 0.f;
#pragma unroll
    for (int j = 0; j < 4; ++j) { v[j] = xr[64 * j]; s += (v[j].x * v[j].x + v[j].y * v[j].y) + (v[j].z * v[j].z + v[j].w * v[j].w); }
    if (xc) {
#pragma unroll
        for (int j = 0; j < 4; ++j) ((GAS f32x4*)xc + lane)[64 * j] = v[j];
    }
    const float rstd = 1.0f / sqrtf(wave_sum(s, lane) * (1.f / D) + RMS_EPS);
#pragma unroll
    for (int j = 0; j < 4; ++j) { v[j] = v[j] * rstd * gr[64 * j]; }
    if (hb) { GAS u32x2* o8 = (GAS u32x2*)hb + lane;
#pragma unroll
        for (int j = 0; j < 4; ++j) { u32x2 w; w.x = pk_bf16(v[j].x, v[j].y); w.y = pk_bf16(v[j].z, v[j].w); o8[64 * j] = w; } }
    if (fo) {
#pragma unroll
        for (int j = 0; j < 4; ++j) ((GAS f32x4*)fo + lane)[64 * j] = v[j];
    }
}
__device__ __forceinline__ int up_dest_row(int n) { return n < FF ? 256 * (n >> 7) + (n & 127) : 256 * ((n - FF) >> 7) + 128 + ((n - FF) & 127); }

__device__ __forceinline__ void ffn_weight_items(const Frame& F, const Args& a, int l, int wi, int nw) {
    LAS float* scr = (LAS float*)(F.lds + RING_OFF + F.wave * 16384);
    unsigned char* ws = a.ws;
    constexpr int I_UP = 16 * 176, I_DN = 44 * 32;
    for (int r = wi; r < I_UP + I_DN; r += nw) {
        if (r < I_UP) { const int kb = r / 176, nb = r % 176;
            transpose_item(a.in[21] + (size_t)l * D * FF2, FF2, 64 * kb, 32 * nb, (bf16_t*)(ws + WS_WUP) + (size_t)l * FF2 * D, D, up_dest_row(32 * nb), scr, F.lane, a.in[12] + l * D); }
        else transpose_mat_item(a.in[24] + (size_t)l * FF * D, D, FF, D, (bf16_t*)(ws + WS_WDN) + (size_t)l * D * FF, r - I_UP, scr, F.lane);
    }
}
__device__ __forceinline__ void p0_prologue(const Frame& F, const Args& a) {
    LAS float* scr = (LAS float*)(F.lds + RING_OFF + F.wave * 16384);
    unsigned char* ws = a.ws;
    constexpr int I_QKV = 16 * 96, I_SQ = 16 * 32, I_POOL = 4 * 32, I_KV = 16 * 64;
    constexpr int NIT = I_QKV + I_SQ + I_POOL + 2 * I_KV + 2 * I_SQ;
    for (int it = F.gw; it < NIT; it += F.NGW) {
        int r = it;
        if (r < I_QKV) { transpose_mat_item(a.in[14], 3 * D, D, 3 * D, (bf16_t*)(ws + WS_WQKV), r, scr, F.lane, a.in[9]); continue; } r -= I_QKV;
        if (r < I_SQ) { transpose_mat_item(a.in[15], D, D, D, (bf16_t*)(ws + WS_WO), r, scr, F.lane); continue; } r -= I_SQ;
        if (r < I_POOL) { const int g = r >> 5; transpose_mat_item(a.in[16] + (size_t)g * 65536, 256, 256, 256, (bf16_t*)(ws + WS_WPOOL) + (size_t)g * 65536, r & 31, scr, F.lane); continue; } r -= I_POOL;
        if (r < 2 * I_KV) { const int l = r / I_KV; transpose_mat_item(a.in[19] + (size_t)l * D * 2 * D, 2 * D, D, 2 * D, (bf16_t*)(ws + WS_WCAKV) + (size_t)l * 2 * D * D, r % I_KV, scr, F.lane); continue; } r -= 2 * I_KV;
        if (r < 2 * I_SQ) { const int l = r / I_SQ; transpose_mat_item(a.in[20] + (size_t)l * D * D, D, D, D, (bf16_t*)(ws + WS_WCAO) + (size_t)l * D * D, r % I_SQ, scr, F.lane); continue; } r -= 2 * I_SQ;
    }
    { const int n8 = 2 * D * D / 8;
      for (int i = F.bx * 512 + F.tid; i < n8; i += F.G * 512) { const int l = i / (D * D / 8), kk = (i % (D * D / 8)) / (D / 8); const float g = a.in[10][l * D + kk];
          const GAS f32x4* src = (const GAS f32x4*)a.in[18] + 2 * (size_t)i; const f32x4 x = src[0] * g, y = src[1] * g;
          u32x4 w; w.x = pk_bf16(x[0], x[1]); w.y = pk_bf16(x[2], x[3]); w.z = pk_bf16(y[0], y[1]); w.w = pk_bf16(y[2], y[3]); ((GAS u32x4*)(ws + WS_WCAQ))[i] = w; } }
    { const GAS f32x4* src = (const GAS f32x4*)a.in[8]; GAS u32x4* dst = (GAS u32x4*)(ws + WS_VMTS); const int n8 = 2 * DB * NMEM * D / 8;
      for (int i = F.bx * 512 + F.tid; i < n8; i += F.G * 512) { const f32x4 x = src[2 * i], y = src[2 * i + 1]; u32x4 w; w.x = pk_bf16(x[0], x[1]); w.y = pk_bf16(x[2], x[3]); w.z = pk_bf16(y[0], y[1]); w.w = pk_bf16(y[2], y[3]); dst[i] = w; } }
    { const GAS f32x4* src = (const GAS f32x4*)a.in[7]; GAS u32x4* dst = (GAS u32x4*)(ws + WS_KMS); const int n8 = 2 * DB * NMEM * D / 8;
      for (int i = F.bx * 512 + F.tid; i < n8; i += F.G * 512) { const f32x4 x = src[2 * i], y = src[2 * i + 1]; u32x4 w; w.x = pk_bf16(x[0], x[1]); w.y = pk_bf16(x[2], x[3]); w.z = pk_bf16(y[0], y[1]); w.w = pk_bf16(y[2], y[3]); dst[i] = w; } }
    for (int m = F.gw; m < 2 * NB * NMEM; m += F.NGW) { const int l = m / (NB * NMEM), r = m % (NB * NMEM);
        norm_row(a.in[2] + (size_t)r * D, a.in[11] + l * D, (bf16_t*)(ws + WS_MN) + (size_t)m * D, nullptr, nullptr, F.lane); }
    { GAS float* ssz = (GAS float*)(ws + WS_SS) + M; for (int i = F.bx * 512 + F.tid; i < 6 * M; i += F.G * 512) ssz[i] = 0.f; }
    for (int m = F.gw; m < M; m += 2 * F.NGW) {
        const int m2 = m + F.NGW; const bool has2 = m2 < M;
        const float* xr = m < MP ? a.in[0] + (size_t)m * D : a.in[1] + (size_t)(m - MP) * D; const float* xr2 = !has2 ? xr : (m2 < MP ? a.in[0] + (size_t)m2 * D : a.in[1] + (size_t)(m2 - MP) * D);
        const GAS f32x4* xp = (const GAS f32x4*)xr + F.lane; const GAS f32x4* xp2 = (const GAS f32x4*)xr2 + F.lane;
        f32x4 v[4], v2[4];
#pragma unroll
        for (int j = 0; j < 4; ++j) { v[j] = xp[64 * j]; v2[j] = xp2[64 * j]; }
        GAS u32x2* op = (GAS u32x2*)((bf16_t*)(ws + WS_HB) + (size_t)m * D) + F.lane; GAS u32x2* op2 = (GAS u32x2*)((bf16_t*)(ws + WS_HB) + (size_t)(has2 ? m2 : m) * D) + F.lane; float q = 0.f, q2 = 0.f;
#pragma unroll
        for (int j = 0; j < 4; ++j) { u32x2 w; w.x = pk_bf16(v[j].x, v[j].y); w.y = pk_bf16(v[j].z, v[j].w); op[64 * j] = w;
            q += (bf_lo(w.x) * bf_lo(w.x) + bf_hi(w.x) * bf_hi(w.x)) + (bf_lo(w.y) * bf_lo(w.y) + bf_hi(w.y) * bf_hi(w.y));
            u32x2 w2; w2.x = pk_bf16(v2[j].x, v2[j].y); w2.y = pk_bf16(v2[j].z, v2[j].w); if (has2) op2[64 * j] = w2;
            q2 += (bf_lo(w2.x) * bf_lo(w2.x) + bf_hi(w2.x) * bf_hi(w2.x)) + (bf_lo(w2.y) * bf_lo(w2.y) + bf_hi(w2.y) * bf_hi(w2.y)); }
        q = wave_sum(q, F.lane); q2 = wave_sum(q2, F.lane);
        if (F.lane == 0) { ((GAS float*)(ws + WS_SS))[m] = q; if (has2) ((GAS float*)(ws + WS_SS))[m2] = q2; } }
}
__device__ __forceinline__ void final_phase(const Frame& F, const Args& a) {
    const float* ss = (const float*)(a.ws + WS_SS) + (size_t)6 * M; const GAS f32x4* gr = (const GAS f32x4*)a.in[13] + F.lane;
    f32x4 g[4];
#pragma unroll
    for (int j = 0; j < 4; ++j) g[j] = gr[64 * j];
    for (int m0 = F.gw; m0 < MP; m0 += 4 * F.NGW) {
        u32x2 w[4][4]; float rs[4];
#pragma unroll
        for (int r = 0; r < 4; ++r) { const int m = m0 + r * F.NGW < MP ? m0 + r * F.NGW : m0; rs[r] = __builtin_amdgcn_rsqf(ss[m] * (1.f / D) + RMS_EPS);
            const GAS u32x2* xp = (const GAS u32x2*)((const bf16_t*)(a.ws + WS_HB) + (size_t)m * D) + F.lane;
#pragma unroll
            for (int j = 0; j < 4; ++j) w[r][j] = xp[64 * j]; }
#pragma unroll
        for (int r = 0; r < 4; ++r) { const int m = m0 + r * F.NGW; if (m < MP) { GAS f32x4* op = (GAS f32x4*)(a.out + OUT_Y + (size_t)m * D) + F.lane;
#pragma unroll
            for (int j = 0; j < 4; ++j) __builtin_nontemporal_store((f32x4){bf_lo(w[r][j].x), bf_hi(w[r][j].x), bf_lo(w[r][j].y), bf_hi(w[r][j].y)} * rs[r] * g[j], op + 64 * j); } }
    }
    for (int r = F.NGW - 1 - F.gw; r < MS; r += F.NGW) {
        const GAS u32x2* xp = (const GAS u32x2*)((const bf16_t*)(a.ws + WS_HB) + (size_t)(MP + r) * D) + F.lane;
        f32x4 x[4];
#pragma unroll
        for (int j = 0; j < 4; ++j) { const u32x2 w = xp[64 * j]; x[j] = (f32x4){bf_lo(w.x), bf_hi(w.x), bf_lo(w.y), bf_hi(w.y)}; }
#pragma unroll
        for (int p = 0; p < 11; ++p) { const GAS u32x2* pp = (const GAS u32x2*)((const bf16_t*)(a.ws + WS_PART) + ((size_t)p * MS + r) * D) + F.lane;
#pragma unroll
            for (int j = 0; j < 4; ++j) { const u32x2 w = pp[64 * j]; x[j] += (f32x4){bf_lo(w.x), bf_hi(w.x), bf_lo(w.y), bf_hi(w.y)}; } }
        float q = 0.f;
#pragma unroll
        for (int j = 0; j < 4; ++j) q += x[j][0] * x[j][0] + x[j][1] * x[j][1] + x[j][2] * x[j][2] + x[j][3] * x[j][3];
        q = wave_sum(q, F.lane);
        const float rs = __builtin_amdgcn_rsqf(q * (1.f / D) + RMS_EPS);
        GAS f32x4* op = (GAS f32x4*)(a.out + OUT_Y + (size_t)(MP + r) * D) + F.lane;
#pragma unroll
        for (int j = 0; j < 4; ++j) __builtin_nontemporal_store(x[j] * rs * g[j], op + 64 * j);
    }
}
template <int W> __device__ __forceinline__ void pool_load_h(float (&hv)[16], const Args& a, const float* ss, const float (&gn)[16], bool samp, int b, int m0, int t, int c0) {
    if (t >= 0) { const GAS u32x4* p = (const GAS u32x4*)((const bf16_t*)(a.ws + WS_HB) + (size_t)(m0 + t) * D + c0); const u32x4 x = p[0], y = p[1];
        const float rs = __builtin_amdgcn_rsqf(ss[m0 + t] * (1.f / D) + RMS_EPS);
        const float v[16] = {bf_lo(x.x), bf_hi(x.x), bf_lo(x.y), bf_hi(x.y), bf_lo(x.z), bf_hi(x.z), bf_lo(x.w), bf_hi(x.w), bf_lo(y.x), bf_hi(y.x), bf_lo(y.y), bf_hi(y.y), bf_lo(y.z), bf_hi(y.z), bf_lo(y.w), bf_hi(y.w)};
#pragma unroll
        for (int e = 0; e < 16; ++e) hv[e] = v[e] * rs * gn[e]; }
    else if (samp) { const GAS f32x4* p = (const GAS f32x4*)(a.in[5] + ((size_t)b * 15 + (15 + t)) * D + c0);
#pragma unroll
        for (int q = 0; q < 4; ++q) { const f32x4 x = p[q]; hv[4 * q] = x[0]; hv[4 * q + 1] = x[1]; hv[4 * q + 2] = x[2]; hv[4 * q + 3] = x[3]; } }
    else {
#pragma unroll
        for (int e = 0; e < 16; ++e) hv[e] = 0.f; }
}
template <int W> __device__ __forceinline__ void pool_item(const Args& a, int chunk, int g, int lane) {
    bf16_t* PB = (bf16_t*)(a.ws + WS_QB); const float* ss = (const float*)(a.ws + WS_SS) + (size_t)3 * M;
    const bool samp = chunk >= MP / 64;
    const int b = samp ? chunk - MP / 64 : chunk >> 6, m0 = samp ? MP + b * DSEQ : b * SEQ, tl = samp ? DSEQ : SEQ;
    const int ts = (samp ? 0 : (chunk & 63) * 64) + 16 * (lane >> 4), c0 = g * 256 + (lane & 15) * 16;
    float gn[16];
    { const GAS f32x4* gp = (const GAS f32x4*)(a.in[9] + D + c0);
#pragma unroll
      for (int q = 0; q < 4; ++q) { const f32x4 x = gp[q]; gn[4 * q] = x[0]; gn[4 * q + 1] = x[1]; gn[4 * q + 2] = x[2]; gn[4 * q + 3] = x[3]; } }
    float run[16], hv[16];
#pragma unroll
    for (int e = 0; e < 16; ++e) run[e] = 0.f;
#pragma unroll 2
    for (int j = 1; j < W; ++j) { pool_load_h<W>(hv, a, ss, gn, samp, b, m0, ts - j, c0);
#pragma unroll
        for (int e = 0; e < 16; ++e) run[e] += hv[e]; }
#pragma unroll 4
    for (int i = 0; i < 16; ++i) {
        const int t = ts + i;
        pool_load_h<W>(hv, a, ss, gn, samp, b, m0, t, c0);
#pragma unroll
        for (int e = 0; e < 16; ++e) run[e] += hv[e];
        const int pos = samp ? PAST + t : t; const float inv = 1.0f / (float)(pos + 1 < W ? pos + 1 : W);
        u32x4 o0, o1;
        o0.x = pk_bf16(run[0] * inv - hv[0], run[1] * inv - hv[1]); o0.y = pk_bf16(run[2] * inv - hv[2], run[3] * inv - hv[3]); o0.z = pk_bf16(run[4] * inv - hv[4], run[5] * inv - hv[5]); o0.w = pk_bf16(run[6] * inv - hv[6], run[7] * inv - hv[7]);
        o1.x = pk_bf16(run[8] * inv - hv[8], run[9] * inv - hv[9]); o1.y = pk_bf16(run[10] * inv - hv[10], run[11] * inv - hv[11]); o1.z = pk_bf16(run[12] * inv - hv[12], run[13] * inv - hv[13]); o1.w = pk_bf16(run[14] * inv - hv[14], run[15] * inv - hv[15]);
        GAS u32x4* op = (GAS u32x4*)(PB + (size_t)(m0 + t) * D + c0); op[0] = o0; op[1] = o1;
        if (t >= tl - 15) { float* fo = (samp ? a.out + OUT_PSS : a.out + OUT_PSP) + ((size_t)b * 15 + (t - (tl - 15))) * D + c0;
#pragma unroll
            for (int q = 0; q < 4; ++q) ((GAS f32x4*)fo)[q] = (f32x4){hv[4 * q], hv[4 * q + 1], hv[4 * q + 2], hv[4 * q + 3]}; }
        float ho[16]; pool_load_h<W>(ho, a, ss, gn, samp, b, m0, t - (W - 1), c0);
#pragma unroll
        for (int e = 0; e < 16; ++e) run[e] -= ho[e];
    }
}
__device__ __forceinline__ void pool_phase(const Frame& F, const Args& a) {
    constexpr int NCH = MP / 64 + DB;
    for (int it = F.gw, pass = 0; it < NCH * 4; it += F.NGW, ++pass) {
        const int gs = it & 3, g = (pass & 1) ? 3 - gs : gs, chunk = it >> 2;
        if (g == 0) pool_item<2>(a, chunk, 0, F.lane); else if (g == 1) pool_item<4>(a, chunk, 1, F.lane); else if (g == 2) pool_item<8>(a, chunk, 2, F.lane); else pool_item<16>(a, chunk, 3, F.lane);
    }
}
__device__ __forceinline__ void ffn_fix_tile(unsigned char* ws, const float* cw, const float* cb, int pm, int tid) {
    const float* edge = (const float*)(ws + WS_EDGE); const float* first = (const float*)(ws + WS_FIRST); bf16_t* A2 = (bf16_t*)(ws + WS_A2);
    for (int it = tid; it < FF / 4; it += 512) {
        const int c4 = it * 4, dcol = 256 * (c4 >> 7) + (c4 & 127);
        f32x4 wg[3], wv[3];
#pragma unroll
        for (int j = 0; j < 3; ++j) { wg[j] = *(const GAS f32x4*)(cw + (size_t)j * FF2 + c4); wv[j] = *(const GAS f32x4*)(cw + (size_t)j * FF2 + FF + c4); }
        const f32x4 bg = *(const GAS f32x4*)(cb + c4), bv = *(const GAS f32x4*)(cb + FF + c4);
        const float* e = edge + (size_t)(pm - 1) * 2 * FF2 + dcol; const float* f = first + (size_t)pm * 2 * FF2 + dcol;
        const f32x4 g2 = *(const GAS f32x4*)e, v2 = *(const GAS f32x4*)(e + 128), g1 = *(const GAS f32x4*)(e + FF2), v1 = *(const GAS f32x4*)(e + FF2 + 128);
        const f32x4 g0 = *(const GAS f32x4*)f, v0 = *(const GAS f32x4*)(f + 128), gp = *(const GAS f32x4*)(f + FF2), vp = *(const GAS f32x4*)(f + FF2 + 128);
        const f32x4 ga = bg + wg[0] * g2 + wg[1] * g1 + wg[2] * g0, va = bv + wv[0] * v2 + wv[1] * v1 + wv[2] * v0;
        const f32x4 gb = bg + wg[0] * g1 + wg[1] * g0 + wg[2] * gp, vb = bv + wv[0] * v1 + wv[1] * v0 + wv[2] * vp;
        f32x4 ya, yb;
#pragma unroll
        for (int q = 0; q < 4; ++q) { ya[q] = ga[q] * va[q] * __builtin_amdgcn_rcpf(1.f + __builtin_amdgcn_exp2f(-ga[q] * LOG2E)); yb[q] = gb[q] * vb[q] * __builtin_amdgcn_rcpf(1.f + __builtin_amdgcn_exp2f(-gb[q] * LOG2E)); }
        u32x2 wa, wb; wa.x = pk_bf16(ya[0], ya[1]); wa.y = pk_bf16(ya[2], ya[3]); wb.x = pk_bf16(yb[0], yb[1]); wb.y = pk_bf16(yb[2], yb[3]);
        *(GAS u32x2*)(A2 + (size_t)(pm * 256) * FF + c4) = wa; *(GAS u32x2*)(A2 + (size_t)(pm * 256 + 1) * FF + c4) = wb;
    }
}

extern __shared__ __attribute__((aligned(16))) unsigned char lds_raw[];
typedef __attribute__((address_space(4))) const Args CArgs;
__device__ __forceinline__ CArgs* kargs() { CArgs* k = (CArgs*)__builtin_amdgcn_kernarg_segment_ptr(); asm volatile("" : "+s"(k)); return k; }
__device__ __forceinline__ int elect_tid() {
    unsigned ones = ~0u; asm volatile("" : "+s"(ones));
    const int lane = (int)__builtin_amdgcn_mbcnt_hi(ones, __builtin_amdgcn_mbcnt_lo(ones, 0u));
    unsigned t = 0u;
    if (lane == 0) t = __hip_atomic_fetch_add((LAS unsigned*)((LAS unsigned char*)lds_raw + TICKET_OFF), 1u, __ATOMIC_RELAXED, __HIP_MEMORY_SCOPE_WORKGROUP);
    return (int)((__builtin_amdgcn_readfirstlane(t) & 7u) * 64u) + lane;
}
__device__ __forceinline__ Frame make_frame() {
    Frame F; F.lds = (LAS unsigned char*)lds_raw;
    const int tid = elect_tid(); __syncthreads();
    int bx = blockIdx.x, G = gridDim.x; asm volatile("" : "+s"(bx), "+s"(G));
    F.tid = tid; F.lane = F.tid & 63; F.wave = __builtin_amdgcn_readfirstlane(F.tid >> 6);
    F.G = G; F.bx = bx; F.vcu = (F.G % 8 == 0) ? (bx % 8) * (F.G / 8) + bx / 8 : bx;
    F.gw = F.vcu * NWAVES + F.wave; F.NGW = F.G * NWAVES; return F;
}
__device__ __forceinline__ Args load_args() { CArgs* k = kargs(); Args a;
#pragma unroll
    for (int i = 0; i < 25; ++i) a.in[i] = k->in[i];
    a.out = k->out; a.ws = k->ws; a.ph_lo = k->ph_lo; a.ph_hi = k->ph_hi; return a; }
#define PHASE static __device__ __forceinline__ void

PHASE ph_prologue() { const Frame F = make_frame(); const Args a = load_args(); p0_prologue(F, a); }
__device__ __forceinline__ void memkv_part(const Frame& F, CArgs* k, int G2, int c2, int l0, int l1) {
    unsigned char* ws = k->ws; float* out = k->out;
    if (c2 < 0) return;
    for (int l = l0; l < l1; ++l) {
        { pg8::GemmP g{D, D, D}; pg8::SchedMN S{(const char*)(ws + WS_MN) + (size_t)l * NB * NMEM * D * 2, (const char*)(ws + WS_WCAKV) + (size_t)l * 2 * D * D * 2, D, D, 16, 4, G2, (c2 + 128 * l) % G2, 0};
          pg8::EpiMemK E{out + OUT_MKP + (size_t)l * NB * NMEM * D, (bf16_t*)(ws + WS_KMP) + (size_t)l * NB * NMEM * D};
          int t_ = F.tid; asm volatile("" : "+v"(t_)); pg8::gemm_phase(F.lds + RING_OFF, g, S, E, t_); }
        { pg8::GemmP g{D, D, D}; pg8::SchedMN S{(const char*)(ws + WS_MN) + (size_t)l * NB * NMEM * D * 2, (const char*)(ws + WS_WCAKV) + ((size_t)l * 2 * D * D + (size_t)D * D) * 2, D, D, 16, 4, G2, (c2 + 128 * l + 64) % G2, 0};
          pg8::EpiMemK E{out + OUT_MVP + (size_t)l * NB * NMEM * D, (bf16_t*)(ws + WS_VMTP) + (size_t)l * NB * NMEM * D};
          int t_ = F.tid; asm volatile("" : "+v"(t_)); pg8::gemm_phase(F.lds + RING_OFF, g, S, E, t_); }
    }
}
PHASE ph_qkv() {
    const Frame F = make_frame(); CArgs* k = kargs(); unsigned char* ws = k->ws;
    pg8::GemmP g{D, D, D}; pg8::SchedQKV S{(const char*)(ws + WS_HB), (const char*)(ws + WS_WQKV), M / 256, F.G, F.bx};
    pg8::EpiQKV E{(bf16_t*)(ws + WS_QB), (size_t)(WS_KB - WS_QB) / 2, k->out, sba::QSCALE, (const float*)(ws + WS_SS)};
    pg8::gemm_phase(F.lds + RING_OFF, g, S, E, F.tid);
    { const Frame F2 = make_frame();
      const int extra = (M / 256) * 12 - 12 * F2.G;
      int G2 = F2.G, c2 = F2.bx; if (extra > 0 && extra < F2.G) { G2 = F2.G - extra; c2 = F2.bx >= extra ? F2.bx - extra : -1; }
      memkv_part(F2, k, G2, c2, 0, 1); }
}
PHASE ph_sbattn() {
    const Frame F = make_frame(); CArgs* k = kargs(); unsigned char* ws = k->ws;
    sba::Tensors T{(const bf16_t*)(ws + WS_QB), (const bf16_t*)(ws + WS_KB), (const bf16_t*)(ws + WS_VB), (bf16_t*)(ws + WS_OB), k->in[3], k->in[4]};
    LAS char* vimg = (LAS char*)(F.lds + RING_OFF + F.wave * sba::WAVE_LDS);
    LAS unsigned* ctr = (LAS unsigned*)(F.lds + MISC_OFF + 64);
    for (;;) {
        unsigned j = 0u; if (F.lane == 0) j = __hip_atomic_fetch_add(ctr, 1u, __ATOMIC_RELAXED, __HIP_MEMORY_SCOPE_WORKGROUP);
        j = (unsigned)__builtin_amdgcn_readfirstlane(j);
        const int id = F.vcu * NWAVES + (int)(j & 7u) + (int)(j >> 3) * F.NGW;
        if (id >= 32768 + 1024) break;
        sba::unit(id, T, vimg, F.lane);
    }
}
__device__ __forceinline__ size_t ca_base(int layer) { return layer == 0 ? WS_QB : WS_OB; }
__device__ __forceinline__ int ca_vwrow0(int layer) { return layer == 0 ? (int)((WS_VB - WS_QB) / 2048) : (int)((WS_VW1 - WS_OB) / 2048); }
__device__ __forceinline__ void wkvw_part(const Frame& F, CArgs* k, int layer, int G, int c) {
    unsigned char* ws = k->ws;
    pg8::GemmP g{D, D, 256};
    pg8::SchedWKVW S{(const char*)(ws + WS_KMP) + (size_t)layer * NB * NMEM * D * 2, (const char*)(ws + WS_KMS) + (size_t)layer * DB * NMEM * D * 2,
                     (const char*)(ws + WS_VMTP) + (size_t)layer * NB * NMEM * D * 2, (const char*)(ws + WS_VMTS) + (size_t)layer * DB * NMEM * D * 2,
                     (const char*)(ws + WS_WCAQ) + (size_t)layer * D * D * 2, (const char*)(ws + WS_WCAO) + (size_t)layer * D * D * 2, G, c, ca_vwrow0(layer)};
    pg8::EpiBf16 E{(bf16_t*)(ws + ca_base(layer)), D, 1.f, nullptr};
    pg8::gemm_phase(F.lds + RING_OFF, g, S, E, F.tid);
}
PHASE ph_resid_gemm(int which_, int layer_, float alpha) {
    const int which = __builtin_amdgcn_readfirstlane(which_), layer = __builtin_amdgcn_readfirstlane(layer_);
    const Frame F = make_frame(); CArgs* k = kargs(); unsigned char* ws = k->ws;
    const char* A; const char* W; int K, ssi;
    if (which == 0) { A = (const char*)(ws + WS_OB); W = (const char*)(ws + WS_WO); K = D; ssi = 1; }
    else if (which == 1) { A = (const char*)(ws + WS_VB); W = (const char*)(ws + WS_WCAO) + (size_t)layer * D * D * 2; K = D; ssi = layer == 0 ? 2 : 5; }
    else { A = (const char*)(ws + WS_A2); W = (const char*)(ws + WS_WDN) + (size_t)layer * D * FF * 2; K = FF; ssi = layer == 0 ? 3 : 6; }
    const bool splitk = which == 2 && layer == 1;
    pg8::GemmP g{K, K, K}; pg8::SchedMN S{A, W, K, K, splitk ? MP / 256 : M / 256, 4, F.G, F.bx, 0};
    if (which == 2) {
        int last = -1;
        for (int i = 0; ; ++i) { pg8::Unit u; if (!S.next(i, u)) break; const int pm = u.row0 >> 8;
            if (pm != last && pm < MP / 256 && (pm & 15) != 0) ffn_fix_tile(ws, k->in[22] + (size_t)layer * 3 * FF2, k->in[23] + (size_t)layer * FF2, pm, F.tid);
            last = pm; }
        asm volatile("s_waitcnt vmcnt(0)" ::: "memory"); __syncthreads();
    }
    pg8::EpiResid<false> E{(bf16_t*)(ws + WS_HB), (float*)(ws + WS_SS) + (size_t)ssi * M, nullptr, alpha};
    pg8::gemm_phase(F.lds + RING_OFF, g, S, E, F.tid);
    if (splitk && alpha != 0.f) {
        const Frame F2 = make_frame();
        pg8::GemmP g2{FF, FF, 256}; pg8::SchedSplitK S2{A, W, F2.G, F2.bx};
        pg8::EpiBf16 E2{(bf16_t*)(ws + WS_PART), D, 1.f, nullptr};
        pg8::gemm_phase(F2.lds + RING_OFF, g2, S2, E2, F2.tid);
    }
    if (alpha != 0.f && (which == 0 || (which == 2 && layer == 0))) {
        const Frame F2 = make_frame();
        const int extra = (M / 256) * 4 - 4 * F2.G;
        const int nl = which == 0 ? 0 : 1;
        int G2 = F2.G, c2 = F2.bx; if (extra > 0 && extra < F2.G) { G2 = F2.G - extra; c2 = F2.bx >= extra ? F2.bx - extra : -1; }
        wkvw_part(F2, k, nl, G2, c2);
    }
}
PHASE ph_pool_gemm(float alpha) {
    const Frame F = make_frame(); CArgs* k = kargs(); unsigned char* ws = k->ws;
    pg8::GemmP g{D, 256, 256}; pg8::SchedPool S{(const char*)(ws + WS_QB), (const char*)(ws + WS_WPOOL), F.G, F.bx};
    pg8::EpiResid<true> E{(bf16_t*)(ws + WS_HB), (float*)(ws + WS_SS) + (size_t)4 * M, k->in[17], alpha};
    pg8::gemm_phase(F.lds + RING_OFF, g, S, E, F.tid);
}
PHASE ph_final() { const Frame F = make_frame(); const Args a = load_args(); final_phase(F, a); }
PHASE ph_pool() { const Frame F = make_frame(); const Args a = load_args(); pool_phase(F, a); }
__device__ __forceinline__ void ffn_tail(int l) {
    const Frame F2 = make_frame(); const Args a = load_args();
    const int extra = 1152 - 4 * F2.G;
    if (extra > 0 && extra < F2.G) { if (F2.bx >= extra) ffn_weight_items(F2, a, l, (F2.bx - extra) * NWAVES + F2.wave, (F2.G - extra) * NWAVES); }
    else ffn_weight_items(F2, a, l, F2.bx * NWAVES + F2.wave, F2.G * NWAVES);
}
PHASE ph_cascore(int layer_) {
    const int layer = __builtin_amdgcn_readfirstlane(layer_);
    const Frame F = make_frame(); CArgs* k = kargs(); unsigned char* ws = k->ws;
    pg8::GemmP g{D, D, D}; pg8::SchedCA2<0> S{(const char*)(ws + WS_HB), (const char*)(ws + ca_base(layer)), F.G, F.bx, ca_vwrow0(layer)};
    pg8::EpiSoftmax E{(bf16_t*)(ws + WS_KB), XCH_OFF, (const float*)(ws + WS_SS) + (size_t)(layer == 0 ? 1 : 4) * M, 0.0625f * LOG2E};
    pg8::gemm_phase(F.lds + RING_OFF, g, S, E, F.tid);
    if (layer == 0) {
        const Frame F2 = make_frame(); const int extra = 1152 - 4 * F2.G;
        int G2 = F2.G, c2 = F2.bx; if (extra > 0 && extra < F2.G) { G2 = F2.G - extra; c2 = F2.bx >= extra ? F2.bx - extra : -1; }
        memkv_part(F2, k, G2, c2, 1, 2); }
}
PHASE ph_caout(int layer_, float alpha) {
    const int layer = __builtin_amdgcn_readfirstlane(layer_);
    const Frame F = make_frame(); CArgs* k = kargs(); unsigned char* ws = k->ws;
    pg8::GemmP g{D, D, D}; pg8::SchedCA2<1> S{(const char*)(ws + WS_KB), (const char*)(ws + ca_base(layer)), F.G, F.bx, ca_vwrow0(layer)};
    pg8::EpiResid<false> E{(bf16_t*)(ws + WS_HB), (float*)(ws + WS_SS) + (size_t)(layer == 0 ? 2 : 5) * M, nullptr, alpha};
    pg8::gemm_phase(F.lds + RING_OFF, g, S, E, F.tid);
    if (layer == 0 && alpha != 0.f) { ffn_tail(0); ffn_tail(1); }
}
PHASE ph_up(int layer_) {
    const int layer = __builtin_amdgcn_readfirstlane(layer_);
    const Frame F = make_frame(); CArgs* k = kargs(); unsigned char* ws = k->ws; float* out = k->out;
    pg8::GemmP g{D, D, D}; pg8::SchedMN S{(const char*)(ws + WS_HB), (const char*)(ws + WS_WUP) + (size_t)layer * FF2 * D * 2, D, D, M / 256, 22, F.G, F.bx, 0};
    pg8::EpiUpGate E{(bf16_t*)(ws + WS_A2), k->in[22] + (size_t)layer * 3 * FF2, k->in[23] + (size_t)layer * FF2, k->in[6] + (size_t)layer * DB * 2 * FF2,
                     out + OUT_FSP + (size_t)layer * NB * 2 * FF2, out + OUT_FSS + (size_t)layer * DB * 2 * FF2, (float*)(ws + WS_EDGE), (float*)(ws + WS_FIRST), XCH_OFF, (const float*)(ws + WS_SS) + (size_t)(layer == 0 ? 2 : 5) * M};
    pg8::gemm_phase(F.lds + RING_OFF, g, S, E, F.tid);
}

constexpr int N_PHASES = 15;
__global__ void __launch_bounds__(NWAVES * 64, 2) trunk_fwd(Args args_unused) {
    CArgs* k = kargs();
    volatile LAS unsigned* MISC = (volatile LAS unsigned*)((LAS unsigned char*)lds_raw + MISC_OFF);
    { const int tid = elect_tid(); __syncthreads();
      if (tid < 32) MISC[tid] = 0u;
      __syncthreads();
      if (k->ph_hi - k->ph_lo > 1) (void)xcd_barrier_post((unsigned*)(k->ws + WS_CTL) + CW_BAR, MISC + 8, tid); }
#ifndef PHASE_MASK
#define PHASE_MASK 0xffffffffull
#endif
#define IN(p) ((((PHASE_MASK) >> (p)) & 1ull) && k->ph_lo <= (p) && (p) < k->ph_hi)
#define SEAM(p) do { if (IN(p) && IN((p) + 1)) { XcdBarrier bar; bar.bar = (unsigned*)(k->ws + WS_CTL) + CW_BAR; bar.x = xb_xcc_id(); bar.st = MISC + 8; xcd_barrier(bar, elect_tid()); } } while (0)
#ifndef PROBE_REP
#define PROBE_REP 0ull
#endif
#define GBAR() do { XcdBarrier bar; bar.bar = (unsigned*)(k->ws + WS_CTL) + CW_BAR; bar.x = xb_xcc_id(); bar.st = MISC + 8; xcd_barrier(bar, elect_tid()); } while (0)
#define RUN(p, call, recall) do { if (IN(p)) { call; if (((PROBE_REP) >> (p)) & 1ull) { GBAR(); recall; } } SEAM(p); } while (0)
    RUN(0, ph_prologue(), ph_prologue());
    RUN(1, ph_qkv(), ph_qkv());
    RUN(2, ph_sbattn(), ph_sbattn());
    RUN(3, ph_resid_gemm(0, 0, 1.f), ph_resid_gemm(0, 0, 0.f));
    for (int layer = 0; layer < 2; ++layer) {
        const int pb = 4 + 6 * layer;
        if (layer == 1) {
            RUN(8, ph_pool(), ph_pool());
            RUN(9, ph_pool_gemm(1.f), ph_pool_gemm(0.f));
        }
        RUN(pb + 0, ph_cascore(layer), ph_cascore(layer));
        RUN(pb + 1, ph_caout(layer, 1.f), ph_caout(layer, 0.f));
        RUN(pb + 2, ph_up(layer), ph_up(layer));
        RUN(pb + 3, ph_resid_gemm(2, layer, 1.f), ph_resid_gemm(2, layer, 0.f));
    }
    if (IN(14)) ph_final();
#undef IN
#undef SEAM
#undef RUN
#undef GBAR
}

extern "C" void kernel_launch(void* const* d_in, const int* in_sizes, int n_in, void* d_out, int out_size, void* d_ws, size_t ws_size, hipStream_t stream) {
    static int grid = 0;
    if (grid == 0) {
        if (n_in != 25 || (size_t)out_size != OUT_TOTAL || ws_size < WS_END) { fprintf(stderr, "kernel_launch: unexpected shapes: n_in %d out %d ws %zu\n", n_in, out_size, ws_size); grid = -1; return; }
        int dev = 0, cus = 0;
        if (hipGetDevice(&dev) != hipSuccess || hipDeviceGetAttribute(&cus, hipDeviceAttributeMultiprocessorCount, dev) != hipSuccess) { grid = -1; return; }
        if (hipFuncSetAttribute((const void*)trunk_fwd, hipFuncAttributeMaxDynamicSharedMemorySize, LDS_BYTES) != hipSuccess) { fprintf(stderr, "kernel_launch: hipFuncSetAttribute failed\n"); grid = -1; return; }
        int per_cu = 0;
        if (hipOccupancyMaxActiveBlocksPerMultiprocessor(&per_cu, (const void*)trunk_fwd, NWAVES * 64, LDS_BYTES) != hipSuccess || per_cu < 1) fprintf(stderr, "kernel_launch: occupancy query reports %d\n", per_cu);
        (void)hipGetLastError();
        grid = cus;
    }
    if (grid < 0) return;
    (void)hipMemsetAsync((char*)d_ws + WS_CTL, 0, CTL_ZERO_BYTES, stream);
    Args a{};
    for (int i = 0; i < 25; ++i) a.in[i] = (const float*)d_in[i];
    a.out = (float*)d_out; a.ws = (unsigned char*)d_ws;
#if MK_ONE_LAUNCH
    a.ph_lo = 0; a.ph_hi = N_PHASES;
    hipLaunchKernelGGL(trunk_fwd, dim3(grid), dim3(NWAVES * 64), LDS_BYTES, stream, a);
#else
    for (int p = 0; p < N_PHASES; ++p) { a.ph_lo = p; a.ph_hi = p + 1; hipLaunchKernelGGL(trunk_fwd, dim3(grid), dim3(NWAVES * 64), LDS_BYTES, stream, a); }
#endif
}
```

```cpp
#include <hip/hip_runtime.h>
#include <cstdio>
#include <cstdint>

#ifndef MK_ONE_LAUNCH
#define MK_ONE_LAUNCH 1
#endif

#define GAS __attribute__((address_space(1)))
#define LAS __attribute__((address_space(3)))
typedef unsigned short bf16_t;
typedef short bf16x8 __attribute__((ext_vector_type(8)));
typedef short s16x4 __attribute__((ext_vector_type(4)));
typedef float f32x4 __attribute__((ext_vector_type(4)));
typedef float f32x16 __attribute__((ext_vector_type(16)));
typedef unsigned u32x4 __attribute__((ext_vector_type(4)));
typedef unsigned u32x2 __attribute__((ext_vector_type(2)));
typedef float f32x2_t __attribute__((ext_vector_type(2)));
typedef __bf16 bf16x2_t __attribute__((ext_vector_type(2)));
typedef GAS unsigned gu32;

__device__ __forceinline__ unsigned pk_bf16(float lo, float hi) { f32x2_t v = {lo, hi}; bf16x2_t b = __builtin_convertvector(v, bf16x2_t); return __builtin_bit_cast(unsigned, b); }
__device__ __forceinline__ float shx(float v, int mask, int lane) { return __int_as_float(__builtin_amdgcn_ds_bpermute((lane ^ mask) << 2, __float_as_int(v))); }
__device__ __forceinline__ float bf_lo(unsigned u) { return __uint_as_float(u << 16); }
__device__ __forceinline__ float bf_hi(unsigned u) { return __uint_as_float(u & 0xffff0000u); }

constexpr int D = 1024, MP = 65536, MS = 2048, M = MP + MS;
constexpr int SEQ = 4096, NB = 16, DB = 32, DSEQ = 64, PAST = 2048;
constexpr int FF = 2816, FF2 = 5632, NMEM = 256;
constexpr float RMS_EPS = 1e-6f;
constexpr float LOG2E = 1.4426950408889634f;
constexpr size_t OUT_Y = 0, OUT_KP = (size_t)M * D, OUT_VP = OUT_KP + (size_t)MP * D, OUT_KS = OUT_VP + (size_t)MP * D, OUT_VS = OUT_KS + (size_t)MS * D;
constexpr size_t OUT_PSP = OUT_VS + (size_t)MS * D, OUT_PSS = OUT_PSP + (size_t)NB * 15 * D, OUT_FSP = OUT_PSS + (size_t)DB * 15 * D;
constexpr size_t OUT_FSS = OUT_FSP + (size_t)2 * NB * 2 * FF2, OUT_MKP = OUT_FSS + (size_t)2 * DB * 2 * FF2, OUT_MVP = OUT_MKP + (size_t)2 * NB * NMEM * D;
constexpr size_t OUT_TOTAL = OUT_MVP + (size_t)2 * NB * NMEM * D;
static_assert(OUT_TOTAL == 226213888ull, "output size");
constexpr size_t MiB = 1u << 20;
constexpr size_t WS_CTL = 0, CTL_ZERO_BYTES = 1 * MiB;
constexpr size_t WS_WQKV = 2 * MiB, WS_WO = 8 * MiB, WS_WPOOL = 10 * MiB, WS_WCAQ = 11 * MiB, WS_WCAKV = 15 * MiB, WS_WCAO = 23 * MiB, WS_WUP = 27 * MiB, WS_WDN = 49 * MiB;
constexpr size_t WS_MN = 60 * MiB, WS_KMP = 76 * MiB, WS_VMTP = 92 * MiB, WS_KMS = 108 * MiB, WS_VMTS = 140 * MiB;
constexpr size_t WS_HB = 172 * MiB, WS_QB = 304 * MiB, WS_KB = 436 * MiB, WS_VB = 568 * MiB;
constexpr size_t WS_A2 = 304 * MiB, WS_EDGE = 700 * MiB, WS_FIRST = 712 * MiB, WS_OB = 724 * MiB, WS_SS = 856 * MiB, WS_VW1 = 858 * MiB, WS_END = 954 * MiB, WS_PART = WS_OB;
static_assert(WS_A2 + (size_t)M * FF * 2 <= WS_EDGE && WS_EDGE + (size_t)(M / 256) * 2 * FF2 * 4 <= WS_FIRST && WS_FIRST + (size_t)(M / 256) * 2 * FF2 * 4 <= WS_OB && WS_OB + (size_t)M * D * 2 <= WS_SS && WS_SS + (size_t)7 * M * 4 <= WS_END && WS_HB + (size_t)M * D * 2 <= WS_QB && WS_VB + (size_t)M * D * 2 <= WS_EDGE, "ws map");
constexpr int CW_BAR = 4096;

namespace pg8 {
constexpr int BM = 256, BK = 64, HALF = 128, HTB = HALF * BK * 2, STAGE_BYTES = 8 * HTB, NXCD = 8, WGM = 8;
__host__ __device__ __forceinline__ int lds_byte(int r, int c) { const int st = (r >> 4) * 2 + (c >> 5), rr = r & 15, cc = c & 31, ob = rr * 64 + cc * 2; return st * 1024 + (ob ^ (((ob >> 9) & 1) << 5)); }
__host__ __device__ __forceinline__ void stage_rc(int b, int& R, int& C) { const int st = b / 1024, sb = b % 1024, swz = sb ^ (((sb >> 9) & 1) << 5); R = (st >> 1) * 16 + swz / 64; C = (st & 1) * 32 + (swz % 64) / 2; }
__host__ __device__ __forceinline__ int perm32(int rho) { const int n = rho >> 4, i = rho & 15; return 8 * (i >> 2) + 4 * n + (i & 3); }

struct Unit { const char* a; const char* b; int row0, col0, vlo, vhi, aux; };
struct GemmP { int lda, ldb, K; };

__device__ __forceinline__ bool tile_of(long L, int nM, int nN, int& pm, int& pn) {
    const int nwg = nM * nN; if (L >= nwg) return false;
    int wgid = (int)L; { const int q = nwg / NXCD, r = nwg % NXCD, xcd = wgid % NXCD, off = wgid / NXCD; wgid = (xcd < r ? xcd * (q + 1) : r * (q + 1) + (xcd - r) * q) + off; }
    const int nig = WGM * nN, gid = wgid / nig, fm = gid * WGM, gsz = (nM - fm) < WGM ? (nM - fm) : WGM;
    pm = fm + ((wgid % nig) % gsz); pn = (wgid % nig) / gsz; return true;
}

template <class Epi, class Sched>
__device__ __forceinline__ void gemm_phase(LAS unsigned char* lds, const GemmP g, const Sched& S, const Epi& E, int tid) {
    const int wid = __builtin_amdgcn_readfirstlane(tid >> 6), lane = tid & 63, wr = wid >> 2, wc = wid & 3, fr = lane & 15, fq = lane >> 4;
    const int K = g.K, nt = K / BK;
    unsigned voffA[2], voffB[2];
#pragma unroll
    for (int i = 0; i < 2; ++i) { int R, C; stage_rc(tid * 16 + i * 8192, R, C); const int Rb = (R & ~31) + perm32(R & 31);
        voffA[i] = (unsigned)(R * g.lda + C) * 2u; voffB[i] = (unsigned)(Rb * g.ldb + C) * 2u; }
    const size_t kstep = (size_t)(BK * 2);
    const size_t hstepA = (size_t)HALF * g.lda * 2, hstepB = (size_t)HALF * g.ldb * 2;
    const unsigned ldsw = (unsigned)wid * 1024u;
    const int aoff = lds_byte(wr * 64 + fr, fq * 8), boff = lds_byte(wc * 32 + fr, fq * 8);
#define PG8_SA(b, h) (((b) * 2 + (h)) * HTB)
#define PG8_SB(b, h) ((4 + (b) * 2 + (h)) * HTB)
#define PG8_STAGE(bufoff, gbase, voff) do { _Pragma("unroll") for (int _i = 0; _i < 2; ++_i) \
        __builtin_amdgcn_global_load_lds((const unsigned*)((const char*)(gbase) + (voff)[_i]), (LAS unsigned*)(lds + (bufoff) + ldsw + _i * 8192), 16, 0, 0); } while (0)
#define PG8_LDA(dst, b, h) do { _Pragma("unroll") for (int m = 0; m < 4; ++m) _Pragma("unroll") for (int k = 0; k < 2; ++k) dst[m][k] = *(const LAS bf16x8*)(lds + PG8_SA(b, h) + aoff + m * 2048 + k * 1024); } while (0)
#define PG8_LDB(dst, b, h) do { _Pragma("unroll") for (int n = 0; n < 2; ++n) _Pragma("unroll") for (int k = 0; k < 2; ++k) dst[n][k] = *(const LAS bf16x8*)(lds + PG8_SB(b, h) + boff + n * 2048 + k * 1024); } while (0)
#define PG8_MMA(ai, bj, At, Bt) do { __builtin_amdgcn_s_setprio(1); _Pragma("unroll") for (int m = 0; m < 4; ++m) _Pragma("unroll") for (int n = 0; n < 2; ++n) _Pragma("unroll") for (int k = 0; k < 2; ++k) \
        acc[ai][bj][m][n] = __builtin_amdgcn_mfma_f32_16x16x32_bf16(Bt[n][k], At[m][k], acc[ai][bj][m][n], 0, 0, 0); __builtin_amdgcn_s_setprio(0); } while (0)
#define PG8_WAIT_V(n) asm volatile("s_waitcnt vmcnt(" #n ")" ::: "memory")
#define PG8_WAIT_L(n) asm volatile("s_waitcnt lgkmcnt(" #n ")" ::: "memory")
#define PG8_BAR __builtin_amdgcn_s_barrier()
#define PG8_SCHED __builtin_amdgcn_sched_barrier(0)
    Unit cur, nxt; int ui = 0;
    if (!S.next(0, cur)) return;
    f32x4 acc[2][2][4][2];
#pragma unroll
    for (int a = 0; a < 2; ++a)
#pragma unroll
        for (int b = 0; b < 2; ++b)
#pragma unroll
            for (int m = 0; m < 4; ++m)
#pragma unroll
                for (int n = 0; n < 2; ++n) acc[a][b][m][n] = (f32x4){0.f, 0.f, 0.f, 0.f};
    bf16x8 At[4][2], B0[2][2], B1[2][2];
    const char* cA = cur.a; const char* cB = cur.b;
    PG8_STAGE(PG8_SB(0, 0), cB, voffB); PG8_STAGE(PG8_SB(0, 1), cB + hstepB, voffB); PG8_STAGE(PG8_SA(0, 0), cA, voffA); PG8_STAGE(PG8_SA(0, 1), cA + hstepA, voffA);
    if (wr == 1) PG8_BAR;
    PG8_WAIT_V(2); PG8_BAR;
    PG8_STAGE(PG8_SB(1, 0), cB + kstep, voffB); PG8_STAGE(PG8_SA(1, 0), cA + kstep, voffA); PG8_STAGE(PG8_SB(1, 1), cB + hstepB + kstep, voffB);
    PG8_WAIT_V(6); PG8_BAR;
    for (;;) {
        const bool has_next = S.next(ui + 1, nxt);
        const char* nA = has_next ? nxt.a : cA; const char* nB = has_next ? nxt.b : cB;
        for (int t = 0; t < nt; t += 2) {
            const bool last = (t == nt - 2);
            const char* a1 = cA + (size_t)(t + 1) * kstep;
            const char* a2 = last ? nA : cA + (size_t)(t + 2) * kstep; const char* b2 = last ? nB : cB + (size_t)(t + 2) * kstep;
            const char* a3 = a2 + kstep; const char* b3 = b2 + kstep;
            PG8_LDB(B0, 0, 0); PG8_LDB(B1, 0, 1); PG8_SCHED; PG8_LDA(At, 0, 0); PG8_STAGE(PG8_SA(1, 1), a1 + hstepA, voffA);
            PG8_WAIT_V(8); PG8_WAIT_L(0); PG8_BAR; PG8_MMA(0, 0, At, B0); PG8_MMA(0, 1, At, B1); PG8_BAR; PG8_SCHED;
            PG8_LDA(At, 0, 1); PG8_STAGE(PG8_SB(0, 0), b2, voffB); PG8_STAGE(PG8_SB(0, 1), b2 + hstepB, voffB); PG8_STAGE(PG8_SA(0, 0), a2, voffA);
            PG8_WAIT_V(8); PG8_WAIT_L(0); PG8_BAR; PG8_MMA(1, 0, At, B0); PG8_MMA(1, 1, At, B1); PG8_BAR; PG8_SCHED;
            PG8_LDB(B0, 1, 0); PG8_LDB(B1, 1, 1); PG8_SCHED; PG8_LDA(At, 1, 0); PG8_STAGE(PG8_SA(0, 1), a2 + hstepA, voffA);
            PG8_WAIT_V(8); PG8_WAIT_L(0); PG8_BAR; PG8_MMA(0, 0, At, B0); PG8_MMA(0, 1, At, B1); PG8_BAR; PG8_SCHED;
            PG8_LDA(At, 1, 1); PG8_STAGE(PG8_SB(1, 0), b3, voffB); PG8_STAGE(PG8_SB(1, 1), b3 + hstepB, voffB); PG8_STAGE(PG8_SA(1, 0), a3, voffA);
            PG8_WAIT_V(8); PG8_WAIT_L(0); PG8_BAR; PG8_MMA(1, 0, At, B0); PG8_MMA(1, 1, At, B1); PG8_BAR; PG8_SCHED;
        }
        if (wr == 0) PG8_BAR;
        { unsigned ones = ~0u; asm volatile("" : "+s"(ones));
          const int ln = (int)__builtin_amdgcn_mbcnt_hi(ones, __builtin_amdgcn_mbcnt_lo(ones, 0u));
          E(acc, cur, wr, wc, ln & 15, ln >> 4, lds); }
        if (!has_next) break;
#pragma unroll
        for (int a = 0; a < 2; ++a)
#pragma unroll
            for (int b = 0; b < 2; ++b)
#pragma unroll
                for (int m = 0; m < 4; ++m)
#pragma unroll
                    for (int n = 0; n < 2; ++n) acc[a][b][m][n] = (f32x4){0.f, 0.f, 0.f, 0.f};
        cur = nxt; cA = nA; cB = nB; ++ui;
        if (wr == 1) PG8_BAR;
    }
    PG8_WAIT_V(0);
    PG8_BAR;
#undef PG8_SA
#undef PG8_SB
#undef PG8_STAGE
#undef PG8_LDA
#undef PG8_LDB
#undef PG8_MMA
#undef PG8_WAIT_V
#undef PG8_WAIT_L
#undef PG8_BAR
#undef PG8_SCHED
}

struct SchedMN {
    const char* A; const char* Bt; int lda, ldb, nM, nN, G, c, col_base;
    __device__ __forceinline__ bool next(int i, Unit& u) const {
        int pm, pn; if (!tile_of((long)i * G + c, nM, nN, pm, pn)) return false;
        u.a = A + (size_t)pm * BM * lda * 2; u.b = Bt + (size_t)pn * BM * ldb * 2; u.row0 = pm * BM; u.col0 = col_base + pn * BM; u.vlo = 0; u.vhi = 0x7fffffff; u.aux = pn; return true;
    }
};
struct SchedWKVW {
    const char* KMP; const char* KMS; const char* VMP; const char* VMS; const char* WQN; const char* WOT; int G, c, VW_ROW0;
    __device__ __forceinline__ bool next(int i, Unit& u) const {
        const int L = i * G + c; if (c < 0 || L >= 1536) return false;
        const int q = L < 768 ? L : L - 768, bb = q >> 4, h = (q >> 2) & 3, ch = q & 3;
        u.vlo = 0; u.vhi = 0x7fffffff; u.aux = 0; u.col0 = L < 768 ? ch * 256 : h * 256;
        if (L < 768) { const char* Km = bb < NB ? KMP + (size_t)bb * NMEM * D * 2 : KMS + (size_t)(bb - NB) * NMEM * D * 2;
            u.a = Km + h * 256 * 2; u.b = WQN + ((size_t)ch * 256 * D + h * 256) * 2; u.row0 = (bb * 4 + h) * 256; }
        else { const char* Vm = bb < NB ? VMP + (size_t)bb * NMEM * D * 2 : VMS + (size_t)(bb - NB) * NMEM * D * 2;
            u.a = WOT + ((size_t)ch * 256 * D + h * 256) * 2; u.b = Vm + h * 256 * 2; u.row0 = VW_ROW0 + bb * 1024 + ch * 256; }
        return true;
    }
};
template <int MODE> struct SchedCA2 {
    const char* A; const char* W; int G, c, VW_ROW0;
    __device__ __forceinline__ bool next(int i, Unit& u) const {
        const int L = i * G + c; if (L >= 1024 + 128) return false;
        int row0, bb, hp;
        if (L < 1024) { const int pm = L >> 2; hp = L & 3; row0 = pm * BM; bb = pm >> 4; u.vlo = 0; u.vhi = 0x7fffffff; }
        else { const int s = L - 1024, b = s >> 2; hp = s & 3; const int r = MP + DSEQ * b; row0 = r < M - BM ? r : M - BM; bb = NB + b; u.vlo = r; u.vhi = r + DSEQ; }
        u.a = A + (size_t)row0 * D * 2;
        u.b = W + (MODE == 0 ? (size_t)((bb * 4 + hp) * 256) : (size_t)(VW_ROW0 + bb * 1024 + hp * 256)) * D * 2;
        u.row0 = row0; u.col0 = hp * 256; u.aux = 0; return true;
    }
};

#define EPI_ARGS f32x4 (&acc)[2][2][4][2], const Unit& u, int wr, int wc, int fr, int fq, LAS unsigned char* lds
struct EpiBf16 {
    bf16_t* O; int ldc; float scale; const float* ss;
    __device__ __forceinline__ void operator()(EPI_ARGS) const {
        const int row0 = u.row0 + wr * 64 + fr, col0 = u.col0 + wc * 32 + 8 * fq;
#pragma unroll
        for (int ai = 0; ai < 2; ++ai)
#pragma unroll
            for (int m = 0; m < 4; ++m) { const int row = row0 + ai * HALF + m * 16; bf16_t* rowp = O + (size_t)row * ldc + col0;
                const float rs = ss ? scale * __builtin_amdgcn_rsqf(ss[row] * (1.f / D) + RMS_EPS) : scale;
                if (row >= u.vlo && row < u.vhi) {
#pragma unroll
                for (int bj = 0; bj < 2; ++bj) { const f32x4 v0 = acc[ai][bj][m][0] * rs, v1 = acc[ai][bj][m][1] * rs;
                    u32x4 w; w.x = pk_bf16(v0[0], v0[1]); w.y = pk_bf16(v0[2], v0[3]); w.z = pk_bf16(v1[0], v1[1]); w.w = pk_bf16(v1[2], v1[3]);
                    *(u32x4*)(rowp + bj * HALF) = w; } } }
    }
};
struct SchedSplitK {
    const char* A; const char* Bt; int G, c;
    __device__ __forceinline__ bool next(int i, Unit& u) const {
        const int L = i * G + c; if (L >= 352) return false;
        const int part = L >> 5, t = L & 31, pm = t >> 2, pn = t & 3;
        u.a = A + ((size_t)(MP + pm * BM) * FF + part * 256) * 2; u.b = Bt + ((size_t)(pn * BM) * FF + part * 256) * 2;
        u.row0 = part * MS + pm * BM; u.col0 = pn * BM; u.vlo = 0; u.vhi = 0x7fffffff; u.aux = part; return true;
    }
};
struct EpiQKV {
    bf16_t* Qb; size_t bstride; float* out; float qscale; const float* ss;
    __device__ __forceinline__ void operator()(EPI_ARGS) const {
        const int typ = u.aux >> 2, colt = (u.aux & 3) * BM + wc * 32 + 8 * fq, row0 = u.row0 + wr * 64 + fr;
        bf16_t* B = Qb + (size_t)typ * bstride;
        const bool samp = u.row0 >= MP;
        float* F = typ == 1 ? (samp ? out + OUT_KS - (size_t)MP * D : out + OUT_KP) : (samp ? out + OUT_VS - (size_t)MP * D : out + OUT_VP);
        const float sc = typ == 0 ? qscale : 1.f;
#pragma unroll
        for (int ai = 0; ai < 2; ++ai)
#pragma unroll
            for (int m = 0; m < 4; ++m) { const size_t off = (size_t)(row0 + ai * HALF + m * 16) * D + colt;
                const float rs = __builtin_amdgcn_rsqf(ss[row0 + ai * HALF + m * 16] * (1.f / D) + RMS_EPS);
#pragma unroll
                for (int bj = 0; bj < 2; ++bj) { const f32x4 v0 = acc[ai][bj][m][0] * rs, v1 = acc[ai][bj][m][1] * rs;
                    if (typ != 0) { *(f32x4*)(F + off + bj * HALF) = v0; *(f32x4*)(F + off + bj * HALF + 4) = v1; }
                    u32x4 w; w.x = pk_bf16(v0[0] * sc, v0[1] * sc); w.y = pk_bf16(v0[2] * sc, v0[3] * sc); w.z = pk_bf16(v1[0] * sc, v1[1] * sc); w.w = pk_bf16(v1[2] * sc, v1[3] * sc);
                    *(u32x4*)(B + off + bj * HALF) = w; } }
    }
};
template <bool SC> struct EpiResid {
    bf16_t* XB; float* ssn; const float* cscale; float alpha;
    __device__ __forceinline__ void operator()(EPI_ARGS) const {
        const int row0 = u.row0 + wr * 64 + fr, col0 = u.col0 + wc * 32 + 8 * fq;
        GAS bf16_t* base = (GAS bf16_t*)XB + (size_t)row0 * D + col0;
        u32x4 xo[2][4][2];
#pragma unroll
        for (int ai = 0; ai < 2; ++ai)
#pragma unroll
            for (int m = 0; m < 4; ++m)
#pragma unroll
                for (int bj = 0; bj < 2; ++bj) xo[ai][m][bj] = *(GAS u32x4*)(base + (size_t)(ai * HALF + m * 16) * D + bj * HALF);
        float q[2][4];
#pragma unroll
        for (int ai = 0; ai < 2; ++ai)
#pragma unroll
            for (int m = 0; m < 4; ++m) q[ai][m] = 0.f;
#pragma unroll
        for (int bj = 0; bj < 2; ++bj) {
            const float al = alpha; const f32x4 ones = {1.f, 1.f, 1.f, 1.f};
            const f32x4 sc0 = (SC ? *(const GAS f32x4*)(cscale + col0 + bj * HALF) : ones) * al, sc1 = (SC ? *(const GAS f32x4*)(cscale + col0 + bj * HALF + 4) : ones) * al;
#pragma unroll
            for (int ai = 0; ai < 2; ++ai)
#pragma unroll
                for (int m = 0; m < 4; ++m) { const u32x4 o = xo[ai][m][bj]; const f32x4 d0 = acc[ai][bj][m][0] * sc0, d1 = acc[ai][bj][m][1] * sc1;
                    u32x4 w; w.x = pk_bf16(bf_lo(o.x) + d0[0], bf_hi(o.x) + d0[1]); w.y = pk_bf16(bf_lo(o.y) + d0[2], bf_hi(o.y) + d0[3]); w.z = pk_bf16(bf_lo(o.z) + d1[0], bf_hi(o.z) + d1[1]); w.w = pk_bf16(bf_lo(o.w) + d1[2], bf_hi(o.w) + d1[3]);
                    const int row = row0 + ai * HALF + m * 16;
                    if (row >= u.vlo && row < u.vhi) *(GAS u32x4*)(base + (size_t)(ai * HALF + m * 16) * D + bj * HALF) = w;
                    q[ai][m] += (bf_lo(w.x) * bf_lo(w.x) + bf_hi(w.x) * bf_hi(w.x)) + (bf_lo(w.y) * bf_lo(w.y) + bf_hi(w.y) * bf_hi(w.y)) + (bf_lo(w.z) * bf_lo(w.z) + bf_hi(w.z) * bf_hi(w.z)) + (bf_lo(w.w) * bf_lo(w.w) + bf_hi(w.w) * bf_hi(w.w)); }
        }
#pragma unroll
        for (int ai = 0; ai < 2; ++ai)
#pragma unroll
            for (int m = 0; m < 4; ++m) { float t = q[ai][m]; t += shx(t, 16, fq * 16 + fr); t += shx(t, 32, fq * 16 + fr);
                const int row = row0 + ai * HALF + m * 16;
                if (fq == 0 && alpha != 0.f && row >= u.vlo && row < u.vhi) __builtin_amdgcn_global_atomic_fadd_f32((GAS float*)ssn + row, t); }
    }
};
struct EpiMemK {
    float* F; bf16_t* B;
    __device__ __forceinline__ void operator()(EPI_ARGS) const {
        const int row0 = u.row0 + wr * 64 + fr, col0 = u.col0 + wc * 32 + 8 * fq;
#pragma unroll
        for (int ai = 0; ai < 2; ++ai)
#pragma unroll
            for (int m = 0; m < 4; ++m) { const size_t off = (size_t)(row0 + ai * HALF + m * 16) * D + col0;
#pragma unroll
                for (int bj = 0; bj < 2; ++bj) { const f32x4 v0 = acc[ai][bj][m][0], v1 = acc[ai][bj][m][1];
                    *(f32x4*)(F + off + bj * HALF) = v0; *(f32x4*)(F + off + bj * HALF + 4) = v1;
                    u32x4 w; w.x = pk_bf16(v0[0], v0[1]); w.y = pk_bf16(v0[2], v0[3]); w.z = pk_bf16(v1[0], v1[1]); w.w = pk_bf16(v1[2], v1[3]);
                    *(u32x4*)(B + off + bj * HALF) = w; } }
    }
};
__device__ __forceinline__ float dpp_ror1(float v) { return __int_as_float(__builtin_amdgcn_update_dpp(0, __float_as_int(v), 0x121, 0xf, 0xf, false)); }
__device__ __forceinline__ float dpp_ror2(float v) { return __int_as_float(__builtin_amdgcn_update_dpp(0, __float_as_int(v), 0x122, 0xf, 0xf, false)); }
__device__ __forceinline__ f32x4 ror1(const f32x4 v) { return (f32x4){dpp_ror1(v[0]), dpp_ror1(v[1]), dpp_ror1(v[2]), dpp_ror1(v[3])}; }
__device__ __forceinline__ f32x4 ror2(const f32x4 v) { return (f32x4){dpp_ror2(v[0]), dpp_ror2(v[1]), dpp_ror2(v[2]), dpp_ror2(v[3])}; }
__device__ __forceinline__ f32x4 sel4(bool c, const f32x4 a, const f32x4 b) { return (f32x4){c ? a[0] : b[0], c ? a[1] : b[1], c ? a[2] : b[2], c ? a[3] : b[3]}; }
typedef __bf16 bf2v_t __attribute__((ext_vector_type(2)));
__device__ __forceinline__ float dot2bf(unsigned x, unsigned w, float c) { return __builtin_amdgcn_fdot2_f32_bf16(__builtin_bit_cast(bf2v_t, x), __builtin_bit_cast(bf2v_t, w), c, false); }
struct EpiUpGate {
    bf16_t* A2; const float* cw; const float* cb; const float* sfs; float* fsp; float* fss; float* edge; float* first; int xoff; const float* ss;
    __device__ __forceinline__ void operator()(EPI_ARGS) const {
#pragma unroll
        for (int ai = 0; ai < 2; ++ai)
#pragma unroll
            for (int m = 0; m < 4; ++m) { const float rs = __builtin_amdgcn_rsqf(ss[u.row0 + ai * HALF + wr * 64 + m * 16 + fr] * (1.f / D) + RMS_EPS);
#pragma unroll
                for (int bj = 0; bj < 2; ++bj) { acc[ai][bj][m][0] = acc[ai][bj][m][0] * rs; acc[ai][bj][m][1] = acc[ai][bj][m][1] * rs; } }
        LAS float* X = (LAS float*)(lds + xoff);
        const int pn = u.col0 >> 8, pm = u.row0 >> 8, cl = wc * 32 + 8 * fq, ch = pn * 128 + cl;
        const bool samp = u.row0 >= MP;
        if (fr >= 14) {
#pragma unroll
            for (int ai = 0; ai < 2; ++ai) {
#pragma unroll
                for (int bj = 0; bj < 2; ++bj)
#pragma unroll
                    for (int n = 0; n < 2; ++n) *(LAS f32x4*)(X + ((ai * 2 + wr) * 2 + (fr - 14)) * 256 + bj * HALF + cl + 4 * n) = acc[ai][bj][3][n];
                const bool is_state = samp || (ai == 1 && wr == 1 && (pm & 15) == 15);
                if (is_state) {
                    float* st = samp ? fss + ((size_t)((u.row0 + ai * HALF + wr * 64 - MP) >> 6) * 2 + (fr - 14)) * FF2 : fsp + ((size_t)(pm >> 4) * 2 + (fr - 14)) * FF2;
#pragma unroll
                    for (int bj = 0; bj < 2; ++bj) { float* sp = st + bj * FF + ch; *(f32x4*)sp = acc[ai][bj][3][0]; *(f32x4*)(sp + 4) = acc[ai][bj][3][1]; } }
                asm volatile("" ::: "memory");
            }
            if (wr == 1) {
#pragma unroll
                for (int bj = 0; bj < 2; ++bj)
#pragma unroll
                    for (int n = 0; n < 2; ++n) *(f32x4*)(edge + ((size_t)pm * 2 + (fr - 14)) * FF2 + u.col0 + bj * HALF + cl + 4 * n) = acc[1][bj][3][n];
            }
        }
        if (wr == 0 && fr < 2) {
#pragma unroll
            for (int bj = 0; bj < 2; ++bj)
#pragma unroll
                for (int n = 0; n < 2; ++n) *(f32x4*)(first + ((size_t)pm * 2 + fr) * FF2 + u.col0 + bj * HALF + cl + 4 * n) = acc[0][bj][0][n];
        }
        unsigned P[2][2][4][4];
#pragma unroll
        for (int ai = 0; ai < 2; ++ai)
#pragma unroll
            for (int bj = 0; bj < 2; ++bj)
#pragma unroll
                for (int m = 0; m < 4; ++m)
#pragma unroll
                    for (int n = 0; n < 2; ++n) { const f32x4 v = acc[ai][bj][m][n];
                        asm volatile("v_cvt_pk_bf16_f32 %0, %1, %2" : "=v"(P[ai][bj][m][2 * n]) : "v"(v[0]), "v"(v[1])); asm volatile("v_cvt_pk_bf16_f32 %0, %1, %2" : "=v"(P[ai][bj][m][2 * n + 1]) : "v"(v[2]), "v"(v[3])); }
        f32x4 WG[3][2], WV[3][2], BG[2], BV[2];
#pragma unroll
        for (int n = 0; n < 2; ++n) {
#pragma unroll
            for (int j = 0; j < 3; ++j) { WG[j][n] = *(const GAS f32x4*)(cw + (size_t)j * FF2 + ch + 4 * n); WV[j][n] = *(const GAS f32x4*)(cw + (size_t)j * FF2 + FF + ch + 4 * n); }
            BG[n] = *(const GAS f32x4*)(cb + ch + 4 * n); BV[n] = *(const GAS f32x4*)(cb + FF + ch + 4 * n); }
        unsigned TG[3][4][2], TV[3][4][2];
#pragma unroll
        for (int j = 0; j < 3; ++j)
#pragma unroll
            for (int q = 0; q < 4; ++q) { TG[j][q][0] = pk_bf16(WG[j][q >> 1][2 * (q & 1)] * -LOG2E, 0.f); TG[j][q][1] = pk_bf16(0.f, WG[j][q >> 1][2 * (q & 1) + 1] * -LOG2E);
                TV[j][q][0] = pk_bf16(WV[j][q >> 1][2 * (q & 1)] * (-1.f / LOG2E), 0.f); TV[j][q][1] = pk_bf16(0.f, WV[j][q >> 1][2 * (q & 1) + 1] * (-1.f / LOG2E)); }
#pragma unroll
        for (int n = 0; n < 2; ++n) { BG[n] = BG[n] * -LOG2E; BV[n] = BV[n] * (-1.f / LOG2E); }
        asm volatile("s_waitcnt lgkmcnt(0)" ::: "memory"); __builtin_amdgcn_s_barrier(); asm volatile("" ::: "memory");
        const bool f0 = fr == 0, f01 = fr < 2;
#pragma unroll
        for (int ai = 0; ai < 2; ++ai) {
            const int brow0 = u.row0 + ai * HALF + wr * 64;
            const int sb = samp ? ((brow0 - MP) >> 6) : 0, pred = (ai * 2 + wr) > 0 ? (ai * 2 + wr - 1) : 0;
            const bool use_x = !samp && (brow0 & (SEQ - 1)) != 0 && (ai | wr) != 0;
            const int hsel = fr >= 14 ? fr - 14 : 0;
            unsigned pk[4][4];
#pragma unroll
            for (int q = 0; q < 4; ++q) {
                const int c2 = ch + 2 * q;
                const f32x2_t bg = {BG[q >> 1][2 * (q & 1)], BG[q >> 1][2 * (q & 1) + 1]}, bv = {BV[q >> 1][2 * (q & 1)], BV[q >> 1][2 * (q & 1) + 1]};
                const LAS float* xp = X + (pred * 2 + hsel) * 256 + cl + 2 * q;
                const f32x2_t xgv = *(const LAS f32x2_t*)xp, xvv = *(const LAS f32x2_t*)(xp + HALF);
                unsigned hg = use_x ? pk_bf16(xgv.x, xgv.y) : 0u, hv = use_x ? pk_bf16(xvv.x, xvv.y) : 0u;
                if (samp) { const float* sp = sfs + ((size_t)sb * 2 + hsel) * FF2 + c2; const f32x2_t sgv = *(const GAS f32x2_t*)sp, svv = *(const GAS f32x2_t*)(sp + FF); hg = pk_bf16(sgv.x, sgv.y); hv = pk_bf16(svv.x, svv.y); }
                unsigned rg1 = __builtin_amdgcn_mov_dpp(hg, 0x121, 0xf, 0xf, false), rg2 = __builtin_amdgcn_mov_dpp(hg, 0x122, 0xf, 0xf, false);
                unsigned rv1 = __builtin_amdgcn_mov_dpp(hv, 0x121, 0xf, 0xf, false), rv2 = __builtin_amdgcn_mov_dpp(hv, 0x122, 0xf, 0xf, false);
#pragma unroll
                for (int m = 0; m < 4; ++m) {
                    const unsigned ug = P[ai][0][m][q], uv = P[ai][1][m][q];
                    const unsigned cg1 = __builtin_amdgcn_mov_dpp(ug, 0x121, 0xf, 0xf, false), cg2 = __builtin_amdgcn_mov_dpp(ug, 0x122, 0xf, 0xf, false);
                    const unsigned cv1 = __builtin_amdgcn_mov_dpp(uv, 0x121, 0xf, 0xf, false), cv2 = __builtin_amdgcn_mov_dpp(uv, 0x122, 0xf, 0xf, false);
                    const unsigned g1 = f0 ? rg1 : cg1, g2 = f01 ? rg2 : cg2, v1 = f0 ? rv1 : cv1, v2 = f01 ? rv2 : cv2;
                    const float ga = dot2bf(ug, TG[2][q][0], dot2bf(g1, TG[1][q][0], dot2bf(g2, TG[0][q][0], bg.x))), gb = dot2bf(ug, TG[2][q][1], dot2bf(g1, TG[1][q][1], dot2bf(g2, TG[0][q][1], bg.y)));
                    const float va = dot2bf(uv, TV[2][q][0], dot2bf(v1, TV[1][q][0], dot2bf(v2, TV[0][q][0], bv.x))), vb = dot2bf(uv, TV[2][q][1], dot2bf(v1, TV[1][q][1], dot2bf(v2, TV[0][q][1], bv.y)));
                    const f32x2_t G = {ga, gb}, V = {va, vb}, Eo = (f32x2_t){__builtin_amdgcn_exp2f(ga), __builtin_amdgcn_exp2f(gb)} + (f32x2_t){1.f, 1.f};
                    const f32x2_t Y = G * V * (f32x2_t){__builtin_amdgcn_rcpf(Eo.x), __builtin_amdgcn_rcpf(Eo.y)};
                    pk[m][q] = pk_bf16(Y.x, Y.y);
                    rg1 = cg1; rg2 = cg2; rv1 = cv1; rv2 = cv2;
                }
            }
#pragma unroll
            for (int m = 0; m < 4; ++m) { u32x4 w; w.x = pk[m][0]; w.y = pk[m][1]; w.z = pk[m][2]; w.w = pk[m][3];
                *(u32x4*)(A2 + (size_t)(brow0 + m * 16 + fr) * FF + ch) = w; }
            asm volatile("" ::: "memory");
        }
    }
};
struct EpiSoftmax {
    bf16_t* P; int xoff; const float* ss; float scale;
    __device__ __forceinline__ void operator()(EPI_ARGS) const {
        LAS f32x2_t* X = (LAS f32x2_t*)(lds + xoff);
#pragma unroll
        for (int ai = 0; ai < 2; ++ai)
#pragma unroll
            for (int m = 0; m < 4; ++m) { const float rs = scale * __builtin_amdgcn_rsqf(ss[u.row0 + ai * HALF + wr * 64 + m * 16 + fr] * (1.f / D) + RMS_EPS);
#pragma unroll
                for (int bj = 0; bj < 2; ++bj) { acc[ai][bj][m][0] = acc[ai][bj][m][0] * rs; acc[ai][bj][m][1] = acc[ai][bj][m][1] * rs; } }
        float mw[2][4];
#pragma unroll
        for (int ai = 0; ai < 2; ++ai)
#pragma unroll
            for (int m = 0; m < 4; ++m) {
                float mx = -3.0e38f;
#pragma unroll
                for (int bj = 0; bj < 2; ++bj)
#pragma unroll
                    for (int n = 0; n < 2; ++n) { const f32x4 x = acc[ai][bj][m][n]; mx = fmaxf(mx, fmaxf(fmaxf(x[0], x[1]), fmaxf(x[2], x[3]))); }
                mx = fmaxf(mx, shx(mx, 16, fq * 16 + fr)); mx = fmaxf(mx, shx(mx, 32, fq * 16 + fr));
                float s = 0.f;
#pragma unroll
                for (int bj = 0; bj < 2; ++bj)
#pragma unroll
                    for (int n = 0; n < 2; ++n) { f32x4 x = acc[ai][bj][m][n];
#pragma unroll
                        for (int e = 0; e < 4; ++e) { x[e] = __builtin_amdgcn_exp2f(x[e] - mx); s += x[e]; } acc[ai][bj][m][n] = x; }
                s += shx(s, 16, fq * 16 + fr); s += shx(s, 32, fq * 16 + fr);
                mw[ai][m] = mx;
                if (fq == 0) X[(ai * HALF + wr * 64 + m * 16 + fr) * 4 + wc] = (f32x2_t){mx, s};
            }
        asm volatile("s_waitcnt lgkmcnt(0)" ::: "memory"); __builtin_amdgcn_s_barrier(); asm volatile("" ::: "memory");
        const int row0 = u.row0 + wr * 64 + fr, col0 = u.col0 + wc * 32 + 8 * fq;
#pragma unroll
        for (int ai = 0; ai < 2; ++ai)
#pragma unroll
            for (int m = 0; m < 4; ++m) { const int rl = ai * HALF + wr * 64 + m * 16 + fr;
                const f32x2_t a = X[rl * 4 + 0], b = X[rl * 4 + 1], c = X[rl * 4 + 2], d = X[rl * 4 + 3];
                const float mt = fmaxf(fmaxf(a.x, b.x), fmaxf(c.x, d.x));
                const float L = a.y * __builtin_amdgcn_exp2f(a.x - mt) + b.y * __builtin_amdgcn_exp2f(b.x - mt) + c.y * __builtin_amdgcn_exp2f(c.x - mt) + d.y * __builtin_amdgcn_exp2f(d.x - mt);
                const float f = __builtin_amdgcn_exp2f(mw[ai][m] - mt) / L;
                const int row = row0 + ai * HALF + m * 16;
                if (row >= u.vlo && row < u.vhi) {
#pragma unroll
                for (int bj = 0; bj < 2; ++bj) { const f32x4 v0 = acc[ai][bj][m][0] * f, v1 = acc[ai][bj][m][1] * f;
                    u32x4 w; w.x = pk_bf16(v0[0], v0[1]); w.y = pk_bf16(v0[2], v0[3]); w.z = pk_bf16(v1[0], v1[1]); w.w = pk_bf16(v1[2], v1[3]);
                    *(u32x4*)(P + (size_t)row * D + col0 + bj * HALF) = w; } } }
    }
};
struct SchedQKV {
    const char* A; const char* Bt; int nM, G, c;
    __device__ __forceinline__ bool next(int i, Unit& u) const {
        int pm, pj; if (!tile_of((long)i * G + c, nM, 12, pm, pj)) return false;
        const int pn = (pj % 3) * 4 + pj / 3;
        u.a = A + (size_t)pm * BM * D * 2; u.b = Bt + (size_t)pn * BM * D * 2; u.row0 = pm * BM; u.col0 = pn * BM; u.vlo = 0; u.vhi = 0x7fffffff; u.aux = pn; return true;
    }
};
struct SchedPool { const char* A; const char* Bt; int G, c;
    __device__ __forceinline__ bool next(int i, Unit& u) const { int pm, pn; if (!tile_of((long)i * G + c, M / 256, 4, pm, pn)) return false;
        u.a = A + ((size_t)pm * 256 * D + pn * 256) * 2; u.b = Bt + (size_t)pn * 65536 * 2; u.row0 = pm * 256; u.col0 = pn * 256; u.vlo = 0; u.vhi = 0x7fffffff; u.aux = 0; return true; } };
}

namespace sba {
constexpr float QSCALE = 0.125f * LOG2E;
constexpr float EXIT_T = 126.f;
constexpr int VDH = 4160, KIMG = 2 * VDH, KROW = 144, WAVE_LDS = KIMG + 64 * KROW;
__device__ __forceinline__ int crow(int r, int hi) { return (r & 3) + 8 * (r >> 2) + 4 * hi; }
__device__ __forceinline__ s16x4 vtr(LAS const char* p) { typedef short v4i16_t __attribute__((ext_vector_type(4))); return __builtin_bit_cast(s16x4, __builtin_amdgcn_ds_read_tr16_b64_v4i16((LAS v4i16_t*)p)); }

__device__ __forceinline__ bf16x8 cvt8(const f32x4 a, const f32x4 b) { u32x4 w; w.x = pk_bf16(a[0], a[1]); w.y = pk_bf16(a[2], a[3]); w.z = pk_bf16(b[0], b[1]); w.w = pk_bf16(b[2], b[3]); return __builtin_bit_cast(bf16x8, w); }
__device__ __forceinline__ void load_bf16(const bf16_t* Kt, const bf16_t* Vt, LAS char* vimg, int lane) {
    const int c = lane & 7;
    LAS char* vdst = vimg + (c >> 2) * VDH + (lane >> 3) * 64 + (c & 3) * 16; LAS char* kdst = vimg + KIMG + (lane >> 3) * KROW + c * 16;
    const unsigned vvo = (unsigned)((lane >> 3) * D + 8 * c) * 2u;
#pragma unroll
    for (int it = 0; it < 8; ++it) { const u32x4 v = *(const GAS u32x4*)((const GAS char*)Vt + (size_t)it * 8 * D * 2 + vvo); *(LAS u32x4*)(vdst + it * 512) = v; }
#pragma unroll
    for (int it = 0; it < 8; ++it) { const u32x4 v = *(const GAS u32x4*)((const GAS char*)Kt + (size_t)it * 8 * D * 2 + vvo); *(LAS u32x4*)(kdst + it * 8 * KROW) = v; }
}
__device__ __forceinline__ void load_f32(const float* Kt, const float* Vt, LAS char* vimg, int lane) {
    const int c = lane & 7;
    LAS char* vdst = vimg + (c >> 2) * VDH + (lane >> 3) * 64 + (c & 3) * 16; LAS char* kdst = vimg + KIMG + (lane >> 3) * KROW + c * 16;
    const unsigned vvo = (unsigned)((lane >> 3) * D + 8 * c) * 4u;
#pragma unroll
    for (int hv = 0; hv < 2; ++hv) {
#pragma unroll
        for (int it = 4 * hv; it < 4 * hv + 4; ++it) { const GAS f32x4* p = (const GAS f32x4*)((const GAS char*)Vt + (size_t)it * 8 * D * 4 + vvo); *(LAS u32x4*)(vdst + it * 512) = __builtin_bit_cast(u32x4, cvt8(p[0], p[1])); }
        asm volatile("" ::: "memory"); }
#pragma unroll
    for (int hv = 0; hv < 2; ++hv) {
#pragma unroll
        for (int it = 4 * hv; it < 4 * hv + 4; ++it) { const GAS f32x4* p = (const GAS f32x4*)((const GAS char*)Kt + (size_t)it * 8 * D * 4 + vvo); *(LAS u32x4*)(kdst + it * 8 * KROW) = __builtin_bit_cast(u32x4, cvt8(p[0], p[1])); }
        asm volatile("" ::: "memory"); }
}
__device__ __forceinline__ void load_bf16_regs(u32x4 (&kr)[8], u32x4 (&vr)[8], const bf16_t* Kt, const bf16_t* Vt, int lane) {
    const unsigned vvo = (unsigned)((lane >> 3) * D + 8 * (lane & 7)) * 2u;
#pragma unroll
    for (int it = 0; it < 8; ++it) vr[it] = *(const GAS u32x4*)((const GAS char*)Vt + (size_t)it * 8 * D * 2 + vvo);
#pragma unroll
    for (int it = 0; it < 8; ++it) kr[it] = *(const GAS u32x4*)((const GAS char*)Kt + (size_t)it * 8 * D * 2 + vvo);
}
template <bool PF>
__device__ __forceinline__ void tile_step(u32x4 (&kr)[8], u32x4 (&vr)[8], const bf16x8 (&qr)[4], f32x16 (&o)[2], float& carry, bool masked, bool upper_dead, int tq, LAS char* vimg, int lane, const bf16_t* nK, const bf16_t* nV, bool do_pf) {
    const int hi = lane >> 5;
    if (PF) { const int c = lane & 7; LAS char* vdst = vimg + (c >> 2) * VDH + (lane >> 3) * 64 + (c & 3) * 16; LAS char* kdst = vimg + KIMG + (lane >> 3) * KROW + c * 16;
#pragma unroll
        for (int it = 0; it < 8; ++it) *(LAS u32x4*)(kdst + it * 8 * KROW) = kr[it];
#pragma unroll
        for (int it = 0; it < 8; ++it) *(LAS u32x4*)(vdst + it * 512) = vr[it]; }
    asm volatile("s_waitcnt lgkmcnt(0)" ::: "memory");
    bf16x8 kf[8];
    { LAS const char* kb = vimg + KIMG + (lane & 31) * KROW + hi * 16;
#pragma unroll
      for (int hf = 0; hf < 2; ++hf)
#pragma unroll
          for (int d0 = 0; d0 < 4; ++d0) kf[hf * 4 + d0] = *(LAS const bf16x8*)(kb + hf * 32 * KROW + d0 * 32); }
    f32x16 p0 = {}, p1 = {};
#pragma unroll
    for (int d0 = 0; d0 < 4; ++d0) p0 = __builtin_amdgcn_mfma_f32_32x32x16_bf16(kf[d0], qr[d0], p0, 0, 0, 0);
    if (!upper_dead) {
#pragma unroll
        for (int d0 = 0; d0 < 4; ++d0) p1 = __builtin_amdgcn_mfma_f32_32x32x16_bf16(kf[4 + d0], qr[d0], p1, 0, 0, 0);
    }
    if (PF && do_pf) { load_bf16_regs(kr, vr, nK, nV, lane); }
    float k0[16], k1[16];
#pragma unroll
    for (int r = 0; r < 16; ++r) {
        const float z = __builtin_amdgcn_fmed3f(p0[r], -100.f, 100.f); const float e = __builtin_amdgcn_exp2f(-z); float sg = __builtin_amdgcn_rcpf(1.f + e); float kp = e * sg;
        if (masked && !(crow(r, hi) < tq)) { sg = 0.f; kp = 1.f; } p0[r] = sg; k0[r] = kp; }
    if (!upper_dead) {
#pragma unroll
        for (int r = 0; r < 16; ++r) {
            const float z = __builtin_amdgcn_fmed3f(p1[r], -100.f, 100.f); const float e = __builtin_amdgcn_exp2f(-z); float sg = __builtin_amdgcn_rcpf(1.f + e); float kp = e * sg;
            if (masked && !(crow(r, hi) + 32 < tq)) { sg = 0.f; kp = 1.f; } p1[r] = sg; k1[r] = kp; }
    } else {
#pragma unroll
        for (int r = 0; r < 16; ++r) { p1[r] = 0.f; k1[r] = 1.f; }
    }
    float Glo[8], Ghi[8];
#pragma unroll
    for (int a = 0; a < 8; ++a) { const float* kk = a < 4 ? k0 + 4 * a : k1 + 4 * (a - 4); const float g = (kk[0] * kk[1]) * (kk[2] * kk[3]);
        auto rr = __builtin_amdgcn_permlane32_swap(__float_as_uint(g), __float_as_uint(g), false, false); Glo[a] = __uint_as_float(rr[0]); Ghi[a] = __uint_as_float(rr[1]); }
    float sx = __builtin_amdgcn_exp2f(-carry);
#pragma unroll
    for (int a = 7; a >= 0; --a) {
        const float base = hi == 0 ? sx * Ghi[a] : sx;
        if (a >= 4) { const int q = 4 * (a - 4);
            const float s3 = base, s2 = s3 * k1[q + 3], s1 = s2 * k1[q + 2], s0 = s1 * k1[q + 1];
            p1[q + 3] *= s3; p1[q + 2] *= s2; p1[q + 1] *= s1; p1[q] *= s0;
        } else { const int q = 4 * a;
            const float s3 = base, s2 = s3 * k0[q + 3], s1 = s2 * k0[q + 2], s0 = s1 * k0[q + 1];
            p0[q + 3] *= s3; p0[q + 2] *= s2; p0[q + 1] *= s1; p0[q] *= s0;
        }
        sx *= Glo[a] * Ghi[a];
    }
    carry = -__builtin_amdgcn_logf(sx);
    bf16x8 pf[4];
#pragma unroll
    for (int s = 0; s < 4; ++s) { const f32x16& p = s < 2 ? p0 : p1; const int q = 8 * (s & 1);
        u32x4 w; w.x = pk_bf16(p[q], p[q + 1]); w.y = pk_bf16(p[q + 2], p[q + 3]); w.z = pk_bf16(p[q + 4], p[q + 5]); w.w = pk_bf16(p[q + 6], p[q + 7]); pf[s] = __builtin_bit_cast(bf16x8, w); }
    LAS const char* vb = vimg + (4 * hi + ((lane & 15) >> 2)) * 64 + ((lane >> 4) & 1) * 32 + (lane & 3) * 8;
#pragma unroll
    for (int dh = 0; dh < 2; ++dh) {
#pragma unroll
        for (int s = 0; s < 2; ++s) { const s16x4 lo = vtr(vb + dh * VDH + s * 1024), hh = vtr(vb + dh * VDH + s * 1024 + 512);
            const bf16x8 vf = (bf16x8){lo[0], lo[1], lo[2], lo[3], hh[0], hh[1], hh[2], hh[3]};
            o[dh] = __builtin_amdgcn_mfma_f32_32x32x16_bf16(vf, pf[s], o[dh], 0, 0, 0); }
        if (!upper_dead) {
#pragma unroll
            for (int s = 2; s < 4; ++s) { const s16x4 lo = vtr(vb + dh * VDH + s * 1024), hh = vtr(vb + dh * VDH + s * 1024 + 512);
                const bf16x8 vf = (bf16x8){lo[0], lo[1], lo[2], lo[3], hh[0], hh[1], hh[2], hh[3]};
                o[dh] = __builtin_amdgcn_mfma_f32_32x32x16_bf16(vf, pf[s], o[dh], 0, 0, 0); }
        }
    }
    asm volatile("s_waitcnt lgkmcnt(0)" ::: "memory");
}

struct Tensors { const bf16_t* Q; const bf16_t* K; const bf16_t* V; bf16_t* O; const float* cK; const float* cV; };

__device__ __forceinline__ void unit(int id, const Tensors& T, LAS char* vimg, int lane) {
    const int r32 = lane & 31, hi = lane >> 5;
    const bool samp = id >= 32768;
    int h, q0; size_t rowb; int b = 0;
    if (!samp) { const int qb = id & 127; h = (id >> 7) & 15; b = id >> 11; rowb = (size_t)b * SEQ; q0 = qb * 32; }
    else { const int s = id - 32768; const int qb = s & 1; h = (s >> 1) & 15; b = s >> 5; rowb = (size_t)MP + (size_t)b * DSEQ; q0 = qb * 32; }
    const bf16_t* Qw = T.Q + (rowb + q0) * D + h * 64; bf16_t* Ow = T.O + (rowb + q0) * D + h * 64;
    asm volatile("" : "+s"(Qw), "+s"(Ow));
    bf16x8 qr[4];
#pragma unroll
    for (int d0 = 0; d0 < 4; ++d0) qr[d0] = *(const GAS bf16x8*)((const GAS char*)Qw + 32 * d0 + (unsigned)(r32 * D + 8 * hi) * 2u);
    f32x16 o[2]; o[0] = f32x16{}; o[1] = f32x16{};
    float carry = 0.f;
    const bf16_t* Kh = T.K + rowb * D + h * 64; const bf16_t* Vh = T.V + rowb * D + h * 64;
    asm volatile("" : "+s"(Kh), "+s"(Vh));
    u32x4 kr[8], vr[8];
    int kt = q0 >> 6;
    if (!samp) {
        int k0 = q0 >= 32 ? q0 - 32 : 0;
        load_bf16_regs(kr, vr, Kh + (size_t)k0 * D, Vh + (size_t)k0 * D, lane);
        { const int kn = k0 >= 64 ? k0 - 64 : 0;
          tile_step<true>(kr, vr, qr, o, carry, true, q0 < 32, q0 + r32 - k0, vimg, lane, Kh + (size_t)kn * D, Vh + (size_t)kn * D, k0 > 0); }
        while (k0 > 0) {
            if (__all(carry > EXIT_T)) break;
            const int prev = k0; k0 = prev >= 64 ? prev - 64 : 0;
            const int kn = k0 >= 64 ? k0 - 64 : 0; const bool clamp = prev < 64;
            tile_step<true>(kr, vr, qr, o, carry, clamp, clamp && prev <= 32, prev - k0, vimg, lane, Kh + (size_t)kn * D, Vh + (size_t)kn * D, k0 > 0);
        }
    } else {
        load_bf16(Kh + (size_t)kt * 64 * D, Vh + (size_t)kt * 64 * D, vimg, lane);
        tile_step<false>(kr, vr, qr, o, carry, true, (q0 & 32) == 0, q0 + r32 - 64 * kt, vimg, lane, nullptr, nullptr, false);
        const float* cKh = T.cK + (size_t)b * PAST * D + h * 64; const float* cVh = T.cV + (size_t)b * PAST * D + h * 64;
        asm volatile("" : "+s"(cKh), "+s"(cVh));
        for (kt = PAST / 64 - 1; kt >= 0; --kt) {
            if (__all(carry > EXIT_T)) break;
            load_f32(cKh + (size_t)kt * 64 * D, cVh + (size_t)kt * 64 * D, vimg, lane);
            tile_step<false>(kr, vr, qr, o, carry, false, false, 64, vimg, lane, nullptr, nullptr, false);
        }
    }
#pragma unroll
    for (int dh = 0; dh < 2; ++dh)
#pragma unroll
        for (int a = 0; a < 4; ++a) { u32x2 w; w.x = pk_bf16(o[dh][4 * a], o[dh][4 * a + 1]); w.y = pk_bf16(o[dh][4 * a + 2], o[dh][4 * a + 3]);
            *(LAS u32x2*)(vimg + r32 * 144 + (32 * dh + 8 * a + 4 * hi) * 2) = w; }
    asm volatile("s_waitcnt lgkmcnt(0)" ::: "memory");
#pragma unroll
    for (int i = 0; i < 4; ++i) { const int row = i * 8 + (lane >> 3), ch = lane & 7; const u32x4 v = *(LAS const u32x4*)(vimg + row * 144 + ch * 16); *(GAS u32x4*)((GAS char*)Ow + (unsigned)(row * D + ch * 8) * 2u) = v; }
    asm volatile("s_waitcnt lgkmcnt(0)" ::: "memory");
}
}

constexpr int NWAVES = 8;
constexpr int RING_OFF = 0, RING_BYTES = 131072, XCH_OFF = RING_BYTES, XCH_BYTES = 8192, MISC_OFF = 143360, TICKET_OFF = MISC_OFF + 256, LDS_BYTES = 147456;
static_assert(sba::WAVE_LDS * NWAVES <= MISC_OFF && XCH_OFF + XCH_BYTES <= MISC_OFF && TICKET_OFF + 64 <= LDS_BYTES, "LDS map");

#define XB_TMO      128
#define XB_XCNT(j)  (256  + 64 * (j))
#define XB_XSUB(j)  (1280 + 64 * (j))
#define XB_XGEN(j)  (2304 + 64 * (j))
#define XB_TOP      3328
#define XB_TOPGEN   3392
#define XCD_BAR_WORDS 3456
#define XB_SPIN_CAP (1u << 18)
__device__ __forceinline__ unsigned xb_ld(unsigned* p)              { return __hip_atomic_load(p, __ATOMIC_RELAXED, __HIP_MEMORY_SCOPE_AGENT); }
__device__ __forceinline__ unsigned xb_add(unsigned* p, unsigned v) { return __hip_atomic_fetch_add(p, v, __ATOMIC_RELAXED, __HIP_MEMORY_SCOPE_AGENT); }
__device__ __forceinline__ unsigned xb_xcc_id() { return (unsigned)__builtin_amdgcn_s_getreg((3 << 11) | 20) & 0xFu; }
#define XB_SPIN(cond, bar) do { unsigned _sp = 0; while (cond) { __builtin_amdgcn_s_sleep(1); \
    if ((++_sp & 255u) == 0u) { if (xb_ld(&(bar)[XB_TMO])) break; if (_sp > XB_SPIN_CAP) { atomicAdd(&(bar)[XB_TMO], 1u); break; } } } } while (0)
struct XcdBarrier { unsigned* bar; unsigned x; volatile LAS unsigned* st; };
__device__ __forceinline__ XcdBarrier xcd_barrier_post(unsigned* bar, volatile LAS unsigned* st, int tid) {
    XcdBarrier b; b.bar = bar; b.x = xb_xcc_id(); b.st = st;
    if (tid == 0) (void)xb_add(&bar[XB_XCNT(b.x)], 1u);
    return b;
}
__device__ __forceinline__ void xcd_barrier_complete(unsigned* bar, unsigned x, unsigned& nloc, unsigned& nx) {
    const unsigned G = gridDim.x * gridDim.y * gridDim.z;
    unsigned sum, cnt, mine, sp = 0u;
    for (;;) {
        sum = 0u; cnt = 0u; mine = 0u;
#pragma unroll
        for (unsigned j = 0; j < 16; ++j) { const unsigned c = xb_ld(&bar[XB_XCNT(j)]); sum += c; cnt += (c > 0u) ? 1u : 0u; mine = (j == x) ? c : mine; }
        if (sum == G) break;
        __builtin_amdgcn_s_sleep(1);
        if ((++sp & 255u) == 0u) { if (xb_ld(&bar[XB_TMO])) break; if (sp > XB_SPIN_CAP) { atomicAdd(&bar[XB_TMO], 1u); break; } }
    }
    nloc = mine > 0u ? mine : 1u; nx = cnt > 0u ? cnt : 1u;
}
__device__ __forceinline__ void xcd_barrier(const XcdBarrier& b, int tid) {
    asm volatile("s_waitcnt vmcnt(0)" ::: "memory");
    __syncthreads();
    if (tid == 0) {
        unsigned* bar = b.bar;
        __builtin_amdgcn_s_waitcnt(0);
        unsigned nloc = b.st[0], nx = b.st[1];
        if (nloc == 0u) { xcd_barrier_complete(bar, b.x, nloc, nx); b.st[0] = nloc; b.st[1] = nx; }
        const unsigned old = xb_add(&bar[XB_XSUB(b.x)], 1u);
        const unsigned gen = old / nloc;
        if (old + 1u == (gen + 1u) * nloc) {
            __builtin_amdgcn_fence(__ATOMIC_RELEASE, "agent");
            asm volatile("s_waitcnt vmcnt(0)" ::: "memory");
            const unsigned og = xb_add(&bar[XB_TOP], 1u);
            const unsigned tg = og / nx;
            if (og + 1u == (tg + 1u) * nx) xb_add(&bar[XB_TOPGEN], 1u);
            else XB_SPIN(xb_ld(&bar[XB_TOPGEN]) == tg, bar);
            __builtin_amdgcn_fence(__ATOMIC_ACQUIRE, "agent");
            xb_add(&bar[XB_XGEN(b.x)], 1u);
            asm volatile("s_waitcnt vmcnt(0)" ::: "memory");
        } else {
            XB_SPIN(xb_ld(&bar[XB_XGEN(b.x)]) == gen, bar);
            __builtin_amdgcn_fence(__ATOMIC_ACQUIRE, "agent");
            asm volatile("s_waitcnt vmcnt(0)" ::: "memory");
        }
    }
    __syncthreads();
}

struct Args { const float* in[25]; float* out; unsigned char* ws; int ph_lo, ph_hi; };
struct Frame { LAS unsigned char* lds; int tid, lane, wave, vcu, G, gw, NGW, bx; };

__device__ __forceinline__ float wave_sum(float v, int lane) {
#pragma unroll
    for (int o = 1; o < 64; o <<= 1) v += shx(v, o, lane);
    return v;
}
__device__ __forceinline__ void transpose_item(const float* W, int ldw, int k0, int n0, bf16_t* WT, int ldt, int drow0, LAS float* scr, int lane, const float* gk = nullptr) {
    f32x4 t[8];
#pragma unroll
    for (int i = 0; i < 8; ++i) { const int kk = 8 * i + (lane >> 3); t[i] = *(const GAS f32x4*)(W + (size_t)(k0 + kk) * ldw + n0 + 4 * (lane & 7)); }
#pragma unroll
    for (int i = 0; i < 8; ++i) { const int kk = 8 * i + (lane >> 3); const float g = gk ? gk[k0 + kk] : 1.f; LAS float* d = scr + kk * 33 + 4 * (lane & 7);
        d[0] = t[i][0] * g; d[1] = t[i][1] * g; d[2] = t[i][2] * g; d[3] = t[i][3] * g; }
    asm volatile("s_waitcnt lgkmcnt(0)" ::: "memory");
    const int c = lane & 7;
#pragma unroll
    for (int j = 0; j < 4; ++j) { const int n = (lane >> 3) + 8 * j; const LAS float* s = scr + (8 * c) * 33 + n;
        u32x4 o; o.x = pk_bf16(s[0 * 33], s[1 * 33]); o.y = pk_bf16(s[2 * 33], s[3 * 33]); o.z = pk_bf16(s[4 * 33], s[5 * 33]); o.w = pk_bf16(s[6 * 33], s[7 * 33]);
        *(GAS u32x4*)(WT + (size_t)(drow0 + n) * ldt + k0 + 8 * c) = o; }
    asm volatile("s_waitcnt lgkmcnt(0)" ::: "memory");
}
__device__ __forceinline__ void transpose_mat_item(const float* W, int ldw, int K, int N, bf16_t* WT, int r, LAS float* scr, int lane, const float* gk = nullptr) {
    const int nblk = N / 32, kb = r / nblk, nb = r % nblk; transpose_item(W, ldw, 64 * kb, 32 * nb, WT, K, 32 * nb, scr, lane, gk);
}
__device__ __forceinline__ void norm_row(const float* xrow, const float* g, bf16_t* hb, float* xc, float* fo, int lane) {
    const GAS f32x4* xr = (const GAS f32x4*)xrow + lane; const GAS f32x4* gr = (const GAS f32x4*)g + lane;
    f32x4 v[4]; float s = 0.f;
#pragma unroll
    for (int j = 0; j < 4; ++j) { v[j] = xr[64 * j]; s += (v[j].x * v[j].x + v[j].y * v[j].y) + (v[j].z * v[j].z + v[j].w * v[j].w); }
    if (xc) {
#pragma unroll
        for (int j = 0; j < 4; ++j) ((GAS f32x4*)xc + lane)[64 * j] = v[j];
    }
    const float rstd = 1.0f / sqrtf(wave_sum(s, lane) * (1.f / D) + RMS_EPS);
#pragma unroll
    for (int j = 0; j < 4; ++j) { v[j] = v[j] * rstd * gr[64 * j]; }
    if (hb) { GAS u32x2* o8 = (GAS u32x2*)hb + lane;
#pragma unroll
        for (int j = 0; j < 4; ++j) { u32x2 w; w.x = pk_bf16(v[j].x, v[j].y); w.y = pk_bf16(v[j].z, v[j].w); o8[64 * j] = w; } }
    if (fo) {
#pragma unroll
        for (int j = 0; j < 4; ++j) ((GAS f32x4*)fo + lane)[64 * j] = v[j];
    }
}
__device__ __forceinline__ int up_dest_row(int n) { return n < FF ? 256 * (n >> 7) + (n & 127) : 256 * ((n - FF) >> 7) + 128 + ((n - FF) & 127); }

__device__ __forceinline__ void ffn_weight_items(const Frame& F, const Args& a, int l, int wi, int nw) {
    LAS float* scr = (LAS float*)(F.lds + RING_OFF + F.wave * 16384);
    unsigned char* ws = a.ws;
    constexpr int I_UP = 16 * 176, I_DN = 44 * 32;
    for (int r = wi; r < I_UP + I_DN; r += nw) {
        if (r < I_UP) { const int kb = r / 176, nb = r % 176;
            transpose_item(a.in[21] + (size_t)l * D * FF2, FF2, 64 * kb, 32 * nb, (bf16_t*)(ws + WS_WUP) + (size_t)l * FF2 * D, D, up_dest_row(32 * nb), scr, F.lane, a.in[12] + l * D); }
        else transpose_mat_item(a.in[24] + (size_t)l * FF * D, D, FF, D, (bf16_t*)(ws + WS_WDN) + (size_t)l * D * FF, r - I_UP, scr, F.lane);
    }
}
__device__ __forceinline__ void p0_prologue(const Frame& F, const Args& a) {
    LAS float* scr = (LAS float*)(F.lds + RING_OFF + F.wave * 16384);
    unsigned char* ws = a.ws;
    constexpr int I_QKV = 16 * 96, I_SQ = 16 * 32, I_POOL = 4 * 32, I_KV = 16 * 64;
    constexpr int NIT = I_QKV + I_SQ + I_POOL + 2 * I_KV + 2 * I_SQ;
    for (int it = F.gw; it < NIT; it += F.NGW) {
        int r = it;
        if (r < I_QKV) { transpose_mat_item(a.in[14], 3 * D, D, 3 * D, (bf16_t*)(ws + WS_WQKV), r, scr, F.lane, a.in[9]); continue; } r -= I_QKV;
        if (r < I_SQ) { transpose_mat_item(a.in[15], D, D, D, (bf16_t*)(ws + WS_WO), r, scr, F.lane); continue; } r -= I_SQ;
        if (r < I_POOL) { const int g = r >> 5; transpose_mat_item(a.in[16] + (size_t)g * 65536, 256, 256, 256, (bf16_t*)(ws + WS_WPOOL) + (size_t)g * 65536, r & 31, scr, F.lane); continue; } r -= I_POOL;
        if (r < 2 * I_KV) { const int l = r / I_KV; transpose_mat_item(a.in[19] + (size_t)l * D * 2 * D, 2 * D, D, 2 * D, (bf16_t*)(ws + WS_WCAKV) + (size_t)l * 2 * D * D, r % I_KV, scr, F.lane); continue; } r -= 2 * I_KV;
        if (r < 2 * I_SQ) { const int l = r / I_SQ; transpose_mat_item(a.in[20] + (size_t)l * D * D, D, D, D, (bf16_t*)(ws + WS_WCAO) + (size_t)l * D * D, r % I_SQ, scr, F.lane); continue; } r -= 2 * I_SQ;
    }
    { const int n8 = 2 * D * D / 8;
      for (int i = F.bx * 512 + F.tid; i < n8; i += F.G * 512) { const int l = i / (D * D / 8), kk = (i % (D * D / 8)) / (D / 8); const float g = a.in[10][l * D + kk];
          const GAS f32x4* src = (const GAS f32x4*)a.in[18] + 2 * (size_t)i; const f32x4 x = src[0] * g, y = src[1] * g;
          u32x4 w; w.x = pk_bf16(x[0], x[1]); w.y = pk_bf16(x[2], x[3]); w.z = pk_bf16(y[0], y[1]); w.w = pk_bf16(y[2], y[3]); ((GAS u32x4*)(ws + WS_WCAQ))[i] = w; } }
    { const GAS f32x4* src = (const GAS f32x4*)a.in[8]; GAS u32x4* dst = (GAS u32x4*)(ws + WS_VMTS); const int n8 = 2 * DB * NMEM * D / 8;
      for (int i = F.bx * 512 + F.tid; i < n8; i += F.G * 512) { const f32x4 x = src[2 * i], y = src[2 * i + 1]; u32x4 w; w.x = pk_bf16(x[0], x[1]); w.y = pk_bf16(x[2], x[3]); w.z = pk_bf16(y[0], y[1]); w.w = pk_bf16(y[2], y[3]); dst[i] = w; } }
    { const GAS f32x4* src = (const GAS f32x4*)a.in[7]; GAS u32x4* dst = (GAS u32x4*)(ws + WS_KMS); const int n8 = 2 * DB * NMEM * D / 8;
      for (int i = F.bx * 512 + F.tid; i < n8; i += F.G * 512) { const f32x4 x = src[2 * i], y = src[2 * i + 1]; u32x4 w; w.x = pk_bf16(x[0], x[1]); w.y = pk_bf16(x[2], x[3]); w.z = pk_bf16(y[0], y[1]); w.w = pk_bf16(y[2], y[3]); dst[i] = w; } }
    for (int m = F.gw; m < 2 * NB * NMEM; m += F.NGW) { const int l = m / (NB * NMEM), r = m % (NB * NMEM);
        norm_row(a.in[2] + (size_t)r * D, a.in[11] + l * D, (bf16_t*)(ws + WS_MN) + (size_t)m * D, nullptr, nullptr, F.lane); }
    { GAS float* ssz = (GAS float*)(ws + WS_SS) + M; for (int i = F.bx * 512 + F.tid; i < 6 * M; i += F.G * 512) ssz[i] = 0.f; }
    for (int m = F.gw; m < M; m += 2 * F.NGW) {
        const int m2 = m + F.NGW; const bool has2 = m2 < M;
        const float* xr = m < MP ? a.in[0] + (size_t)m * D : a.in[1] + (size_t)(m - MP) * D; const float* xr2 = !has2 ? xr : (m2 < MP ? a.in[0] + (size_t)m2 * D : a.in[1] + (size_t)(m2 - MP) * D);
        const GAS f32x4* xp = (const GAS f32x4*)xr + F.lane; const GAS f32x4* xp2 = (const GAS f32x4*)xr2 + F.lane;
        f32x4 v[4], v2[4];
#pragma unroll
        for (int j = 0; j < 4; ++j) { v[j] = xp[64 * j]; v2[j] = xp2[64 * j]; }
        GAS u32x2* op = (GAS u32x2*)((bf16_t*)(ws + WS_HB) + (size_t)m * D) + F.lane; GAS u32x2* op2 = (GAS u32x2*)((bf16_t*)(ws + WS_HB) + (size_t)(has2 ? m2 : m) * D) + F.lane; float q = 0.f, q2 = 0.f;
#pragma unroll
        for (int j = 0; j < 4; ++j) { u32x2 w; w.x = pk_bf16(v[j].x, v[j].y); w.y = pk_bf16(v[j].z, v[j].w); op[64 * j] = w;
            q += (bf_lo(w.x) * bf_lo(w.x) + bf_hi(w.x) * bf_hi(w.x)) + (bf_lo(w.y) * bf_lo(w.y) + bf_hi(w.y) * bf_hi(w.y));
            u32x2 w2; w2.x = pk_bf16(v2[j].x, v2[j].y); w2.y = pk_bf16(v2[j].z, v2[j].w); if (has2) op2[64 * j] = w2;
            q2 += (bf_lo(w2.x) * bf_lo(w2.x) + bf_hi(w2.x) * bf_hi(w2.x)) + (bf_lo(w2.y) * bf_lo(w2.y) + bf_hi(w2.y) * bf_hi(w2.y)); }
        q = wave_sum(q, F.lane); q2 = wave_sum(q2, F.lane);
        if (F.lane == 0) { ((GAS float*)(ws + WS_SS))[m] = q; if (has2) ((GAS float*)(ws + WS_SS))[m2] = q2; } }
}
__device__ __forceinline__ void final_phase(const Frame& F, const Args& a) {
    const float* ss = (const float*)(a.ws + WS_SS) + (size_t)6 * M; const GAS f32x4* gr = (const GAS f32x4*)a.in[13] + F.lane;
    f32x4 g[4];
#pragma unroll
    for (int j = 0; j < 4; ++j) g[j] = gr[64 * j];
    for (int m0 = F.gw; m0 < MP; m0 += 4 * F.NGW) {
        u32x2 w[4][4]; float rs[4];
#pragma unroll
        for (int r = 0; r < 4; ++r) { const int m = m0 + r * F.NGW < MP ? m0 + r * F.NGW : m0; rs[r] = __builtin_amdgcn_rsqf(ss[m] * (1.f / D) + RMS_EPS);
            const GAS u32x2* xp = (const GAS u32x2*)((const bf16_t*)(a.ws + WS_HB) + (size_t)m * D) + F.lane;
#pragma unroll
            for (int j = 0; j < 4; ++j) w[r][j] = xp[64 * j]; }
#pragma unroll
        for (int r = 0; r < 4; ++r) { const int m = m0 + r * F.NGW; if (m < MP) { GAS f32x4* op = (GAS f32x4*)(a.out + OUT_Y + (size_t)m * D) + F.lane;
#pragma unroll
            for (int j = 0; j < 4; ++j) __builtin_nontemporal_store((f32x4){bf_lo(w[r][j].x), bf_hi(w[r][j].x), bf_lo(w[r][j].y), bf_hi(w[r][j].y)} * rs[r] * g[j], op + 64 * j); } }
    }
    for (int r = F.NGW - 1 - F.gw; r < MS; r += F.NGW) {
        const GAS u32x2* xp = (const GAS u32x2*)((const bf16_t*)(a.ws + WS_HB) + (size_t)(MP + r) * D) + F.lane;
        f32x4 x[4];
#pragma unroll
        for (int j = 0; j < 4; ++j) { const u32x2 w = xp[64 * j]; x[j] = (f32x4){bf_lo(w.x), bf_hi(w.x), bf_lo(w.y), bf_hi(w.y)}; }
#pragma unroll
        for (int p = 0; p < 11; ++p) { const GAS u32x2* pp = (const GAS u32x2*)((const bf16_t*)(a.ws + WS_PART) + ((size_t)p * MS + r) * D) + F.lane;
#pragma unroll
            for (int j = 0; j < 4; ++j) { const u32x2 w = pp[64 * j]; x[j] += (f32x4){bf_lo(w.x), bf_hi(w.x), bf_lo(w.y), bf_hi(w.y)}; } }
        float q = 0.f;
#pragma unroll
        for (int j = 0; j < 4; ++j) q += x[j][0] * x[j][0] + x[j][1] * x[j][1] + x[j][2] * x[j][2] + x[j][3] * x[j][3];
        q = wave_sum(q, F.lane);
        const float rs = __builtin_amdgcn_rsqf(q * (1.f / D) + RMS_EPS);
        GAS f32x4* op = (GAS f32x4*)(a.out + OUT_Y + (size_t)(MP + r) * D) + F.lane;
#pragma unroll
        for (int j = 0; j < 4; ++j) __builtin_nontemporal_store(x[j] * rs * g[j], op + 64 * j);
    }
}
template <int W> __device__ __forceinline__ void pool_load_h(float (&hv)[16], const Args& a, const float* ss, const float (&gn)[16], bool samp, int b, int m0, int t, int c0) {
    if (t >= 0) { const GAS u32x4* p = (const GAS u32x4*)((const bf16_t*)(a.ws + WS_HB) + (size_t)(m0 + t) * D + c0); const u32x4 x = p[0], y = p[1];
        const float rs = __builtin_amdgcn_rsqf(ss[m0 + t] * (1.f / D) + RMS_EPS);
        const float v[16] = {bf_lo(x.x), bf_hi(x.x), bf_lo(x.y), bf_hi(x.y), bf_lo(x.z), bf_hi(x.z), bf_lo(x.w), bf_hi(x.w), bf_lo(y.x), bf_hi(y.x), bf_lo(y.y), bf_hi(y.y), bf_lo(y.z), bf_hi(y.z), bf_lo(y.w), bf_hi(y.w)};
#pragma unroll
        for (int e = 0; e < 16; ++e) hv[e] = v[e] * rs * gn[e]; }
    else if (samp) { const GAS f32x4* p = (const GAS f32x4*)(a.in[5] + ((size_t)b * 15 + (15 + t)) * D + c0);
#pragma unroll
        for (int q = 0; q < 4; ++q) { const f32x4 x = p[q]; hv[4 * q] = x[0]; hv[4 * q + 1] = x[1]; hv[4 * q + 2] = x[2]; hv[4 * q + 3] = x[3]; } }
    else {
#pragma unroll
        for (int e = 0; e < 16; ++e) hv[e] = 0.f; }
}
template <int W> __device__ __forceinline__ void pool_item(const Args& a, int chunk, int g, int lane) {
    bf16_t* PB = (bf16_t*)(a.ws + WS_QB); const float* ss = (const float*)(a.ws + WS_SS) + (size_t)3 * M;
    const bool samp = chunk >= MP / 64;
    const int b = samp ? chunk - MP / 64 : chunk >> 6, m0 = samp ? MP + b * DSEQ : b * SEQ, tl = samp ? DSEQ : SEQ;
    const int ts = (samp ? 0 : (chunk & 63) * 64) + 16 * (lane >> 4), c0 = g * 256 + (lane & 15) * 16;
    float gn[16];
    { const GAS f32x4* gp = (const GAS f32x4*)(a.in[9] + D + c0);
#pragma unroll
      for (int q = 0; q < 4; ++q) { const f32x4 x = gp[q]; gn[4 * q] = x[0]; gn[4 * q + 1] = x[1]; gn[4 * q + 2] = x[2]; gn[4 * q + 3] = x[3]; } }
    float run[16], hv[16];
#pragma unroll
    for (int e = 0; e < 16; ++e) run[e] = 0.f;
#pragma unroll 2
    for (int j = 1; j < W; ++j) { pool_load_h<W>(hv, a, ss, gn, samp, b, m0, ts - j, c0);
#pragma unroll
        for (int e = 0; e < 16; ++e) run[e] += hv[e]; }
#pragma unroll 4
    for (int i = 0; i < 16; ++i) {
        const int t = ts + i;
        pool_load_h<W>(hv, a, ss, gn, samp, b, m0, t, c0);
#pragma unroll
        for (int e = 0; e < 16; ++e) run[e] += hv[e];
        const int pos = samp ? PAST + t : t; const float inv = 1.0f / (float)(pos + 1 < W ? pos + 1 : W);
        u32x4 o0, o1;
        o0.x = pk_bf16(run[0] * inv - hv[0], run[1] * inv - hv[1]); o0.y = pk_bf16(run[2] * inv - hv[2], run[3] * inv - hv[3]); o0.z = pk_bf16(run[4] * inv - hv[4], run[5] * inv - hv[5]); o0.w = pk_bf16(run[6] * inv - hv[6], run[7] * inv - hv[7]);
        o1.x = pk_bf16(run[8] * inv - hv[8], run[9] * inv - hv[9]); o1.y = pk_bf16(run[10] * inv - hv[10], run[11] * inv - hv[11]); o1.z = pk_bf16(run[12] * inv - hv[12], run[13] * inv - hv[13]); o1.w = pk_bf16(run[14] * inv - hv[14], run[15] * inv - hv[15]);
        GAS u32x4* op = (GAS u32x4*)(PB + (size_t)(m0 + t) * D + c0); op[0] = o0; op[1] = o1;
        if (t >= tl - 15) { float* fo = (samp ? a.out + OUT_PSS : a.out + OUT_PSP) + ((size_t)b * 15 + (t - (tl - 15))) * D + c0;
#pragma unroll
            for (int q = 0; q < 4; ++q) ((GAS f32x4*)fo)[q] = (f32x4){hv[4 * q], hv[4 * q + 1], hv[4 * q + 2], hv[4 * q + 3]}; }
        float ho[16]; pool_load_h<W>(ho, a, ss, gn, samp, b, m0, t - (W - 1), c0);
#pragma unroll
        for (int e = 0; e < 16; ++e) run[e] -= ho[e];
    }
}
__device__ __forceinline__ void pool_phase(const Frame& F, const Args& a) {
    constexpr int NCH = MP / 64 + DB;
    for (int it = F.gw, pass = 0; it < NCH * 4; it += F.NGW, ++pass) {
        const int gs = it & 3, g = (pass & 1) ? 3 - gs : gs, chunk = it >> 2;
        if (g == 0) pool_item<2>(a, chunk, 0, F.lane); else if (g == 1) pool_item<4>(a, chunk, 1, F.lane); else if (g == 2) pool_item<8>(a, chunk, 2, F.lane); else pool_item<16>(a, chunk, 3, F.lane);
    }
}
__device__ __forceinline__ void ffn_fix_tile(unsigned char* ws, const float* cw, const float* cb, int pm, int tid) {
    const float* edge = (const float*)(ws + WS_EDGE); const float* first = (const float*)(ws + WS_FIRST); bf16_t* A2 = (bf16_t*)(ws + WS_A2);
    for (int it = tid; it < FF / 4; it += 512) {
        const int c4 = it * 4, dcol = 256 * (c4 >> 7) + (c4 & 127);
        f32x4 wg[3], wv[3];
#pragma unroll
        for (int j = 0; j < 3; ++j) { wg[j] = *(const GAS f32x4*)(cw + (size_t)j * FF2 + c4); wv[j] = *(const GAS f32x4*)(cw + (size_t)j * FF2 + FF + c4); }
        const f32x4 bg = *(const GAS f32x4*)(cb + c4), bv = *(const GAS f32x4*)(cb + FF + c4);
        const float* e = edge + (size_t)(pm - 1) * 2 * FF2 + dcol; const float* f = first + (size_t)pm * 2 * FF2 + dcol;
        const f32x4 g2 = *(const GAS f32x4*)e, v2 = *(const GAS f32x4*)(e + 128), g1 = *(const GAS f32x4*)(e + FF2), v1 = *(const GAS f32x4*)(e + FF2 + 128);
        const f32x4 g0 = *(const GAS f32x4*)f, v0 = *(const GAS f32x4*)(f + 128), gp = *(const GAS f32x4*)(f + FF2), vp = *(const GAS f32x4*)(f + FF2 + 128);
        const f32x4 ga = bg + wg[0] * g2 + wg[1] * g1 + wg[2] * g0, va = bv + wv[0] * v2 + wv[1] * v1 + wv[2] * v0;
        const f32x4 gb = bg + wg[0] * g1 + wg[1] * g0 + wg[2] * gp, vb = bv + wv[0] * v1 + wv[1] * v0 + wv[2] * vp;
        f32x4 ya, yb;
#pragma unroll
        for (int q = 0; q < 4; ++q) { ya[q] = ga[q] * va[q] * __builtin_amdgcn_rcpf(1.f + __builtin_amdgcn_exp2f(-ga[q] * LOG2E)); yb[q] = gb[q] * vb[q] * __builtin_amdgcn_rcpf(1.f + __builtin_amdgcn_exp2f(-gb[q] * LOG2E)); }
        u32x2 wa, wb; wa.x = pk_bf16(ya[0], ya[1]); wa.y = pk_bf16(ya[2], ya[3]); wb.x = pk_bf16(yb[0], yb[1]); wb.y = pk_bf16(yb[2], yb[3]);
        *(GAS u32x2*)(A2 + (size_t)(pm * 256) * FF + c4) = wa; *(GAS u32x2*)(A2 + (size_t)(pm * 256 + 1) * FF + c4) = wb;
    }
}

extern __shared__ __attribute__((aligned(16))) unsigned char lds_raw[];
typedef __attribute__((address_space(4))) const Args CArgs;
__device__ __forceinline__ CArgs* kargs() { CArgs* k = (CArgs*)__builtin_amdgcn_kernarg_segment_ptr(); asm volatile("" : "+s"(k)); return k; }
__device__ __forceinline__ int elect_tid() {
    unsigned ones = ~0u; asm volatile("" : "+s"(ones));
    const int lane = (int)__builtin_amdgcn_mbcnt_hi(ones, __builtin_amdgcn_mbcnt_lo(ones, 0u));
    unsigned t = 0u;
    if (lane == 0) t = __hip_atomic_fetch_add((LAS unsigned*)((LAS unsigned char*)lds_raw + TICKET_OFF), 1u, __ATOMIC_RELAXED, __HIP_MEMORY_SCOPE_WORKGROUP);
    return (int)((__builtin_amdgcn_readfirstlane(t) & 7u) * 64u) + lane;
}
__device__ __forceinline__ Frame make_frame() {
    Frame F; F.lds = (LAS unsigned char*)lds_raw;
    const int tid = elect_tid(); __syncthreads();
    int bx = blockIdx.x, G = gridDim.x; asm volatile("" : "+s"(bx), "+s"(G));
    F.tid = tid; F.lane = F.tid & 63; F.wave = __builtin_amdgcn_readfirstlane(F.tid >> 6);
    F.G = G; F.bx = bx; F.vcu = (F.G % 8 == 0) ? (bx % 8) * (F.G / 8) + bx / 8 : bx;
    F.gw = F.vcu * NWAVES + F.wave; F.NGW = F.G * NWAVES; return F;
}
__device__ __forceinline__ Args load_args() { CArgs* k = kargs(); Args a;
#pragma unroll
    for (int i = 0; i < 25; ++i) a.in[i] = k->in[i];
    a.out = k->out; a.ws = k->ws; a.ph_lo = k->ph_lo; a.ph_hi = k->ph_hi; return a; }
#define PHASE static __device__ __forceinline__ void

PHASE ph_prologue() { const Frame F = make_frame(); const Args a = load_args(); p0_prologue(F, a); }
__device__ __forceinline__ void memkv_part(const Frame& F, CArgs* k, int G2, int c2, int l0, int l1) {
    unsigned char* ws = k->ws; float* out = k->out;
    if (c2 < 0) return;
    for (int l = l0; l < l1; ++l) {
        { pg8::GemmP g{D, D, D}; pg8::SchedMN S{(const char*)(ws + WS_MN) + (size_t)l * NB * NMEM * D * 2, (const char*)(ws + WS_WCAKV) + (size_t)l * 2 * D * D * 2, D, D, 16, 4, G2, (c2 + 128 * l) % G2, 0};
          pg8::EpiMemK E{out + OUT_MKP + (size_t)l * NB * NMEM * D, (bf16_t*)(ws + WS_KMP) + (size_t)l * NB * NMEM * D};
          int t_ = F.tid; asm volatile("" : "+v"(t_)); pg8::gemm_phase(F.lds + RING_OFF, g, S, E, t_); }
        { pg8::GemmP g{D, D, D}; pg8::SchedMN S{(const char*)(ws + WS_MN) + (size_t)l * NB * NMEM * D * 2, (const char*)(ws + WS_WCAKV) + ((size_t)l * 2 * D * D + (size_t)D * D) * 2, D, D, 16, 4, G2, (c2 + 128 * l + 64) % G2, 0};
          pg8::EpiMemK E{out + OUT_MVP + (size_t)l * NB * NMEM * D, (bf16_t*)(ws + WS_VMTP) + (size_t)l * NB * NMEM * D};
          int t_ = F.tid; asm volatile("" : "+v"(t_)); pg8::gemm_phase(F.lds + RING_OFF, g, S, E, t_); }
    }
}
PHASE ph_qkv() {
    const Frame F = make_frame(); CArgs* k = kargs(); unsigned char* ws = k->ws;
    pg8::GemmP g{D, D, D}; pg8::SchedQKV S{(const char*)(ws + WS_HB), (const char*)(ws + WS_WQKV), M / 256, F.G, F.bx};
    pg8::EpiQKV E{(bf16_t*)(ws + WS_QB), (size_t)(WS_KB - WS_QB) / 2, k->out, sba::QSCALE, (const float*)(ws + WS_SS)};
    pg8::gemm_phase(F.lds + RING_OFF, g, S, E, F.tid);
    { const Frame F2 = make_frame();
      const int extra = (M / 256) * 12 - 12 * F2.G;
      int G2 = F2.G, c2 = F2.bx; if (extra > 0 && extra < F2.G) { G2 = F2.G - extra; c2 = F2.bx >= extra ? F2.bx - extra : -1; }
      memkv_part(F2, k, G2, c2, 0, 1); }
}
PHASE ph_sbattn() {
    const Frame F = make_frame(); CArgs* k = kargs(); unsigned char* ws = k->ws;
    sba::Tensors T{(const bf16_t*)(ws + WS_QB), (const bf16_t*)(ws + WS_KB), (const bf16_t*)(ws + WS_VB), (bf16_t*)(ws + WS_OB), k->in[3], k->in[4]};
    LAS char* vimg = (LAS char*)(F.lds + RING_OFF + F.wave * sba::WAVE_LDS);
    LAS unsigned* ctr = (LAS unsigned*)(F.lds + MISC_OFF + 64);
    for (;;) {
        unsigned j = 0u; if (F.lane == 0) j = __hip_atomic_fetch_add(ctr, 1u, __ATOMIC_RELAXED, __HIP_MEMORY_SCOPE_WORKGROUP);
        j = (unsigned)__builtin_amdgcn_readfirstlane(j);
        const int id = F.vcu * NWAVES + (int)(j & 7u) + (int)(j >> 3) * F.NGW;
        if (id >= 32768 + 1024) break;
        sba::unit(id, T, vimg, F.lane);
    }
}
__device__ __forceinline__ size_t ca_base(int layer) { return layer == 0 ? WS_QB : WS_OB; }
__device__ __forceinline__ int ca_vwrow0(int layer) { return layer == 0 ? (int)((WS_VB - WS_QB) / 2048) : (int)((WS_VW1 - WS_OB) / 2048); }
__device__ __forceinline__ void wkvw_part(const Frame& F, CArgs* k, int layer, int G, int c) {
    unsigned char* ws = k->ws;
    pg8::GemmP g{D, D, 256};
    pg8::SchedWKVW S{(const char*)(ws + WS_KMP) + (size_t)layer * NB * NMEM * D * 2, (const char*)(ws + WS_KMS) + (size_t)layer * DB * NMEM * D * 2,
                     (const char*)(ws + WS_VMTP) + (size_t)layer * NB * NMEM * D * 2, (const char*)(ws + WS_VMTS) + (size_t)layer * DB * NMEM * D * 2,
                     (const char*)(ws + WS_WCAQ) + (size_t)layer * D * D * 2, (const char*)(ws + WS_WCAO) + (size_t)layer * D * D * 2, G, c, ca_vwrow0(layer)};
    pg8::EpiBf16 E{(bf16_t*)(ws + ca_base(layer)), D, 1.f, nullptr};
    pg8::gemm_phase(F.lds + RING_OFF, g, S, E, F.tid);
}
PHASE ph_resid_gemm(int which_, int layer_, float alpha) {
    const int which = __builtin_amdgcn_readfirstlane(which_), layer = __builtin_amdgcn_readfirstlane(layer_);
    const Frame F = make_frame(); CArgs* k = kargs(); unsigned char* ws = k->ws;
    const char* A; const char* W; int K, ssi;
    if (which == 0) { A = (const char*)(ws + WS_OB); W = (const char*)(ws + WS_WO); K = D; ssi = 1; }
    else if (which == 1) { A = (const char*)(ws + WS_VB); W = (const char*)(ws + WS_WCAO) + (size_t)layer * D * D * 2; K = D; ssi = layer == 0 ? 2 : 5; }
    else { A = (const char*)(ws + WS_A2); W = (const char*)(ws + WS_WDN) + (size_t)layer * D * FF * 2; K = FF; ssi = layer == 0 ? 3 : 6; }
    const bool splitk = which == 2 && layer == 1;
    pg8::GemmP g{K, K, K}; pg8::SchedMN S{A, W, K, K, splitk ? MP / 256 : M / 256, 4, F.G, F.bx, 0};
    if (which == 2) {
        int last = -1;
        for (int i = 0; ; ++i) { pg8::Unit u; if (!S.next(i, u)) break; const int pm = u.row0 >> 8;
            if (pm != last && pm < MP / 256 && (pm & 15) != 0) ffn_fix_tile(ws, k->in[22] + (size_t)layer * 3 * FF2, k->in[23] + (size_t)layer * FF2, pm, F.tid);
            last = pm; }
        asm volatile("s_waitcnt vmcnt(0)" ::: "memory"); __syncthreads();
    }
    pg8::EpiResid<false> E{(bf16_t*)(ws + WS_HB), (float*)(ws + WS_SS) + (size_t)ssi * M, nullptr, alpha};
    pg8::gemm_phase(F.lds + RING_OFF, g, S, E, F.tid);
    if (splitk && alpha != 0.f) {
        const Frame F2 = make_frame();
        pg8::GemmP g2{FF, FF, 256}; pg8::SchedSplitK S2{A, W, F2.G, F2.bx};
        pg8::EpiBf16 E2{(bf16_t*)(ws + WS_PART), D, 1.f, nullptr};
        pg8::gemm_phase(F2.lds + RING_OFF, g2, S2, E2, F2.tid);
    }
    if (alpha != 0.f && (which == 0 || (which == 2 && layer == 0))) {
        const Frame F2 = make_frame();
        const int extra = (M / 256) * 4 - 4 * F2.G;
        const int nl = which == 0 ? 0 : 1;
        int G2 = F2.G, c2 = F2.bx; if (extra > 0 && extra < F2.G) { G2 = F2.G - extra; c2 = F2.bx >= extra ? F2.bx - extra : -1; }
        wkvw_part(F2, k, nl, G2, c2);
    }
}
PHASE ph_pool_gemm(float alpha) {
    const Frame F = make_frame(); CArgs* k = kargs(); unsigned char* ws = k->ws;
    pg8::GemmP g{D, 256, 256}; pg8::SchedPool S{(const char*)(ws + WS_QB), (const char*)(ws + WS_WPOOL), F.G, F.bx};
    pg8::EpiResid<true> E{(bf16_t*)(ws + WS_HB), (float*)(ws + WS_SS) + (size_t)4 * M, k->in[17], alpha};
    pg8::gemm_phase(F.lds + RING_OFF, g, S, E, F.tid);
}
PHASE ph_final() { const Frame F = make_frame(); const Args a = load_args(); final_phase(F, a); }
PHASE ph_pool() { const Frame F = make_frame(); const Args a = load_args(); pool_phase(F, a); }
__device__ __forceinline__ void ffn_tail(int l) {
    const Frame F2 = make_frame(); const Args a = load_args();
    const int extra = 1152 - 4 * F2.G;
    if (extra > 0 && extra < F2.G) { if (F2.bx >= extra) ffn_weight_items(F2, a, l, (F2.bx - extra) * NWAVES + F2.wave, (F2.G - extra) * NWAVES); }
    else ffn_weight_items(F2, a, l, F2.bx * NWAVES + F2.wave, F2.G * NWAVES);
}
PHASE ph_cascore(int layer_) {
    const int layer = __builtin_amdgcn_readfirstlane(layer_);
    const Frame F = make_frame(); CArgs* k = kargs(); unsigned char* ws = k->ws;
    pg8::GemmP g{D, D, D}; pg8::SchedCA2<0> S{(const char*)(ws + WS_HB), (const char*)(ws + ca_base(layer)), F.G, F.bx, ca_vwrow0(layer)};
    pg8::EpiSoftmax E{(bf16_t*)(ws + WS_KB), XCH_OFF, (const float*)(ws + WS_SS) + (size_t)(layer == 0 ? 1 : 4) * M, 0.0625f * LOG2E};
    pg8::gemm_phase(F.lds + RING_OFF, g, S, E, F.tid);
    if (layer == 0) {
        const Frame F2 = make_frame(); const int extra = 1152 - 4 * F2.G;
        int G2 = F2.G, c2 = F2.bx; if (extra > 0 && extra < F2.G) { G2 = F2.G - extra; c2 = F2.bx >= extra ? F2.bx - extra : -1; }
        memkv_part(F2, k, G2, c2, 1, 2); }
}
PHASE ph_caout(int layer_, float alpha) {
    const int layer = __builtin_amdgcn_readfirstlane(layer_);
    const Frame F = make_frame(); CArgs* k = kargs(); unsigned char* ws = k->ws;
    pg8::GemmP g{D, D, D}; pg8::SchedCA2<1> S{(const char*)(ws + WS_KB), (const char*)(ws + ca_base(layer)), F.G, F.bx, ca_vwrow0(layer)};
    pg8::EpiResid<false> E{(bf16_t*)(ws + WS_HB), (float*)(ws + WS_SS) + (size_t)(layer == 0 ? 2 : 5) * M, nullptr, alpha};
    pg8::gemm_phase(F.lds + RING_OFF, g, S, E, F.tid);
    if (layer == 0 && alpha != 0.f) { ffn_tail(0); ffn_tail(1); }
}
PHASE ph_up(int layer_) {
    const int layer = __builtin_amdgcn_readfirstlane(layer_);
    const Frame F = make_frame(); CArgs* k = kargs(); unsigned char* ws = k->ws; float* out = k->out;
    pg8::GemmP g{D, D, D}; pg8::SchedMN S{(const char*)(ws + WS_HB), (const char*)(ws + WS_WUP) + (size_t)layer * FF2 * D * 2, D, D, M / 256, 22, F.G, F.bx, 0};
    pg8::EpiUpGate E{(bf16_t*)(ws + WS_A2), k->in[22] + (size_t)layer * 3 * FF2, k->in[23] + (size_t)layer * FF2, k->in[6] + (size_t)layer * DB * 2 * FF2,
                     out + OUT_FSP + (size_t)layer * NB * 2 * FF2, out + OUT_FSS + (size_t)layer * DB * 2 * FF2, (float*)(ws + WS_EDGE), (float*)(ws + WS_FIRST), XCH_OFF, (const float*)(ws + WS_SS) + (size_t)(layer == 0 ? 2 : 5) * M};
    pg8::gemm_phase(F.lds + RING_OFF, g, S, E, F.tid);
}

constexpr int N_PHASES = 15;
__global__ void __launch_bounds__(NWAVES * 64, 2) trunk_fwd(Args args_unused) {
    CArgs* k = kargs();
    volatile LAS unsigned* MISC = (volatile LAS unsigned*)((LAS unsigned char*)lds_raw + MISC_OFF);
    { const int tid = elect_tid(); __syncthreads();
      if (tid < 32) MISC[tid] = 0u;
      __syncthreads();
      if (k->ph_hi - k->ph_lo > 1) (void)xcd_barrier_post((unsigned*)(k->ws + WS_CTL) + CW_BAR, MISC + 8, tid); }
#ifndef PHASE_MASK
#define PHASE_MASK 0xffffffffull
#endif
#define IN(p) ((((PHASE_MASK) >> (p)) & 1ull) && k->ph_lo <= (p) && (p) < k->ph_hi)
#define SEAM(p) do { if (IN(p) && IN((p) + 1)) { XcdBarrier bar; bar.bar = (unsigned*)(k->ws + WS_CTL) + CW_BAR; bar.x = xb_xcc_id(); bar.st = MISC + 8; xcd_barrier(bar, elect_tid()); } } while (0)
#ifndef PROBE_REP
#define PROBE_REP 0ull
#endif
#define GBAR() do { XcdBarrier bar; bar.bar = (unsigned*)(k->ws + WS_CTL) + CW_BAR; bar.x = xb_xcc_id(); bar.st = MISC + 8; xcd_barrier(bar, elect_tid()); } while (0)
#define RUN(p, call, recall) do { if (IN(p)) { call; if (((PROBE_REP) >> (p)) & 1ull) { GBAR(); recall; } } SEAM(p); } while (0)
    RUN(0, ph_prologue(), ph_prologue());
    RUN(1, ph_qkv(), ph_qkv());
    RUN(2, ph_sbattn(), ph_sbattn());
    RUN(3, ph_resid_gemm(0, 0, 1.f), ph_resid_gemm(0, 0, 0.f));
    for (int layer = 0; layer < 2; ++layer) {
        const int pb = 4 + 6 * layer;
        if (layer == 1) {
            RUN(8, ph_pool(), ph_pool());
            RUN(9, ph_pool_gemm(1.f), ph_pool_gemm(0.f));
        }
        RUN(pb + 0, ph_cascore(layer), ph_cascore(layer));
        RUN(pb + 1, ph_caout(layer, 1.f), ph_caout(layer, 0.f));
        RUN(pb + 2, ph_up(layer), ph_up(layer));
        RUN(pb + 3, ph_resid_gemm(2, layer, 1.f), ph_resid_gemm(2, layer, 0.f));
    }
    if (IN(14)) ph_final();
#undef IN
#undef SEAM
#undef RUN
#undef GBAR
}

extern "C" void kernel_launch(void* const* d_in, const int* in_sizes, int n_in, void* d_out, int out_size, void* d_ws, size_t ws_size, hipStream_t stream) {
    static int grid = 0;
    if (grid == 0) {
        if (n_in != 25 || (size_t)out_size != OUT_TOTAL || ws_size < WS_END) { fprintf(stderr, "kernel_launch: unexpected shapes: n_in %d out %d ws %zu\n", n_in, out_size, ws_size); grid = -1; return; }
        int dev = 0, cus = 0;
        if (hipGetDevice(&dev) != hipSuccess || hipDeviceGetAttribute(&cus, hipDeviceAttributeMultiprocessorCount, dev) != hipSuccess) { grid = -1; return; }
        if (hipFuncSetAttribute((const void*)trunk_fwd, hipFuncAttributeMaxDynamicSharedMemorySize, LDS_BYTES) != hipSuccess) { fprintf(stderr, "kernel_launch: hipFuncSetAttribute failed\n"); grid = -1; return; }
        int per_cu = 0;
        if (hipOccupancyMaxActiveBlocksPerMultiprocessor(&per_cu, (const void*)trunk_fwd, NWAVES * 64, LDS_BYTES) != hipSuccess || per_cu < 1) fprintf(stderr, "kernel_launch: occupancy query reports %d\n", per_cu);
        (void)hipGetLastError();
        grid = cus;
    }
    if (grid < 0) return;
    (void)hipMemsetAsync((char*)d_ws + WS_CTL, 0, CTL_ZERO_BYTES, stream);
    Args a{};
    for (int i = 0; i < 25; ++i) a.in[i] = (const float*)d_in[i];
    a.out = (float*)d_out; a.ws = (unsigned char*)d_ws;
#if MK_ONE_LAUNCH
    a.ph_lo = 0; a.ph_hi = N_PHASES;
    hipLaunchKernelGGL(trunk_fwd, dim3(grid), dim3(NWAVES * 64), LDS_BYTES, stream, a);
#else
    for (int p = 0; p < N_PHASES; ++p) { a.ph_lo = p; a.ph_hi = p + 1; hipLaunchKernelGGL(trunk_fwd, dim3(grid), dim3(NWAVES * 64), LDS_BYTES, stream, a); }
#endif
}
```
